# Optimizing an MI355X kernel written in HIP

```python
import math
import jax, jax.numpy as jnp
from jax import lax
import numpy as np

D_MODEL = 1024
BATCH = 4
SEQ = 8192
DEPTH = 2

N_A_LAYERS = DEPTH // 2
N_B_LAYERS = DEPTH - N_A_LAYERS
HEAD_DIM = 64
A_HEADS = D_MODEL // (2 * HEAD_DIM)
A_VDIM = 2 * HEAD_DIM
A_QK_WIDTH = A_HEADS * 2 * HEAD_DIM
A_V_WIDTH = A_HEADS * A_VDIM
B_HEADS = D_MODEL // HEAD_DIM
B_WIDTH = B_HEADS * HEAD_DIM
FFN_HIDDEN = 256 * ((8 * D_MODEL // 3 + 255) // 256)
BLOCK_Q = 128
NUM_BUCKETS = 32
MAX_DISTANCE = 128
N_MOD = 9
EPS = 1e-6

kernel_name = "yoco_diffattn_fox_macaron_adaln"


def rms_norm(x, g):
    xf = x.astype(jnp.float32)
    y = xf * lax.rsqrt(jnp.mean(xf * xf, axis=-1, keepdims=True) + EPS)
    return (y * g.astype(jnp.float32)).astype(x.dtype)


def modulate(h, shift, scale):
    return h * (1 + scale[:, None, :]) + shift[:, None, :]


def swiglu(h, w_in, w_out):
    g, u = jnp.split(h @ w_in, 2, axis=-1)
    return (jax.nn.silu(g) * u) @ w_out


def t5_bucket(rel):
    n = jnp.maximum(rel, 0)
    max_exact = NUM_BUCKETS // 2
    nf = jnp.maximum(n, 1).astype(jnp.float32)
    large = max_exact + (jnp.log(nf / max_exact) / math.log(MAX_DISTANCE / max_exact)
                         * (NUM_BUCKETS - max_exact)).astype(jnp.int32)
    large = jnp.minimum(large, NUM_BUCKETS - 1)
    return jnp.where(n < max_exact, n, large)


def to_blocks(t):
    b, s = t.shape[:2]
    t = t.reshape((b, s // BLOCK_Q, BLOCK_Q) + t.shape[2:])
    return jnp.moveaxis(t, 1, 0)


def from_blocks(t):
    t = jnp.moveaxis(t, 0, 1)
    return t.reshape((t.shape[0], t.shape[1] * t.shape[2]) + t.shape[3:])


def lambda_init_fn(layer):
    return 0.8 - 0.6 * math.exp(-0.3 * layer)


def diff_attention(h, w_qkv, w_o, lam_params, subln_g, rel_bias, lambda_init):
    b, s, _ = h.shape
    qkv = h @ w_qkv
    q, k, v = jnp.split(qkv, [A_QK_WIDTH, 2 * A_QK_WIDTH], axis=-1)
    q = q.reshape(b, s, A_HEADS, 2, HEAD_DIM)
    k = k.reshape(b, s, A_HEADS, 2, HEAD_DIM)
    v = v.reshape(b, s, A_HEADS, A_VDIM)
    lf = lam_params.astype(jnp.float32)
    lam = jnp.exp(jnp.sum(lf[0] * lf[1])) - jnp.exp(jnp.sum(lf[2] * lf[3])) + lambda_init
    table = rel_bias.astype(jnp.float32)
    k_pos = jnp.arange(s)
    scale = HEAD_DIM ** -0.5

    def block(args):
        qb, blk = args
        q_pos = blk * BLOCK_Q + jnp.arange(BLOCK_Q)
        rel = q_pos[:, None] - k_pos[None, :]
        bias = jnp.take(table, t5_bucket(rel), axis=0)
        bias = jnp.transpose(bias, (2, 0, 1))[None, :, None]
        logits = jnp.einsum('bqhmd,bkhmd->bhmqk', qb, k).astype(jnp.float32) * scale + bias
        logits = jnp.where(rel >= 0, logits, -jnp.inf)
        p = jax.nn.softmax(logits, axis=-1)
        w = p[:, :, 0] - lam * p[:, :, 1]
        return jnp.einsum('bhqk,bkhe->bqhe', w.astype(v.dtype), v)

    nb = s // BLOCK_Q
    o = from_blocks(lax.map(block, (to_blocks(q), jnp.arange(nb))))
    o = rms_norm(o, subln_g) * (1 - lambda_init)
    return o.reshape(b, s, A_V_WIDTH) @ w_o


def shared_kv(x, c_act, kv_ada_w, kv_ada_b, kv_norm_g, kv_w, fgate_w, fgate_b):
    b, s, _ = x.shape
    shift, scale = jnp.split(c_act @ kv_ada_w + kv_ada_b, 2, axis=-1)
    h = modulate(rms_norm(x, kv_norm_g), shift, scale)
    k, v = jnp.split(h @ kv_w, 2, axis=-1)
    k = k.reshape(b, s, B_HEADS, HEAD_DIM)
    v = v.reshape(b, s, B_HEADS, HEAD_DIM)
    log_f = jax.nn.log_sigmoid((h @ fgate_w + fgate_b).astype(jnp.float32))
    F = jnp.cumsum(log_f, axis=1)
    return k, v, F


def forgetting_attention(h, w_q, w_o, k, v, F):
    b, s, _ = h.shape
    q = (h @ w_q).reshape(b, s, B_HEADS, HEAD_DIM)
    k_pos = jnp.arange(s)
    F_k = jnp.transpose(F, (0, 2, 1))
    scale = HEAD_DIM ** -0.5

    def block(args):
        qb, Fqb, blk = args
        q_pos = blk * BLOCK_Q + jnp.arange(BLOCK_Q)
        causal = q_pos[:, None] >= k_pos[None, :]
        decay = jnp.transpose(Fqb, (0, 2, 1))[..., None] - F_k[:, :, None, :]
        logits = jnp.einsum('bqhd,bkhd->bhqk', qb, k).astype(jnp.float32) * scale + decay
        logits = jnp.where(causal, logits, -jnp.inf)
        p = jax.nn.softmax(logits, axis=-1)
        return jnp.einsum('bhqk,bkhd->bqhd', p.astype(v.dtype), v)

    nb = s // BLOCK_Q
    o = from_blocks(lax.map(block, (to_blocks(q), to_blocks(F), jnp.arange(nb))))
    return o.reshape(b, s, B_WIDTH) @ w_o


def setup_inputs(seed: int = 0) -> dict:
    key = jax.random.key(seed)
    ks = jax.random.split(key, 21)
    f32 = jnp.float32
    D = D_MODEL

    def nrm(k, shape, std):
        return jax.random.normal(k, shape, f32) * std

    return {
        "x": nrm(ks[0], (BATCH, SEQ, D), 1.0),
        "c": nrm(ks[1], (BATCH, D), 1.0),
        "ada_w": nrm(ks[2], (DEPTH, D, N_MOD * D), 0.5 * D ** -0.5),
        "ada_b": nrm(ks[3], (DEPTH, N_MOD * D), 0.02),
        "norm_g": 1.0 + nrm(ks[4], (DEPTH, 3, D), 0.02),
        "ffn_w_in": nrm(ks[5], (DEPTH, 2, D, 2 * FFN_HIDDEN), D ** -0.5),
        "ffn_w_out": nrm(ks[6], (DEPTH, 2, FFN_HIDDEN, D), FFN_HIDDEN ** -0.5),
        "a_w_qkv": nrm(ks[7], (N_A_LAYERS, D, 2 * A_QK_WIDTH + A_V_WIDTH), D ** -0.5),
        "a_w_o": nrm(ks[8], (N_A_LAYERS, A_V_WIDTH, D), A_V_WIDTH ** -0.5),
        "a_lambda": nrm(ks[9], (N_A_LAYERS, 4, HEAD_DIM), 0.1),
        "a_subln_g": 1.0 + nrm(ks[10], (N_A_LAYERS, A_VDIM), 0.02),
        "rel_bias": nrm(ks[11], (NUM_BUCKETS, A_HEADS), 0.5),
        "kv_ada_w": nrm(ks[12], (D, 2 * D), 0.5 * D ** -0.5),
        "kv_ada_b": nrm(ks[13], (2 * D,), 0.02),
        "kv_norm_g": 1.0 + nrm(ks[14], (D,), 0.02),
        "kv_w": nrm(ks[15], (D, 2 * B_WIDTH), D ** -0.5),
        "fgate_w": nrm(ks[16], (D, B_HEADS), D ** -0.5),
        "fgate_b": jax.random.uniform(ks[17], (B_HEADS,), f32, minval=1.0, maxval=4.0),
        "b_w_q": nrm(ks[18], (N_B_LAYERS, D, B_WIDTH), D ** -0.5),
        "b_w_o": nrm(ks[19], (N_B_LAYERS, B_WIDTH, D), B_WIDTH ** -0.5),
        "final_g": 1.0 + nrm(ks[20], (D,), 0.02),
    }


def reference(x, c, ada_w, ada_b, norm_g, ffn_w_in, ffn_w_out, a_w_qkv, a_w_o, a_lambda,
              a_subln_g, rel_bias, kv_ada_w, kv_ada_b, kv_norm_g, kv_w, fgate_w, fgate_b,
              b_w_q, b_w_o, final_g):
    c_act = jax.nn.silu(c)
    k_sh = v_sh = F_sh = None
    for layer in range(DEPTH):
        if layer == N_A_LAYERS:
            k_sh, v_sh, F_sh = shared_kv(x, c_act, kv_ada_w, kv_ada_b, kv_norm_g, kv_w,
                                         fgate_w, fgate_b)
        mod = c_act @ ada_w[layer] + ada_b[layer]
        sh1, sc1, g1, sh2, sc2, g2, sh3, sc3, g3 = jnp.split(mod, N_MOD, axis=-1)
        h = modulate(rms_norm(x, norm_g[layer, 0]), sh1, sc1)
        x = x + 0.5 * g1[:, None, :] * swiglu(h, ffn_w_in[layer, 0], ffn_w_out[layer, 0])
        h = modulate(rms_norm(x, norm_g[layer, 1]), sh2, sc2)
        if layer < N_A_LAYERS:
            mix = diff_attention(h, a_w_qkv[layer], a_w_o[layer], a_lambda[layer],
                                 a_subln_g[layer], rel_bias, lambda_init_fn(layer))
        else:
            j = layer - N_A_LAYERS
            mix = forgetting_attention(h, b_w_q[j], b_w_o[j], k_sh, v_sh, F_sh)
        x = x + g2[:, None, :] * mix
        h = modulate(rms_norm(x, norm_g[layer, 2]), sh3, sc3)
        x = x + 0.5 * g3[:, None, :] * swiglu(h, ffn_w_in[layer, 1], ffn_w_out[layer, 1])
    return rms_norm(x, final_g)
```

```cpp
#include <hip/hip_cooperative_groups.h>
#include <hip/hip_runtime.h>
#include <cstdio>
#include <cstdint>
__device__ __forceinline__ int opq_tid(int wave_s) { int l; asm volatile("v_mbcnt_lo_u32_b32 %0, -1, 0\n\tv_mbcnt_hi_u32_b32 %0, -1, %0" : "=v"(l)); return (wave_s << 6) | l; }
template <int O> __device__ __forceinline__ float xlane_partner_lt32(float v) { return __int_as_float(__builtin_amdgcn_ds_swizzle(__float_as_int(v), (O << 10) | 0x1f)); }
template <int O> __device__ __forceinline__ float xadd(float v) {
    if constexpr (O == 32) { auto rr = __builtin_amdgcn_permlane32_swap(__float_as_uint(v), __float_as_uint(v), false, false); return __uint_as_float(rr[0]) + __uint_as_float(rr[1]); }
    else return v + xlane_partner_lt32<O>(v); }
template <int O> __device__ __forceinline__ float xmax(float v) {
    if constexpr (O == 32) { auto rr = __builtin_amdgcn_permlane32_swap(__float_as_uint(v), __float_as_uint(v), false, false); return fmaxf(__uint_as_float(rr[0]), __uint_as_float(rr[1])); }
    else return fmaxf(v, xlane_partner_lt32<O>(v)); }
__device__ __forceinline__ float wave_sum64(float v) { v = xadd<1>(v); v = xadd<2>(v); v = xadd<4>(v); v = xadd<8>(v); v = xadd<16>(v); return xadd<32>(v); }
__device__ __forceinline__ float wave_max32(float v) { v = xmax<1>(v); v = xmax<2>(v); v = xmax<4>(v); v = xmax<8>(v); return xmax<16>(v); }
__device__ __forceinline__ float wave_max64(float v) { return xmax<32>(wave_max32(v)); }
namespace pg8 {
#define PG8_LAS __attribute__((address_space(3)))
typedef unsigned short bf16_t;
typedef short bf16x8 __attribute__((ext_vector_type(8)));
typedef float f32x4 __attribute__((ext_vector_type(4)));
typedef unsigned u32x4 __attribute__((ext_vector_type(4)));
constexpr int BM = 256, BK = 64, HALF = 128, HTB = HALF * BK * 2  , STAGE_BYTES = 8 * HTB, NXCD = 8, WGM = 8;

__host__ __device__ __forceinline__ int lds_byte(int r, int c) { const int st = (r >> 4) * 2 + (c >> 5), rr = r & 15, cc = c & 31, ob = rr * 64 + cc * 2; return st * 1024 + (ob ^ (((ob >> 9) & 1) << 5)); }
__host__ __device__ __forceinline__ void stage_rc(int b, int& R, int& C) { const int st = b / 1024, sb = b % 1024, swz = sb ^ (((sb >> 9) & 1) << 5); R = (st >> 1) * 16 + swz / 64; C = (st & 1) * 32 + (swz % 64) / 2; }
__host__ __device__ __forceinline__ int perm32(int rho) { const int n = rho >> 4, i = rho & 15; return 8 * (i >> 2) + 4 * n + (i & 3); }

struct Unit { int pm, pn; };
struct Gemm { const bf16_t* A; const bf16_t* Bt; int M, N, K; };

struct StaticOrder {
    int nM, nN, nwg, G, c;
    __host__ __device__ void init(int M, int N, int G_, int c_) { nM = M / BM; nN = N / BM; nwg = nM * nN; G = G_; c = c_; }
    __host__ __device__ bool next(int i, Unit& u) const {
        const long L = (long)i * G + c; if (L >= nwg) return false;
        int wgid = (int)L; { const int q = nwg / NXCD, r = nwg % NXCD, xcd = wgid % NXCD, off = wgid / NXCD; wgid = (xcd < r ? xcd * (q + 1) : r * (q + 1) + (xcd - r) * q) + off; }
        const int nig = WGM * nN, gid = wgid / nig, fm = gid * WGM, gsz = (nM - fm) < WGM ? (nM - fm) : WGM;
        u.pm = fm + ((wgid % nig) % gsz); u.pn = (wgid % nig) / gsz; return true;
    }
    __device__ __forceinline__ void a_ready(const Unit&) const {}
    __device__ __forceinline__ void done(const Unit&) const {}
};

__device__ __forceinline__ unsigned cvt_pk_bf16(float lo, float hi) { unsigned r; asm volatile("v_cvt_pk_bf16_f32 %0, %1, %2" : "=v"(r) : "v"(lo), "v"(hi)); return r; }
typedef float f32x2 __attribute__((ext_vector_type(2)));
__device__ __forceinline__ f32x2 gelu_pk(f32x2 v) {
    const f32x2 av = __builtin_elementwise_abs(v), d = av * 0.2316418882f + 1.0f;
    f32x2 t; t.x = __builtin_amdgcn_rcpf(d.x); t.y = __builtin_amdgcn_rcpf(d.y);
    f32x2 q = t * 0.5307027145f + (-0.7265760135f); q = q * t + 0.7107068705f; q = q * t + (-0.142248368f); q = q * t + 0.127414796f; q = q * t;
    const f32x2 s = (v * v) * (-0.72134752044f);
    f32x2 e; e.x = __builtin_amdgcn_exp2f(s.x); e.y = __builtin_amdgcn_exp2f(s.y);
    const f32x2 m = v * (q * e), r = v - m;
    f32x2 o; o.x = v.x < 0.f ? m.x : r.x; o.y = v.y < 0.f ? m.y : r.y; return o;
}

template <int ACT  > struct EpiBf16 {
    static constexpr bool PERM = true, AFTER_DRAIN = false; static_assert(ACT == 0 || ACT == 1, "EpiBf16: ACT is 0 (none) or 1 (gelu_pk)");
    bf16_t* O; int ldc; const float* bias; int split_cols; size_t split_stride; float scale0;
    __device__ __forceinline__ void operator()(const f32x4 (&acc)[2][2][4][2], const Unit& u, int wr, int wc, int fr, int fq) const {
        const int row0 = u.pm * BM + wr * 64 + fr; int colt = u.pn * BM; bf16_t* base = O;
        float sc = 1.f; if (split_cols) { const int t = colt / split_cols; base += (size_t)t * split_stride; colt -= t * split_cols; if (t == 0) sc = scale0; }
        const int col0 = colt + wc * 32 + 8 * fq, bcol0 = u.pn * BM + wc * 32 + 8 * fq;
        f32x4 bv[2][2];
#pragma unroll
        for (int bj = 0; bj < 2; ++bj)
#pragma unroll
            for (int n = 0; n < 2; ++n) bv[bj][n] = bias ? *(const f32x4*)(bias + bcol0 + bj * HALF + 4 * n) : (f32x4){0.f, 0.f, 0.f, 0.f};
#pragma unroll
        for (int ai = 0; ai < 2; ++ai)
#pragma unroll
            for (int m = 0; m < 4; ++m) { bf16_t* rowp = base + (size_t)(row0 + ai * HALF + m * 16) * ldc + col0;
#pragma unroll
                for (int bj = 0; bj < 2; ++bj) { f32x4 v0 = acc[ai][bj][m][0] + bv[bj][0], v1 = acc[ai][bj][m][1] + bv[bj][1];
                    if (ACT == 1) { f32x2 a = gelu_pk((f32x2){v0[0], v0[1]}), b = gelu_pk((f32x2){v0[2], v0[3]}), c = gelu_pk((f32x2){v1[0], v1[1]}), d = gelu_pk((f32x2){v1[2], v1[3]});
                        v0 = (f32x4){a.x, a.y, b.x, b.y}; v1 = (f32x4){c.x, c.y, d.x, d.y}; }
                    v0 = v0 * sc; v1 = v1 * sc; u32x4 w; w.x = cvt_pk_bf16(v0[0], v0[1]); w.y = cvt_pk_bf16(v0[2], v0[3]); w.z = cvt_pk_bf16(v1[0], v1[1]); w.w = cvt_pk_bf16(v1[2], v1[3]);
                    *(u32x4*)(rowp + bj * HALF) = w; } }
    }
};

struct EpiSwiglu {
    static constexpr bool PERM = true, AFTER_DRAIN = false;
    bf16_t* H; int ldh;
    __device__ __forceinline__ void operator()(const f32x4 (&acc)[2][2][4][2], const Unit& u, int wr, int wc, int fr, int fq) const {
        const int row0 = u.pm * BM + wr * 64 + fr, col0 = u.pn * HALF + wc * 32 + 8 * fq;
#pragma unroll
        for (int ai = 0; ai < 2; ++ai)
#pragma unroll
            for (int m = 0; m < 4; ++m) { bf16_t* rowp = H + (size_t)(row0 + ai * HALF + m * 16) * ldh + col0;
                float hv[8];
#pragma unroll
                for (int n = 0; n < 2; ++n)
#pragma unroll
                    for (int i = 0; i < 4; ++i) { const float g = acc[ai][0][m][n][i], uu = acc[ai][1][m][n][i];
                        const float sg = g * __builtin_amdgcn_rcpf(1.0f + __builtin_amdgcn_exp2f(-1.4426950408889634f * g)); hv[4 * n + i] = sg * uu; }
                u32x4 w; w.x = cvt_pk_bf16(hv[0], hv[1]); w.y = cvt_pk_bf16(hv[2], hv[3]); w.z = cvt_pk_bf16(hv[4], hv[5]); w.w = cvt_pk_bf16(hv[6], hv[7]);
                *(u32x4*)rowp = w; }
    }
};
typedef _Float16 h16x2_t __attribute__((ext_vector_type(2)));
typedef float f32x2s_t __attribute__((ext_vector_type(2)));
__device__ __forceinline__ unsigned pk_h2(float a, float b) { f32x2s_t v = {__builtin_fminf(__builtin_fmaxf(a, -65504.f), 65504.f), __builtin_fminf(__builtin_fmaxf(b, -65504.f), 65504.f)}; h16x2_t h = __builtin_convertvector(v, h16x2_t); return __builtin_bit_cast(unsigned, h); }
__device__ __forceinline__ f32x2s_t up_h2(unsigned w) { h16x2_t h = __builtin_bit_cast(h16x2_t, w); return __builtin_convertvector(h, f32x2s_t); }
__device__ __forceinline__ f32x4 bfx4_lo(const u32x4& w) { const f32x2s_t a = up_h2(w.x), b = up_h2(w.y); return (f32x4){a.x, a.y, b.x, b.y}; }
__device__ __forceinline__ f32x4 bfx4_hi(const u32x4& w) { const f32x2s_t a = up_h2(w.z), b = up_h2(w.w); return (f32x4){a.x, a.y, b.x, b.y}; }
struct EpiResid {
    static constexpr bool PERM = true, AFTER_DRAIN = false;
    const bf16_t* base; bf16_t* out; const float* gate; int gstride; float coef;
    __device__ __forceinline__ void operator()(const f32x4 (&acc)[2][2][4][2], const Unit& u, int wr, int wc, int fr, int fq) const {
        const int row0 = u.pm * BM + wr * 64 + fr, col0 = u.pn * BM + wc * 32 + 8 * fq;
        const float* gp = gate + (size_t)((u.pm * BM) >> 13) * gstride + col0;
        f32x4 gv[2][2];
#pragma unroll
        for (int bj = 0; bj < 2; ++bj)
#pragma unroll
            for (int n = 0; n < 2; ++n) gv[bj][n] = *(const f32x4*)(gp + bj * HALF + 4 * n) * coef;
        u32x4 bwa[2][4][2];
#pragma unroll
        for (int ai = 0; ai < 2; ++ai)
#pragma unroll
            for (int m = 0; m < 4; ++m)
#pragma unroll
                for (int bj = 0; bj < 2; ++bj) bwa[ai][m][bj] = *(const u32x4*)(base + (size_t)(row0 + ai * HALF + m * 16) * 1024 + col0 + bj * HALF);
#pragma unroll
        for (int ai = 0; ai < 2; ++ai)
#pragma unroll
            for (int m = 0; m < 4; ++m) { const size_t off = (size_t)(row0 + ai * HALF + m * 16) * 1024 + col0;
#pragma unroll
                for (int bj = 0; bj < 2; ++bj) { const u32x4 bw = bwa[ai][m][bj];
                    const f32x4 v0 = bfx4_lo(bw) + gv[bj][0] * acc[ai][bj][m][0], v1 = bfx4_hi(bw) + gv[bj][1] * acc[ai][bj][m][1];
                    u32x4 w; w.x = pk_h2(v0[0], v0[1]); w.y = pk_h2(v0[2], v0[3]); w.z = pk_h2(v1[0], v1[1]); w.w = pk_h2(v1[2], v1[3]);
                    *(u32x4*)(out + off + bj * HALF) = w; } }
    }
};
struct OneUnit { int pm, pn;
    __device__ __forceinline__ bool next(int i, Unit& u) const { if (i) return false; u.pm = pm; u.pn = pn; return true; }
    __device__ __forceinline__ void a_ready(const Unit&) const {}
    __device__ __forceinline__ void done(const Unit&) const {} };
struct RmsStats {
    unsigned* xbuf;
    unsigned* cnt;
    float eps;
    __device__ __forceinline__ void run(const f32x4 (&v)[2][2][4][2], const Unit& u, int wr, int wc, int fr, int fq, PG8_LAS unsigned char* lds, int wid, int lane) const {
        PG8_LAS float* P = (PG8_LAS float*)lds;
        PG8_LAS float* S = (PG8_LAS float*)(lds + 8192);
#pragma unroll
        for (int ai = 0; ai < 2; ++ai)
#pragma unroll
            for (int m = 0; m < 4; ++m) { float q = 0.f;
#pragma unroll
                for (int bj = 0; bj < 2; ++bj)
#pragma unroll
                    for (int n = 0; n < 2; ++n) { const f32x4 x = v[ai][bj][m][n]; q += (x[0] * x[0] + x[1] * x[1]) + (x[2] * x[2] + x[3] * x[3]); }
                q = xadd<16>(q); q = xadd<32>(q);
                if (fq == 0) P[(ai * HALF + wr * 64 + m * 16 + fr) * 4 + wc] = q; }
        asm volatile("s_waitcnt lgkmcnt(0)" ::: "memory"); __builtin_amdgcn_s_barrier(); asm volatile("" ::: "memory");
        const int row = wid * 32 + (lane & 31);
        if (lane < 32) { const float s = (P[row * 4 + 0] + P[row * 4 + 1]) + (P[row * 4 + 2] + P[row * 4 + 3]);
            __hip_atomic_store(xbuf + ((size_t)(u.pm * BM + row) * 4 + u.pn), __float_as_uint(s), __ATOMIC_RELAXED, __HIP_MEMORY_SCOPE_AGENT); }
        asm volatile("s_waitcnt vmcnt(0)" ::: "memory");
        if (lane == 0) __hip_atomic_fetch_add(cnt + 64 * u.pm, 1u, __ATOMIC_RELAXED, __HIP_MEMORY_SCOPE_AGENT);
        if (wid == 0) { unsigned sp = 0;
            while ((unsigned)__builtin_amdgcn_readfirstlane(__hip_atomic_load(cnt + 64 * u.pm, __ATOMIC_RELAXED, __HIP_MEMORY_SCOPE_AGENT)) < 32u) { __builtin_amdgcn_s_sleep(2); if (++sp > (1u << 22)) break; }
            __builtin_amdgcn_fence(__ATOMIC_ACQUIRE, "agent"); }
        asm volatile("s_waitcnt vmcnt(0) lgkmcnt(0)" ::: "memory"); __builtin_amdgcn_s_barrier(); asm volatile("" ::: "memory");
        if (lane < 32) { const unsigned* slot = xbuf + (size_t)(u.pm * BM + row) * 4; float t = 0.f;
#pragma unroll
            for (int k = 0; k < 4; ++k) t += __uint_as_float(__hip_atomic_load(slot + k, __ATOMIC_RELAXED, __HIP_MEMORY_SCOPE_AGENT));
            S[row] = __builtin_amdgcn_rsqf(t * (1.0f / 1024.0f) + eps); }
        asm volatile("s_waitcnt lgkmcnt(0)" ::: "memory"); __builtin_amdgcn_s_barrier(); asm volatile("" ::: "memory");
    }
    __device__ __forceinline__ void publish(const f32x4 (&v)[2][2][4][2], const Unit& u, int wr, int wc, int fr, int fq, PG8_LAS unsigned char* lds, int wid, int lane) const {
        PG8_LAS float* P = (PG8_LAS float*)lds;
#pragma unroll
        for (int ai = 0; ai < 2; ++ai)
#pragma unroll
            for (int m = 0; m < 4; ++m) { float q = 0.f;
#pragma unroll
                for (int bj = 0; bj < 2; ++bj)
#pragma unroll
                    for (int n = 0; n < 2; ++n) { const f32x4 x = v[ai][bj][m][n]; q += (x[0] * x[0] + x[1] * x[1]) + (x[2] * x[2] + x[3] * x[3]); }
                q = xadd<16>(q); q = xadd<32>(q);
                if (fq == 0) P[(ai * HALF + wr * 64 + m * 16 + fr) * 4 + wc] = q; }
        asm volatile("s_waitcnt lgkmcnt(0)" ::: "memory"); __builtin_amdgcn_s_barrier(); asm volatile("" ::: "memory");
        const int row = wid * 32 + (lane & 31);
        if (lane < 32) { const float s = (P[row * 4 + 0] + P[row * 4 + 1]) + (P[row * 4 + 2] + P[row * 4 + 3]);
            __hip_atomic_store(xbuf + ((size_t)(u.pm * BM + row) * 4 + u.pn), __float_as_uint(s), __ATOMIC_RELAXED, __HIP_MEMORY_SCOPE_AGENT); }
        asm volatile("s_waitcnt vmcnt(0)" ::: "memory");
        if (lane == 0) __hip_atomic_fetch_add(cnt + 64 * u.pm, 1u, __ATOMIC_RELAXED, __HIP_MEMORY_SCOPE_AGENT);
    }
    __device__ __forceinline__ void collect(const Unit& u, PG8_LAS unsigned char* lds, int wid, int lane) const {
        PG8_LAS float* S = (PG8_LAS float*)(lds + 8192);
        const int row = wid * 32 + (lane & 31);
        if (wid == 0) { unsigned sp = 0;
            while ((unsigned)__builtin_amdgcn_readfirstlane(__hip_atomic_load(cnt + 64 * u.pm, __ATOMIC_RELAXED, __HIP_MEMORY_SCOPE_AGENT)) < 32u) { __builtin_amdgcn_s_sleep(2); if (++sp > (1u << 22)) break; }
            __builtin_amdgcn_fence(__ATOMIC_ACQUIRE, "agent"); }
        asm volatile("s_waitcnt lgkmcnt(0)" ::: "memory"); __builtin_amdgcn_s_barrier(); asm volatile("" ::: "memory");
        if (lane < 32) { const unsigned* slot = xbuf + (size_t)(u.pm * BM + row) * 4; float t = 0.f;
#pragma unroll
            for (int k = 0; k < 4; ++k) t += __uint_as_float(__hip_atomic_load(slot + k, __ATOMIC_RELAXED, __HIP_MEMORY_SCOPE_AGENT));
            S[row] = __builtin_amdgcn_rsqf(t * (1.0f / 1024.0f) + eps); }
        asm volatile("s_waitcnt lgkmcnt(0)" ::: "memory"); __builtin_amdgcn_s_barrier(); asm volatile("" ::: "memory");
    }
};
template <bool BASE_H, bool FIN> struct EpiResidNorm {
    static constexpr bool PERM = true, AFTER_DRAIN = false;
    const void* base; bf16_t* outb; float* outf; const float* gate; int gstride; float coef;
    const float* ng; const float* shift; const float* scale; int mstride; bf16_t* xn; RmsStats st; PG8_LAS unsigned char* tabs;
    __device__ __forceinline__ void operator()(const f32x4 (&acc_c)[2][2][4][2], const Unit& u, int wr, int wc, int fr, int fq) const {
        f32x4 (&acc)[2][2][4][2] = const_cast<f32x4 (&)[2][2][4][2]>(acc_c);
        asm volatile("" : "+v"(fr), "+v"(fq));
        PG8_LAS unsigned char* lds = tabs; const int wid = wr * 4 + wc, lane = fq * 16 + fr;
        const int row0 = u.pm * BM + wr * 64 + fr, col0 = u.pn * BM + wc * 32 + 8 * fq, b = (u.pm * BM) >> 13;
        {   const float* gp = gate + (size_t)b * gstride + col0;
            f32x4 gv[2][2];
#pragma unroll
            for (int bj = 0; bj < 2; ++bj)
#pragma unroll
                for (int n = 0; n < 2; ++n) gv[bj][n] = *(const f32x4*)(gp + bj * HALF + 4 * n) * coef;
            if constexpr (BASE_H) {
                u32x4 bw[2][4][2];
#pragma unroll
                for (int ai = 0; ai < 2; ++ai)
#pragma unroll
                    for (int m = 0; m < 4; ++m)
#pragma unroll
                        for (int bj = 0; bj < 2; ++bj) bw[ai][m][bj] = *(const u32x4*)((const bf16_t*)base + (size_t)(row0 + ai * HALF + m * 16) * 1024 + col0 + bj * HALF);
#pragma unroll
                for (int ai = 0; ai < 2; ++ai)
#pragma unroll
                    for (int m = 0; m < 4; ++m) { const size_t off = (size_t)(row0 + ai * HALF + m * 16) * 1024 + col0;
#pragma unroll
                        for (int bj = 0; bj < 2; ++bj) {
                            acc[ai][bj][m][0] = bfx4_lo(bw[ai][m][bj]) + gv[bj][0] * acc[ai][bj][m][0]; acc[ai][bj][m][1] = bfx4_hi(bw[ai][m][bj]) + gv[bj][1] * acc[ai][bj][m][1];
                        } }
            } else {
#pragma unroll
                for (int ai = 0; ai < 2; ++ai)
#pragma unroll
                    for (int mp = 0; mp < 2; ++mp) { f32x4 bf[2][2][2];
#pragma unroll
                        for (int mm = 0; mm < 2; ++mm)
#pragma unroll
                            for (int bj = 0; bj < 2; ++bj)
#pragma unroll
                                for (int n = 0; n < 2; ++n) bf[mm][bj][n] = *(const f32x4*)((const float*)base + (size_t)(row0 + ai * HALF + (2 * mp + mm) * 16) * 1024 + col0 + bj * HALF + 4 * n);
#pragma unroll
                        for (int mm = 0; mm < 2; ++mm) { const int m = 2 * mp + mm; const size_t off = (size_t)(row0 + ai * HALF + m * 16) * 1024 + col0;
#pragma unroll
                            for (int bj = 0; bj < 2; ++bj) {
                                acc[ai][bj][m][0] = bf[mm][bj][0] + gv[bj][0] * acc[ai][bj][m][0]; acc[ai][bj][m][1] = bf[mm][bj][1] + gv[bj][1] * acc[ai][bj][m][1];
                                if constexpr (!FIN) { const f32x4 v0 = acc[ai][bj][m][0], v1 = acc[ai][bj][m][1];
                                    u32x4 w; w.x = pk_h2(v0[0], v0[1]); w.y = pk_h2(v0[2], v0[3]); w.z = pk_h2(v1[0], v1[1]); w.w = pk_h2(v1[2], v1[3]);
                                    *(u32x4*)(outb + off + bj * HALF) = w; } } }
                        asm volatile("" ::: "memory"); }
            } }
        if constexpr (BASE_H) {
            st.publish(acc, u, wr, wc, fr, fq, lds, wid, lane);
            if constexpr (!FIN) {
#pragma unroll
                for (int ai = 0; ai < 2; ++ai)
#pragma unroll
                    for (int m = 0; m < 4; ++m) { const size_t off = (size_t)(row0 + ai * HALF + m * 16) * 1024 + col0;
#pragma unroll
                        for (int bj = 0; bj < 2; ++bj) { const f32x4 v0 = acc[ai][bj][m][0], v1 = acc[ai][bj][m][1];
                            u32x4 w; w.x = pk_h2(v0[0], v0[1]); w.y = pk_h2(v0[2], v0[3]); w.z = pk_h2(v1[0], v1[1]); w.w = pk_h2(v1[2], v1[3]);
                            *(u32x4*)(outb + off + bj * HALF) = w; } } }
            st.collect(u, lds, wid, lane);
        } else st.run(acc, u, wr, wc, fr, fq, lds, wid, lane);
        const PG8_LAS float* S = (const PG8_LAS float*)(lds + 8192);
        f32x4 gm[2][2], sh[2][2];
#pragma unroll
        for (int bj = 0; bj < 2; ++bj)
#pragma unroll
            for (int n = 0; n < 2; ++n) { const int c = col0 + bj * HALF + 4 * n; const f32x4 g = *(const f32x4*)(ng + c);
                if constexpr (FIN) { gm[bj][n] = g; sh[bj][n] = (f32x4){0.f, 0.f, 0.f, 0.f}; }
                else { gm[bj][n] = g * (*(const f32x4*)(scale + (size_t)b * mstride + c) + 1.0f); sh[bj][n] = *(const f32x4*)(shift + (size_t)b * mstride + c); } }
#pragma unroll
        for (int ai = 0; ai < 2; ++ai)
#pragma unroll
            for (int m = 0; m < 4; ++m) { const int r = ai * HALF + wr * 64 + m * 16 + fr; const float rs = S[r]; const size_t off = (size_t)(u.pm * BM + r) * 1024 + col0;
                if constexpr (FIN) {
#pragma unroll
                    for (int bj = 0; bj < 2; ++bj)
#pragma unroll
                        for (int n = 0; n < 2; ++n) *(f32x4*)(outf + off + bj * HALF + 4 * n) = acc[ai][bj][m][n] * rs * gm[bj][n];
                } else {
#pragma unroll
                    for (int bj = 0; bj < 2; ++bj) { const f32x4 v0 = acc[ai][bj][m][0] * rs * gm[bj][0] + sh[bj][0], v1 = acc[ai][bj][m][1] * rs * gm[bj][1] + sh[bj][1];
                        u32x4 w; w.x = cvt_pk_bf16(v0[0], v0[1]); w.y = cvt_pk_bf16(v0[2], v0[3]); w.z = cvt_pk_bf16(v1[0], v1[1]); w.w = cvt_pk_bf16(v1[2], v1[3]);
                        *(u32x4*)(xn + off + bj * HALF) = w; } } }
    }
};
template <class Epi, class Sched, bool ALIGN_EPI = false, bool SP2 = false>
__device__ __forceinline__ void gemm_phase(PG8_LAS unsigned char* lds, const Gemm g, const Sched& S, const Epi& E, const int tid_in) {
    int tid = tid_in; asm volatile("" : "+v"(tid));
    const int wid = __builtin_amdgcn_readfirstlane(tid >> 6), lane = tid & 63, wr = wid >> 2, wc = wid & 3, fr = lane & 15, fq = lane >> 4;
    const int K = g.K, nt = K / BK;
    unsigned voffA[2], voffB[2];
#pragma unroll
    for (int i = 0; i < 2; ++i) { int R, C; stage_rc(tid * 16 + i * 8192, R, C); const int Rb = Epi::PERM ? ((R & ~31) + perm32(R & 31)) : R;
        voffA[i] = (unsigned)(R * K + C) * 2u; voffB[i] = (unsigned)(Rb * K + C) * 2u; }
    const size_t kstep = (size_t)(BK * 2);
    const size_t hstep = (size_t)HALF * K * 2;
    const size_t tstep = 2 * hstep;
    const unsigned ldsw = (unsigned)wid * 1024u;
    const int aoff = lds_byte(wr * 64 + fr, fq * 8), boff = lds_byte(wc * 32 + fr, fq * 8);
#define PG8_SA(b, h) (((b) * 2 + (h)) * HTB)
#define PG8_SB(b, h) ((4 + (b) * 2 + (h)) * HTB)
#define PG8_STAGE(bufoff, gbase, voff) do { _Pragma("unroll") for (int _i = 0; _i < 2; ++_i) \
        __builtin_amdgcn_global_load_lds((const unsigned*)((const char*)(gbase) + (voff)[_i]), (PG8_LAS unsigned*)(lds + (bufoff) + ldsw + _i * 8192), 16, 0, 0); } while (0)
#define PG8_LDA(dst, b, h) do { _Pragma("unroll") for (int m = 0; m < 4; ++m) _Pragma("unroll") for (int k = 0; k < 2; ++k) dst[m][k] = *(const PG8_LAS bf16x8*)(lds + PG8_SA(b, h) + aoff + m * 2048 + k * 1024); } while (0)
#define PG8_LDB(dst, b, h) do { _Pragma("unroll") for (int n = 0; n < 2; ++n) _Pragma("unroll") for (int k = 0; k < 2; ++k) dst[n][k] = *(const PG8_LAS bf16x8*)(lds + PG8_SB(b, h) + boff + n * 2048 + k * 1024); } while (0)
#define PG8_MMA(ai, bj, At, Bt) do { __builtin_amdgcn_s_setprio(1); _Pragma("unroll") for (int m = 0; m < 4; ++m) _Pragma("unroll") for (int n = 0; n < 2; ++n) _Pragma("unroll") for (int k = 0; k < 2; ++k) \
        acc[ai][bj][m][n] = __builtin_amdgcn_mfma_f32_16x16x32_bf16(Bt[n][k], At[m][k], acc[ai][bj][m][n], 0, 0, 0); __builtin_amdgcn_s_setprio(0); } while (0)
#define PG8_WAIT_V(n) asm volatile("s_waitcnt vmcnt(" #n ")" ::: "memory")
#define PG8_WAIT_L(n) asm volatile("s_waitcnt lgkmcnt(" #n ")" ::: "memory")
#define PG8_BAR __builtin_amdgcn_s_barrier()
#define PG8_SCHED __builtin_amdgcn_sched_barrier(0)
    Unit cur, nxt; int ui = 0;
    if (!S.next(0, cur)) return;
    f32x4 acc[2][2][4][2];
#pragma unroll
    for (int a = 0; a < 2; ++a)
#pragma unroll
        for (int b = 0; b < 2; ++b)
#pragma unroll
            for (int m = 0; m < 4; ++m)
#pragma unroll
                for (int n = 0; n < 2; ++n) acc[a][b][m][n] = (f32x4){0.f, 0.f, 0.f, 0.f};
    bf16x8 At[4][2], B0[2][2], B1[2][2];
    const char* cA = (const char*)g.A + (size_t)cur.pm * tstep; const char* cB = (const char*)g.Bt + (size_t)cur.pn * tstep;
    S.a_ready(cur);
    if constexpr (SP2) {
        PG8_STAGE(PG8_SB(0, 0), cB, voffB); PG8_STAGE(PG8_SB(0, 1), cB + hstep, voffB); PG8_STAGE(PG8_SA(0, 0), cA, voffA); PG8_STAGE(PG8_SA(0, 1), cA + hstep, voffA);
        if (wr == 1) PG8_BAR;
        PG8_WAIT_V(2); PG8_BAR;
        PG8_STAGE(PG8_SB(1, 0), cB + kstep, voffB); PG8_STAGE(PG8_SA(1, 0), cA + kstep, voffA); PG8_STAGE(PG8_SB(1, 1), cB + hstep + kstep, voffB);
        PG8_WAIT_V(6); PG8_BAR;
    } else {
        PG8_STAGE(PG8_SB(0, 0), cB, voffB); PG8_STAGE(PG8_SA(0, 0), cA, voffA); PG8_STAGE(PG8_SB(0, 1), cB + hstep, voffB); PG8_STAGE(PG8_SA(0, 1), cA + hstep, voffA);
        if (wr == 1) PG8_BAR;
        PG8_WAIT_V(4); PG8_BAR;
        PG8_STAGE(PG8_SB(1, 0), cB + kstep, voffB); PG8_STAGE(PG8_SA(1, 0), cA + kstep, voffA); PG8_STAGE(PG8_SB(1, 1), cB + hstep + kstep, voffB);
        PG8_WAIT_V(6); PG8_BAR;
    }
    for (;;) {
        const bool has_next = S.next(ui + 1, nxt);
        const char* nA = has_next ? (const char*)g.A + (size_t)nxt.pm * tstep : cA; const char* nB = has_next ? (const char*)g.Bt + (size_t)nxt.pn * tstep : cB;
        for (int t = 0; t < nt; t += 2) {
            const bool last = (t == nt - 2);
            const char* a1 = cA + (size_t)(t + 1) * kstep;
            const char* a2 = last ? nA : cA + (size_t)(t + 2) * kstep; const char* b2 = last ? nB : cB + (size_t)(t + 2) * kstep;
            const char* a3 = a2 + kstep; const char* b3 = b2 + kstep;
            if (last && has_next) S.a_ready(nxt);
            if constexpr (SP2) {
            PG8_LDB(B0, 0, 0); PG8_LDB(B1, 0, 1); PG8_SCHED; PG8_LDA(At, 0, 0); PG8_STAGE(PG8_SA(1, 1), a1 + hstep, voffA);
            PG8_WAIT_V(8); PG8_WAIT_L(0); PG8_BAR; PG8_MMA(0, 0, At, B0); PG8_MMA(0, 1, At, B1); PG8_BAR; PG8_SCHED;
            PG8_LDA(At, 0, 1); PG8_STAGE(PG8_SB(0, 0), b2, voffB); PG8_STAGE(PG8_SB(0, 1), b2 + hstep, voffB); PG8_STAGE(PG8_SA(0, 0), a2, voffA);
            PG8_WAIT_V(8); PG8_WAIT_L(0); PG8_BAR; PG8_MMA(1, 0, At, B0); PG8_MMA(1, 1, At, B1); PG8_BAR; PG8_SCHED;
            PG8_LDB(B0, 1, 0); PG8_LDB(B1, 1, 1); PG8_SCHED; PG8_LDA(At, 1, 0); PG8_STAGE(PG8_SA(0, 1), a2 + hstep, voffA);
            PG8_WAIT_V(8); PG8_WAIT_L(0); PG8_BAR; PG8_MMA(0, 0, At, B0); PG8_MMA(0, 1, At, B1); PG8_BAR; PG8_SCHED;
            PG8_LDA(At, 1, 1); PG8_STAGE(PG8_SB(1, 0), b3, voffB); PG8_STAGE(PG8_SB(1, 1), b3 + hstep, voffB); PG8_STAGE(PG8_SA(1, 0), a3, voffA);
            PG8_WAIT_V(8); PG8_WAIT_L(0); PG8_BAR; PG8_MMA(1, 0, At, B0); PG8_MMA(1, 1, At, B1); PG8_BAR; PG8_SCHED;
            } else {
            PG8_LDB(B0, 0, 0); PG8_SCHED; PG8_LDA(At, 0, 0); PG8_STAGE(PG8_SA(1, 1), a1 + hstep, voffA);
            PG8_WAIT_L(8); PG8_BAR; PG8_WAIT_L(0); PG8_MMA(0, 0, At, B0); PG8_BAR; PG8_SCHED;
            PG8_LDB(B1, 0, 1); PG8_STAGE(PG8_SB(0, 0), b2, voffB);
            PG8_BAR; PG8_WAIT_L(0); PG8_MMA(0, 1, At, B1); PG8_BAR;
            PG8_LDA(At, 0, 1); PG8_STAGE(PG8_SA(0, 0), a2, voffA);
            PG8_BAR; PG8_WAIT_L(0); PG8_MMA(1, 0, At, B0); PG8_BAR; PG8_SCHED;
            PG8_STAGE(PG8_SB(0, 1), b2 + hstep, voffB);
            PG8_WAIT_V(6); PG8_BAR; PG8_MMA(1, 1, At, B1); PG8_BAR;
            PG8_LDB(B0, 1, 0); PG8_SCHED; PG8_LDA(At, 1, 0); PG8_STAGE(PG8_SA(0, 1), a2 + hstep, voffA);
            PG8_WAIT_L(8); PG8_BAR; PG8_WAIT_L(0); PG8_MMA(0, 0, At, B0); PG8_BAR; PG8_SCHED;
            PG8_LDB(B1, 1, 1); PG8_STAGE(PG8_SB(1, 0), b3, voffB);
            PG8_BAR; PG8_WAIT_L(0); PG8_MMA(0, 1, At, B1); PG8_BAR;
            PG8_LDA(At, 1, 1); PG8_STAGE(PG8_SA(1, 0), a3, voffA);
            PG8_BAR; PG8_WAIT_L(0); PG8_MMA(1, 0, At, B0); PG8_BAR; PG8_SCHED;
            PG8_STAGE(PG8_SB(1, 1), b3 + hstep, voffB);
            PG8_WAIT_V(6); PG8_BAR; PG8_MMA(1, 1, At, B1); PG8_BAR;
            }
        }
        if constexpr (ALIGN_EPI) { if (wr == 0) PG8_BAR; }
        if constexpr (!Epi::AFTER_DRAIN) { E(acc, cur, wr, wc, fr, fq); S.done(cur); }
        if (!has_next) break;
#pragma unroll
        for (int a = 0; a < 2; ++a)
#pragma unroll
            for (int b = 0; b < 2; ++b)
#pragma unroll
                for (int m = 0; m < 4; ++m)
#pragma unroll
                    for (int n = 0; n < 2; ++n) acc[a][b][m][n] = (f32x4){0.f, 0.f, 0.f, 0.f};
        cur = nxt; cA = nA; cB = nB; ++ui;
        if constexpr (ALIGN_EPI) { if (wr == 1) PG8_BAR; }
    }
    PG8_WAIT_V(0);
    if constexpr (!ALIGN_EPI) { if (wr == 0) PG8_BAR; }
    PG8_BAR;
    if constexpr (Epi::AFTER_DRAIN) { E.fused(acc, cur, wr, wc, fr, fq, lds, wid, lane); S.done(cur); }
#undef PG8_SA
#undef PG8_SB
#undef PG8_STAGE
#undef PG8_LDA
#undef PG8_LDB
#undef PG8_MMA
#undef PG8_WAIT_V
#undef PG8_WAIT_L
#undef PG8_BAR
#undef PG8_SCHED
}
}

#ifndef PG8_SP2
#define PG8_SP2 true
#endif
#ifndef PG8_ALIGN
#define PG8_ALIGN true
#endif
#include <hip/hip_bf16.h>
#include <cmath>
namespace attn_body {
using bf16=__hip_bfloat16;
using bf16x8=__attribute__((ext_vector_type(8)))short;
using s16x4=__attribute__((ext_vector_type(4)))short;
using f32x16=__attribute__((ext_vector_type(16)))float;
using u32x4=__attribute__((ext_vector_type(4)))unsigned;
constexpr int BATCH=4,NHEAD=16,SEQ=8192,D=64,DM=NHEAD*D;
constexpr int NW=8,QBLK=32,QB=QBLK*NW,KVBLK=64,NQB=SEQ/QB;
constexpr int ATTN_PITCH=DM, ATTN_UNIT_ROWS=QB;
__device__ __forceinline__ int crow(int r,int hi){return (r&3)+8*(r>>2)+4*hi;}
#define SBAR() __builtin_amdgcn_sched_barrier(0)
__device__ __forceinline__ void cmask(f32x16&p0,f32x16&p1,int jb,int qrel,int hi){
  const float NEG=-INFINITY; int kb=64*jb+4*hi;
  #pragma unroll
  for(int r=0;r<16;++r){int kv=kb+(r&3)+8*(r>>2); if(kv>qrel)p0[r]=NEG; if(kv+32>qrel)p1[r]=NEG;}
}


typedef float f32x4v __attribute__((ext_vector_type(4)));
#define ALAS __attribute__((address_space(3)))
__device__ __forceinline__ void biasmask(f32x16&p0,f32x16&p1,int jb,int qrel,int hi,const ALAS float*tab){
  const int nb=qrel-64*jb-4*hi;
  #pragma unroll
  for(int r=0;r<16;++r){ const int n0=nb-((r&3)+8*(r>>2)); int i0=n0<-1?-1:n0; i0=(i0>128?128:i0)+1; int i1=n0-32; i1=i1<-1?-1:i1; i1=(i1>128?128:i1)+1; p0[r]+=tab[i0]; p1[r]+=tab[i1]; }
}
constexpr int NSLOT=3, SLOTB=8192;
constexpr int LDS_K=0, LDS_V=NSLOT*SLOTB, LDS_WS=2*NSLOT*SLOTB, LDS_OST=LDS_WS+NW*64*4, LDS_BYTES=LDS_OST+NW*4096;
constexpr float C2=0.125f*1.4426950408889634f;
__device__ __forceinline__ void glds16(const void*gsrc,unsigned lds_dst){unsigned keep;
  asm volatile("s_mov_b32 %0, m0\n\ts_mov_b32 m0, %2\n\ts_nop 0\n\tglobal_load_lds_dwordx4 %1, off\n\ts_mov_b32 m0, %0":"=&s"(keep):"v"(gsrc),"s"(lds_dst):"memory");}
__device__ __forceinline__ float max3f(float a,float b,float c){float r;asm("v_max3_f32 %0, %1, %2, %3":"=v"(r):"v"(a),"v"(b),"v"(c));return r;}
__device__ __forceinline__ float max2f(float a,float b){float r;asm("v_max_f32_e32 %0, %1, %2":"=v"(r):"v"(a),"v"(b));return r;}
__device__ __forceinline__ float fadd_s(float a,float b){float r;asm("v_add_f32_e32 %0, %1, %2":"=v"(r):"v"(a),"v"(b));return r;}
__device__ __forceinline__ float fsub_s(float a,float b){float r;asm("v_sub_f32_e32 %0, %1, %2":"=v"(r):"v"(a),"v"(b));return r;}
typedef float f32x2_t __attribute__((ext_vector_type(2))); typedef __bf16 bf16x2_t __attribute__((ext_vector_type(2)));
__device__ __forceinline__ unsigned cvtpk_s(float lo,float hi){f32x2_t v={lo,hi};bf16x2_t b=__builtin_convertvector(v,bf16x2_t);return __builtin_bit_cast(unsigned,b);}
#define WAIT_BAR(N) asm volatile("s_waitcnt vmcnt(" #N ") lgkmcnt(0)\n\ts_barrier":::"memory")

__device__ __forceinline__ void qkt(f32x16&p0,f32x16&p1,const char*Kslot,const bf16x8*qr,const f32x16&negm,int r32,int hi){
  const char*kb=Kslot+hi*1024+r32*16;
  #pragma unroll
  for(int d0=0;d0<4;++d0){
    const bf16x8 b0=*reinterpret_cast<const bf16x8*>(kb+d0*2048);
    const bf16x8 b1=*reinterpret_cast<const bf16x8*>(kb+d0*2048+512);
    if(d0==0){p0=__builtin_amdgcn_mfma_f32_32x32x16_bf16(b0,qr[0],negm,0,0,0);p1=__builtin_amdgcn_mfma_f32_32x32x16_bf16(b1,qr[0],negm,0,0,0);}
    else{p0=__builtin_amdgcn_mfma_f32_32x32x16_bf16(b0,qr[d0],p0,0,0,0);p1=__builtin_amdgcn_mfma_f32_32x32x16_bf16(b1,qr[d0],p1,0,0,0);}}
}
typedef __attribute__((address_space(3))) const char* lds_cptr;
typedef short v4i16_t __attribute__((ext_vector_type(4)));
__device__ __forceinline__ void kload8(bf16x8*kf,lds_cptr kp){
  kf[0]=*(const __attribute__((address_space(3))) bf16x8*)(kp);      kf[1]=*(const __attribute__((address_space(3))) bf16x8*)(kp+512);
  kf[2]=*(const __attribute__((address_space(3))) bf16x8*)(kp+2048); kf[3]=*(const __attribute__((address_space(3))) bf16x8*)(kp+2560);
  kf[4]=*(const __attribute__((address_space(3))) bf16x8*)(kp+4096); kf[5]=*(const __attribute__((address_space(3))) bf16x8*)(kp+4608);
  kf[6]=*(const __attribute__((address_space(3))) bf16x8*)(kp+6144); kf[7]=*(const __attribute__((address_space(3))) bf16x8*)(kp+6656);
}
__device__ __forceinline__ void kload2(bf16x8*kf,lds_cptr kp,int j){ kf[2*j]=*(const __attribute__((address_space(3))) bf16x8*)(kp+j*2048); kf[2*j+1]=*(const __attribute__((address_space(3))) bf16x8*)(kp+j*2048+512); }
__device__ __forceinline__ s16x4 vtr(lds_cptr p){ return __builtin_bit_cast(s16x4,__builtin_amdgcn_ds_read_tr16_b64_v4i16((__attribute__((address_space(3))) v4i16_t*)p)); }
__device__ __forceinline__ float rowmax(const f32x16&p0,const f32x16&p1){
  float a=max3f(p0[0],p0[1],p1[0]),b=max3f(p0[2],p0[3],p1[1]);a=max3f(a,p1[2],p1[3]);
  #pragma unroll
  for(int r=4;r<16;r+=4){a=max3f(a,p0[r],p0[r+1]);b=max3f(b,p0[r+2],p0[r+3]);a=max3f(a,p1[r],p1[r+1]);b=max3f(b,p1[r+2],p1[r+3]);}
  const float m=max2f(a,b);
  auto rr=__builtin_amdgcn_permlane32_swap(__float_as_uint(m),__float_as_uint(m),false,false);
  return max2f(__uint_as_float(rr[0]),__uint_as_float(rr[1]));
}
__device__ __forceinline__ void pv(f32x16*o,int vb,bf16x8 pa0,bf16x8 pa1,bf16x8 pa2,bf16x8 pa3){
  #pragma unroll
  for(int d0=0;d0<2;++d0){s16x4 lo[4],hi[4];
    #pragma unroll
    for(int ks=0;ks<4;++ks){
      asm volatile("ds_read_b64_tr_b16 %0,%1 offset:%c2":"=&v"(lo[ks]):"v"(vb),"i"(d0*4096+ks*1024):"memory");
      asm volatile("ds_read_b64_tr_b16 %0,%1 offset:%c2":"=&v"(hi[ks]):"v"(vb),"i"(d0*4096+ks*1024+512):"memory");}
    asm volatile("s_waitcnt lgkmcnt(0)":::"memory");SBAR();
    #define PK(k) (bf16x8){lo[k][0],lo[k][1],lo[k][2],lo[k][3],hi[k][0],hi[k][1],hi[k][2],hi[k][3]}
    o[d0]=__builtin_amdgcn_mfma_f32_32x32x16_bf16(pa0,PK(0),o[d0],0,0,0);
    o[d0]=__builtin_amdgcn_mfma_f32_32x32x16_bf16(pa1,PK(1),o[d0],0,0,0);
    o[d0]=__builtin_amdgcn_mfma_f32_32x32x16_bf16(pa2,PK(2),o[d0],0,0,0);
    o[d0]=__builtin_amdgcn_mfma_f32_32x32x16_bf16(pa3,PK(3),o[d0],0,0,0);
    #undef PK
  }
}

#ifndef ATTN_STORE16
#define ATTN_STORE16(p,v) (*(u32x4*)(p)=(v))
#endif
template<int THRL,int MODE> __device__ __forceinline__ void attn_unit(int b,int qc,int kc,int vc,int oc,int qb,const bf16*Q,const bf16*__restrict__ K,const bf16*__restrict__ V,bf16*O,char*shm,const float*aux,int hidx,const float*kpart,int npart,const int tid_in){
  int tid=tid_in; asm volatile("":"+v"(tid));
  const int lane=tid&63,r32=lane&31,hi=lane>>5; const int wid=__builtin_amdgcn_readfirstlane(tid>>6);
  const long rowbase=(long)b*SEQ; const int q0=qb*QB;
  const bf16*Qw=Q+(rowbase+q0+wid*QBLK)*DM+qc;
  const bf16*Kh=K+rowbase*DM+kc; const bf16*Vh=V+rowbase*DM+vc;
  const unsigned lds0=(unsigned)(uintptr_t)shm;
  float*wsf=(float*)(shm+LDS_WS)+wid*64;
  int tskip=0; float mfix=0.f;
  if(MODE==1){
    bf16x8 qv[4];
    #pragma unroll
    for(int d0=0;d0<4;++d0) qv[d0]=*reinterpret_cast<const bf16x8*>(&Qw[(long)r32*DM+d0*16+hi*8]);
    float kmv[4];
    #pragma unroll
    for(int j=0;j<4;++j){ const int i=lane+64*j; kmv[j]=(i<npart)?kpart[(long)i*64]:0.f; }
    const int NT0=(q0+QB)/KVBLK;
    const float a_q0=aux[q0], a_row=aux[q0+wid*QBLK+r32], a_t0=aux[64*lane+63], a_t1=aux[64*(lane+64)+63];
    const int n4=(q0+QB)>>2; f32x4v tv[4];
    #pragma unroll
    for(int j=0;j<4;++j){ const int i=tid+512*j; if(i<n4) tv[j]=((const f32x4v*)aux)[i]; }
    float km=fmaxf(fmaxf(kmv[0],kmv[1]),fmaxf(kmv[2],kmv[3]));
    for(int i=lane+256;i<npart;i+=64) km=fmaxf(km,kpart[(long)i*64]);
    float ss=0.f;
    #pragma unroll
    for(int d0=0;d0<4;++d0){
      #pragma unroll
      for(int e=0;e<8;++e){ const float f=__uint_as_float(((unsigned)(unsigned short)qv[d0][e])<<16); ss+=f*f; } }
    { auto rr=__builtin_amdgcn_permlane32_swap(__float_as_uint(ss),__float_as_uint(ss),false,false); ss=__uint_as_float(rr[0])+__uint_as_float(rr[1]); }
    const float ssrow=ss;
    ss=wave_max32(ss);
    km=wave_max64(km);
    ALAS float*wsl=(ALAS float*)((__attribute__((address_space(3))) char*)shm+LDS_WS);
    if(lane==0)wsl[wid*64]=ss;
    { ALAS f32x4v*tabw=(ALAS f32x4v*)((__attribute__((address_space(3))) char*)shm+LDS_BYTES);
      #pragma unroll
      for(int j=0;j<4;++j){ const int i=tid+512*j; if(i<n4) tabw[i]=tv[j]; } }
    asm volatile("s_waitcnt lgkmcnt(0)\n\ts_barrier":::"memory");
    float qm=wsl[0];
    #pragma unroll
    for(int w=1;w<NW;++w)qm=fmaxf(qm,wsl[w*64]);
    const float smax2=2.f*(__builtin_amdgcn_sqrtf(qm*km)*1.01f+1.f);
    const float thr=a_q0-160.f-smax2;
    mfix=a_row+(__builtin_amdgcn_sqrtf(ssrow*km)*1.01f+1.f);
    const bool sk0=(lane<NT0-6)&&(a_t0<thr);
    const bool sk1=(lane+64<NT0-6)&&(a_t1<thr);
    const unsigned long long m0=~__ballot(sk0), m1=~__ballot(sk1);
    const int nlead=m0?__builtin_ctzll(m0):64+(m1?__builtin_ctzll(m1):64);
    tskip=__builtin_amdgcn_readfirstlane(nlead&~1);
    Kh+=(long)tskip*KVBLK*DM; Vh+=(long)tskip*KVBLK*DM;
  }
  const bf16*ksrc=Kh+(long)lane*DM+wid*8;
  const bf16*vsrc=Vh+(long)(16*(wid&3)+(lane>>2))*DM+(wid>>2)*32+(lane&3)*8;
  const unsigned kdst=lds0+LDS_K+wid*1024, vdst=lds0+LDS_V+wid*1024;
  #define DMA_K(t,slot) glds16(ksrc+(long)(t)*KVBLK*DM,(unsigned)__builtin_amdgcn_readfirstlane(kdst+(slot)))
  #define DMA_V(t,slot) glds16(vsrc+(long)(t)*KVBLK*DM,(unsigned)__builtin_amdgcn_readfirstlane(vdst+(slot)))
  const int vb0=(int)(lds0+LDS_V)+((lane>>4)&1)*32+(lane&3)*8+(4*hi+((lane&15)>>2))*64;
  const char*Kbase=shm+LDS_K; bf16x8 kf[8];
  const lds_cptr shm3=(lds_cptr)shm; const lds_cptr kp0=shm3+LDS_K+hi*1024+r32*16; const lds_cptr vp0=shm3+LDS_V+((lane>>4)&1)*32+(lane&3)*8+(4*hi+((lane&15)>>2))*64;
  const int NT=(q0+QB)/KVBLK-tskip;
  const ALAS float*tab3=(const ALAS float*)(shm3+LDS_BYTES);
  { ALAS float*tabf=(ALAS float*)(shm3+LDS_BYTES);
    if(MODE==0){ if(tid<130){ float v; if(tid==0)v=-INFINITY; else if(tid==129)v=0.f; else{ const int n=tid-1; int bk; if(n<16)bk=n; else{ const int lg=16+(int)(__builtin_amdgcn_logf((float)n*0.0625f)*(16.0f/3.0f));     bk=lg<31?lg:31; } v=(aux[bk*8+hidx]-aux[31*8+hidx])*1.4426950408889634f; } tabf[tid]=v; } }
    asm volatile("s_waitcnt vmcnt(0) lgkmcnt(0)":::"memory"); }
  DMA_K(0,0);DMA_V(0,0);DMA_K(1,SLOTB);
  bf16x8 qr[4];
  #pragma unroll
  for(int d0=0;d0<4;++d0)qr[d0]=*reinterpret_cast<const bf16x8*>(&Qw[(long)r32*DM+d0*16+hi*8]);
  float mhat=(MODE==1)?mfix:0.f,l_reg=0.f;f32x16 o[2];o[0]=f32x16{};o[1]=f32x16{};f32x16 negm=f32x16{};asm volatile("":"+v"(negm));
  const f32x16 zero16=f32x16{};
  #define CIN ((MODE==1)?zero16:negm)
  const int qrel=wid*QBLK+r32;
  #define CMASK(P0,P1,t) do{int jb_=(t)-(NT-4); if(MODE==1){ if(jb_>=0)cmask(P0,P1,jb_,qrel,hi); } else { if(jb_>=-2)biasmask(P0,P1,jb_,qrel,hi,tab3); } }while(0)
  #define FADD(P0,P1,t) do{ if(MODE==1){ const ALAS f32x4v*fp_=(const ALAS f32x4v*)(shm3+LDS_BYTES)+(16*((t)+tskip)+hi); \
    _Pragma("unroll") for(int g_=0;g_<4;++g_){ const f32x4v a_=fp_[2*g_]-mhat, b_=fp_[8+2*g_]-mhat; \
      P0[4*g_]+=a_[0];P0[4*g_+1]+=a_[1];P0[4*g_+2]+=a_[2];P0[4*g_+3]+=a_[3]; P1[4*g_]+=b_[0];P1[4*g_+1]+=b_[1];P1[4*g_+2]+=b_[2];P1[4*g_+3]+=b_[3]; } } }while(0)
  bool resc=false;
  #define START(P0,P1) do{ resc=false; if(MODE==1){ \
      _Pragma("unroll") for(int r=0;r<16;++r)P0[r]=__builtin_amdgcn_exp2f(P0[r]); } else { const float rm=rowmax(P0,P1); \
    { const float dl=rm; mhat=fadd_s(mhat,dl); \
      _Pragma("unroll") for(int r=0;r<16;++r){P0[r]=fsub_s(P0[r],dl);P1[r]=fsub_s(P1[r],dl);} \
      _Pragma("unroll") for(int r=0;r<16;++r)negm[r]=-mhat; asm volatile("":"+v"(negm)); } \
    _Pragma("unroll") for(int r=0;r<16;++r)P0[r]=__builtin_amdgcn_exp2f(P0[r]); } }while(0)
  #define RESC() do{ if(resc){ asm volatile("s_waitcnt lgkmcnt(0)":::"memory"); \
      _Pragma("unroll") for(int d_=0;d_<2;++d_) _Pragma("unroll") for(int r=0;r<16;++r)o[d_][r]*=wsf[crow(r,hi)]; } }while(0)
  f32x16 pA0,pA1,pB0,pB1;
  int sl_prev=0,sl_cur=0,sl_next=SLOTB;
  #define ROT() do{sl_prev=sl_cur;sl_cur=sl_next;sl_next=(sl_next==(NSLOT-1)*SLOTB)?0:sl_next+SLOTB;}while(0)
  DMA_K(2,2*SLOTB);
  WAIT_BAR(3);
  qkt(pA0,pA1,Kbase,qr,CIN,r32,hi);asm volatile("s_nop 15\n\ts_nop 7":"+v"(pA0),"+v"(pA1));FADD(pA0,pA1,0);CMASK(pA0,pA1,0);
  START(pA0,pA1);
  _Pragma("unroll") for(int r=0;r<16;++r)pA1[r]=__builtin_amdgcn_exp2f(pA1[r]);
  WAIT_BAR(0);
  DMA_K(3,0);DMA_V(1,SLOTB);
  ROT();
  kload8(kf,kp0+sl_cur);
  WAIT_BAR(2);
  s16x4 vlo[8],vhi[8]; u32x4 pw0,pw1,pw2,pw3;
  #define PKW(P,B) cvtpk_s(P[B],P[B+1])
  #define PAF(k) __builtin_bit_cast(bf16x8,pw##k)
  #define VFR(i) (bf16x8){vlo[i][0],vlo[i][1],vlo[i][2],vlo[i][3],vhi[i][0],vhi[i][1],vhi[i][2],vhi[i][3]}
  #define PIN(x) asm volatile("":"+v"(x))
  #define MX3(a,b,c) __builtin_fmaxf(__builtin_fmaxf((a),(b)),(c))
  #define GAPA(MF,A0,A1,A2,A3,W0,W1,PW) do{ MF; sacc+=A0; sacc+=A1; sacc+=A2; sacc+=A3; PIN(sacc); W0; W1; PIN(PW); SBAR(); }while(0)
  #define EX(v) __builtin_amdgcn_exp2f(v)
  #define GAPB(MF,X,B) do{ MF; X[B]=EX(X[B]); X[B+1]=EX(X[B+1]); X[B+2]=EX(X[B+2]); X[B+3]=EX(X[B+3]); PIN(X); SBAR(); }while(0)
  #define VRD(i) do{ vlo[i]=vtr(vp_+(((i)>>2)*4096+((i)&3)*1024)); vhi[i]=vtr(vp_+(((i)>>2)*4096+((i)&3)*1024+512)); }while(0)
  #define KRD(G,j) do{ if(G){ kload2(kf,kp0+sl_next,j); SBAR(); } }while(0)
  #define STEP(C0,C1,P0,P1,t,GK,GV,GL) do{ SBAR(); \
    const lds_cptr vp_=vp0+sl_prev; \
    VRD(0); SBAR(); float sacc=(P0[0]+P0[1]); \
    GAPA(C0=__builtin_amdgcn_mfma_f32_32x32x16_bf16(kf[0],qr[0],CIN,0,0,0), P0[2],P0[3],P0[4],P0[5],     pw0[0]=PKW(P0,0), pw0[1]=PKW(P0,2), pw0); \
    VRD(4); SBAR(); GAPA(C1=__builtin_amdgcn_mfma_f32_32x32x16_bf16(kf[1],qr[0],CIN,0,0,0), P0[6],P0[7],P0[8],P0[9],     pw0[2]=PKW(P0,4), pw0[3]=PKW(P0,6), pw0); \
    VRD(1); SBAR(); GAPA(C0=__builtin_amdgcn_mfma_f32_32x32x16_bf16(kf[2],qr[1],C0,0,0,0),   P0[10],P0[11],P0[12],P0[13], pw1[0]=PKW(P0,8), pw1[1]=PKW(P0,10), pw1); \
    VRD(5); SBAR(); GAPA(C1=__builtin_amdgcn_mfma_f32_32x32x16_bf16(kf[3],qr[1],C1,0,0,0),   P0[14],P0[15],P1[0],P1[1],   pw1[2]=PKW(P0,12),pw1[3]=PKW(P0,14), pw1); \
    VRD(2); SBAR(); GAPA(C0=__builtin_amdgcn_mfma_f32_32x32x16_bf16(kf[4],qr[2],C0,0,0,0),   P1[2],P1[3],P1[4],P1[5],     pw2[0]=PKW(P1,0), pw2[1]=PKW(P1,2), pw2); \
    VRD(6); SBAR(); GAPA(C1=__builtin_amdgcn_mfma_f32_32x32x16_bf16(kf[5],qr[2],C1,0,0,0),   P1[6],P1[7],P1[8],P1[9],     pw2[2]=PKW(P1,4), pw2[3]=PKW(P1,6), pw2); \
    VRD(3); SBAR(); GAPA(C0=__builtin_amdgcn_mfma_f32_32x32x16_bf16(kf[6],qr[3],C0,0,0,0),   P1[10],P1[11],P1[12],P1[13], pw3[0]=PKW(P1,8), pw3[1]=PKW(P1,10), pw3); \
    VRD(7); SBAR(); GAPA(C1=__builtin_amdgcn_mfma_f32_32x32x16_bf16(kf[7],qr[3],C1,0,0,0),   P1[14],P1[15],0.f,0.f,       pw3[2]=PKW(P1,12),pw3[3]=PKW(P1,14), pw3); \
    l_reg+=sacc; \
    if(GK){DMA_K((t)+3,sl_cur);} if(GV){DMA_V((t)+1,sl_next);} \
    FADD(C0,C1,t); CMASK(C0,C1,t); \
    resc=false; if(MODE!=1) { float a=MX3(C0[0],C0[1],C1[0]),b=MX3(C0[2],C0[3],C1[1]); a=MX3(a,C1[2],C1[3]); \
      _Pragma("unroll") for(int r=4;r<16;r+=4){a=MX3(a,C0[r],C0[r+1]);b=MX3(b,C0[r+2],C0[r+3]);a=MX3(a,C1[r],C1[r+1]);b=MX3(b,C1[r+2],C1[r+3]);} \
      float rm=__builtin_fmaxf(a,b); { auto rr=__builtin_amdgcn_permlane32_swap(__float_as_uint(rm),__float_as_uint(rm),false,false); rm=__builtin_fmaxf(__uint_as_float(rr[0]),__uint_as_float(rr[1])); } \
      resc=false; \
      if(__builtin_expect(__any(rm>(float)THRL),0)){ const float dl=__builtin_fmaxf(rm,0.f); mhat+=dl; \
        _Pragma("unroll") for(int r=0;r<16;++r){C0[r]-=dl;C1[r]-=dl;} \
        if(MODE==0){ _Pragma("unroll") for(int r=0;r<16;++r)negm[r]=-mhat; asm volatile("":"+v"(negm)); } \
        const float f=__builtin_amdgcn_exp2f(-dl); l_reg*=f; if(hi==0)wsf[r32]=f; resc=true; } } \
    SBAR(); \
    GAPB(o[0]=__builtin_amdgcn_mfma_f32_32x32x16_bf16(PAF(0),VFR(0),o[0],0,0,0), C0,0); \
    GAPB(o[1]=__builtin_amdgcn_mfma_f32_32x32x16_bf16(PAF(0),VFR(4),o[1],0,0,0), C0,4); \
    KRD(GL,0); GAPB(o[0]=__builtin_amdgcn_mfma_f32_32x32x16_bf16(PAF(1),VFR(1),o[0],0,0,0), C0,8); \
    KRD(GL,1); GAPB(o[1]=__builtin_amdgcn_mfma_f32_32x32x16_bf16(PAF(1),VFR(5),o[1],0,0,0), C0,12); \
    KRD(GL,2); GAPB(o[0]=__builtin_amdgcn_mfma_f32_32x32x16_bf16(PAF(2),VFR(2),o[0],0,0,0), C1,0); \
    KRD(GL,3); GAPB(o[1]=__builtin_amdgcn_mfma_f32_32x32x16_bf16(PAF(2),VFR(6),o[1],0,0,0), C1,4); \
    GAPB(o[0]=__builtin_amdgcn_mfma_f32_32x32x16_bf16(PAF(3),VFR(3),o[0],0,0,0), C1,8); \
    GAPB(o[1]=__builtin_amdgcn_mfma_f32_32x32x16_bf16(PAF(3),VFR(7),o[1],0,0,0), C1,12); \
    }while(0)
  int t=1;
  #undef CMASK
  #define CMASK(P0,P1,t) do{}while(0)
  for(;t+(MODE==0?7:5)<NT;t+=2){
    STEP(pB0,pB1,pA0,pA1,t,true,true,true);     WAIT_BAR(2); RESC(); ROT();
    STEP(pA0,pA1,pB0,pB1,t+1,true,true,true);   WAIT_BAR(2); RESC(); ROT();
  }
  #undef CMASK
  #define CMASK(P0,P1,t) do{int jb_=(t)-(NT-4); if(MODE==1){ if(jb_>=0)cmask(P0,P1,jb_,qrel,hi); } else { if(jb_>=-2)biasmask(P0,P1,jb_,qrel,hi,tab3); } }while(0)
  #define ENDW(tt) do{ if((tt)+3<NT){WAIT_BAR(2);} else if((tt)+2<NT){WAIT_BAR(1);} else {WAIT_BAR(0);} }while(0)
  for(;t+1<NT;t+=2){
    STEP(pB0,pB1,pA0,pA1,t,(t+3<NT),(t+1<NT),(t+1<NT));       ENDW(t);   RESC(); ROT();
    STEP(pA0,pA1,pB0,pB1,t+1,(t+4<NT),(t+2<NT),(t+2<NT));     ENDW(t+1); RESC(); ROT();
  }
  STEP(pB0,pB1,pA0,pA1,NT-1,false,false,false); RESC();
  { float sacc=pB0[0]+pB0[1]; _Pragma("unroll") for(int r=2;r<16;++r)sacc+=pB0[r]; _Pragma("unroll") for(int r=0;r<16;++r)sacc+=pB1[r]; l_reg+=sacc;
    pw0=(u32x4){PKW(pB0,0),PKW(pB0,2),PKW(pB0,4),PKW(pB0,6)};pw1=(u32x4){PKW(pB0,8),PKW(pB0,10),PKW(pB0,12),PKW(pB0,14)};pw2=(u32x4){PKW(pB1,0),PKW(pB1,2),PKW(pB1,4),PKW(pB1,6)};pw3=(u32x4){PKW(pB1,8),PKW(pB1,10),PKW(pB1,12),PKW(pB1,14)};
    SBAR(); pv(o,vb0+sl_cur,PAF(0),PAF(1),PAF(2),PAF(3)); }
  #undef PKW
  #undef PAF
  #undef VFR
  #undef PIN
  #undef MX3
  #undef GAPA
  #undef GAPB
  #undef EX
  #undef VRD
  #undef KRD
  #undef STEP
  #undef ENDW
  {auto rr=__builtin_amdgcn_permlane32_swap(__float_as_uint(l_reg),__float_as_uint(l_reg),false,false);l_reg=__uint_as_float(rr[0])+__uint_as_float(rr[1]);}
  if(hi==0)wsf[32+r32]=l_reg;asm volatile("s_waitcnt lgkmcnt(0)":::"memory");
  float rli[16];
  #pragma unroll
  for(int r=0;r<16;++r)rli[r]=__builtin_amdgcn_rcpf(wsf[32+crow(r,hi)]);
  bf16*Ow=O+(rowbase+q0+wid*QBLK)*DM+oc;
  { bf16*stg=(bf16*)(shm+LDS_OST)+wid*2048;
    #pragma unroll
    for(int r=0;r<16;++r){const int orow=crow(r,hi);
      #pragma unroll
      for(int d0=0;d0<2;++d0)stg[orow*64+d0*32+r32]=__float2bfloat16(o[d0][r]*rli[r]);}
    asm volatile("s_waitcnt lgkmcnt(0)":::"memory");
    #pragma unroll
    for(int i=0;i<4;++i){const int row=i*8+(lane>>3),ch=lane&7; const u32x4 v=*(const u32x4*)(stg+row*64+ch*8); ATTN_STORE16(Ow+(long)row*DM+ch*8,v);} }
  asm volatile("s_waitcnt lgkmcnt(0)\n\ts_barrier":::"memory");
  #undef FADD
  #undef CIN
  #undef DMA_K
  #undef DMA_V
  #undef CMASK
  #undef START
  #undef RESC
  #undef ROT
}
constexpr int WLDS_V=NSLOT*SLOTB, WLDS_WS=WLDS_V+NSLOT*2*SLOTB, WLDS_OST=WLDS_WS+NW*64*4, WLDS_BYTES=WLDS_OST+NW*4096;
__device__ __forceinline__ void pv_w(f32x16*o,int vb,bf16x8 pa0,bf16x8 pa1,bf16x8 pa2,bf16x8 pa3){
  #pragma unroll
  for(int d0=0;d0<4;++d0){s16x4 lo[4],hi[4];
    #pragma unroll
    for(int ks=0;ks<4;++ks){
      asm volatile("ds_read_b64_tr_b16 %0,%1 offset:%c2":"=&v"(lo[ks]):"v"(vb),"i"(d0*4096+ks*1024):"memory");
      asm volatile("ds_read_b64_tr_b16 %0,%1 offset:%c2":"=&v"(hi[ks]):"v"(vb),"i"(d0*4096+ks*1024+512):"memory");}
    asm volatile("s_waitcnt lgkmcnt(0)":::"memory");SBAR();
    #define PK(k) (bf16x8){lo[k][0],lo[k][1],lo[k][2],lo[k][3],hi[k][0],hi[k][1],hi[k][2],hi[k][3]}
    o[d0]=__builtin_amdgcn_mfma_f32_32x32x16_bf16(pa0,PK(0),o[d0],0,0,0);
    o[d0]=__builtin_amdgcn_mfma_f32_32x32x16_bf16(pa1,PK(1),o[d0],0,0,0);
    o[d0]=__builtin_amdgcn_mfma_f32_32x32x16_bf16(pa2,PK(2),o[d0],0,0,0);
    o[d0]=__builtin_amdgcn_mfma_f32_32x32x16_bf16(pa3,PK(3),o[d0],0,0,0);
    #undef PK
  }
}
template<int THRL,bool COMB> __device__ __forceinline__ void attn_unit_w(int b,int qc,int kc,int vc,int oc,int qb,const bf16*Q,const bf16*__restrict__ K,const bf16*__restrict__ V,bf16*O,char*shm,const float*aux,int hidx,const float*kpart,int npart,const int tid_in,const bf16*O0r,const float lam,const float*subg){
  int tid=tid_in; asm volatile("":"+v"(tid));
  constexpr int MODE=0;
  const int lane=tid&63,r32=lane&31,hi=lane>>5; const int wid=__builtin_amdgcn_readfirstlane(tid>>6);
  const long rowbase=(long)b*SEQ; const int q0=qb*QB;
  const bf16*Qw=Q+(rowbase+q0+wid*QBLK)*DM+qc;
  const bf16*Kh=K+rowbase*DM+kc; const bf16*Vh=V+rowbase*DM+vc;
  const unsigned lds0=(unsigned)(uintptr_t)shm;
  float*wsf=(float*)(shm+WLDS_WS)+wid*64;
  int tskip=0;
  if(MODE==1){
    float ss=0.f;
    #pragma unroll
    for(int d0=0;d0<4;++d0){ const bf16x8 qv=*reinterpret_cast<const bf16x8*>(&Qw[(long)r32*DM+d0*16+hi*8]);
      #pragma unroll
      for(int e=0;e<8;++e){ const float f=__uint_as_float(((unsigned)(unsigned short)qv[e])<<16); ss+=f*f; } }
    { auto rr=__builtin_amdgcn_permlane32_swap(__float_as_uint(ss),__float_as_uint(ss),false,false); ss=__uint_as_float(rr[0])+__uint_as_float(rr[1]); }
    ss=wave_max32(ss);
    float km=0.f; for(int i=lane;i<npart;i+=64) km=fmaxf(km,kpart[(long)i*64]);
    km=wave_max64(km);
    ALAS float*wsl=(ALAS float*)((__attribute__((address_space(3))) char*)shm+WLDS_WS);
    if(lane==0)wsl[wid*64]=ss;
    asm volatile("s_waitcnt lgkmcnt(0)\n\ts_barrier":::"memory");
    float qm=wsl[0];
    #pragma unroll
    for(int w=1;w<NW;++w)qm=fmaxf(qm,wsl[w*64]);
    const float smax2=2.f*(__builtin_amdgcn_sqrtf(qm*km)*1.01f+1.f);
    const int NT0=(q0+QB)/KVBLK;
    const float thr=aux[q0]-160.f-smax2;
    const bool sk0=(lane<NT0-6)&&(aux[64*lane+63]<thr);
    const bool sk1=(lane+64<NT0-6)&&(aux[64*(lane+64)+63]<thr);
    const unsigned long long m0=~__ballot(sk0), m1=~__ballot(sk1);
    const int nlead=m0?__builtin_ctzll(m0):64+(m1?__builtin_ctzll(m1):64);
    tskip=__builtin_amdgcn_readfirstlane(nlead&~1);
    Kh+=(long)tskip*KVBLK*DM; Vh+=(long)tskip*KVBLK*DM; aux+=64*tskip;
  }
  const bf16*ksrc=Kh+(long)lane*DM+wid*8;
  const bf16*vsrc=Vh+(long)(16*(wid&3)+(lane>>2))*DM+(wid>>2)*32+(lane&3)*8;
  const unsigned kdst=lds0+LDS_K+wid*1024, vdst=lds0+WLDS_V+wid*1024;
  #define DMA_K(t,slot) glds16(ksrc+(long)(t)*KVBLK*DM,(unsigned)__builtin_amdgcn_readfirstlane(kdst+(slot)))
  #define DMA_V(t,slot) do{ glds16(vsrc+(long)(t)*KVBLK*DM,(unsigned)__builtin_amdgcn_readfirstlane(vdst+2*(slot))); glds16(vsrc+64+(long)(t)*KVBLK*DM,(unsigned)__builtin_amdgcn_readfirstlane(vdst+2*(slot)+8192)); }while(0)
  const int vb0=(int)(lds0+WLDS_V)+((lane>>4)&1)*32+(lane&3)*8+(4*hi+((lane&15)>>2))*64;
  const char*Kbase=shm+LDS_K; bf16x8 kf[8];
  const lds_cptr shm3=(lds_cptr)shm; const lds_cptr kp0=shm3+LDS_K+hi*1024+r32*16; const lds_cptr vp0=shm3+WLDS_V+((lane>>4)&1)*32+(lane&3)*8+(4*hi+((lane&15)>>2))*64;
  const int NT=(q0+QB)/KVBLK-tskip;
  const ALAS float*tab3=(const ALAS float*)(shm3+WLDS_BYTES);
  { ALAS float*tabf=(ALAS float*)(shm3+WLDS_BYTES);
    if(MODE==0){ if(tid<130){ float v; if(tid==0)v=-INFINITY; else if(tid==129)v=0.f; else{ const int n=tid-1; int bk; if(n<16)bk=n; else{ const int lg=16+(int)(__builtin_amdgcn_logf((float)n*0.0625f)*(16.0f/3.0f));     bk=lg<31?lg:31; } v=(aux[bk*8+hidx]-aux[31*8+hidx])*1.4426950408889634f; } tabf[tid]=v; } }
    else{ const int n4=(q0+QB-64*tskip)>>2; for(int i=tid;i<n4;i+=512) ((ALAS f32x4v*)tabf)[i]=((const f32x4v*)aux)[i]; }
    asm volatile("s_waitcnt vmcnt(0) lgkmcnt(0)":::"memory"); }
  DMA_K(0,0);DMA_V(0,0);DMA_K(1,SLOTB);
  bf16x8 qr[4];
  #pragma unroll
  for(int d0=0;d0<4;++d0)qr[d0]=*reinterpret_cast<const bf16x8*>(&Qw[(long)r32*DM+d0*16+hi*8]);
  float mhat=0.f,l_reg=0.f;f32x16 o[4];o[0]=f32x16{};o[1]=f32x16{};o[2]=f32x16{};o[3]=f32x16{};
  const f32x16 zero16=f32x16{};
  #define CIN zero16
  const int qrel=wid*QBLK+r32;
  #define CMASK(P0,P1,t) do{int jb_=(t)-(NT-4); if(MODE==1){ if(jb_>=0)cmask(P0,P1,jb_,qrel,hi); } else { if(jb_>=-2)biasmask(P0,P1,jb_,qrel,hi,tab3); } }while(0)
  #define FADD(P0,P1,t) do{ if(MODE==1){ const ALAS f32x4v*fp_=(const ALAS f32x4v*)(shm3+WLDS_BYTES)+(16*(t)+hi); \
    _Pragma("unroll") for(int g_=0;g_<4;++g_){ const f32x4v a_=fp_[2*g_]-mhat, b_=fp_[8+2*g_]-mhat; \
      P0[4*g_]+=a_[0];P0[4*g_+1]+=a_[1];P0[4*g_+2]+=a_[2];P0[4*g_+3]+=a_[3]; P1[4*g_]+=b_[0];P1[4*g_+1]+=b_[1];P1[4*g_+2]+=b_[2];P1[4*g_+3]+=b_[3]; } } }while(0)
  bool resc=false;
  #define START(P0,P1) do{ const float rm=rowmax(P0,P1); resc=false; mhat=rm; \
    _Pragma("unroll") for(int r=0;r<16;++r)P0[r]=__builtin_amdgcn_exp2f(fsub_s(P0[r],mhat)); }while(0)
  #define RESC() do{ if(resc){ asm volatile("s_waitcnt lgkmcnt(0)":::"memory"); \
      _Pragma("unroll") for(int d_=0;d_<4;++d_) _Pragma("unroll") for(int r=0;r<16;++r)o[d_][r]*=wsf[crow(r,hi)]; } }while(0)
  f32x16 pA0,pA1,pB0,pB1;
  int sl_prev=0,sl_cur=0,sl_next=SLOTB;
  #define ROT() do{sl_prev=sl_cur;sl_cur=sl_next;sl_next=(sl_next==(NSLOT-1)*SLOTB)?0:sl_next+SLOTB;}while(0)
  DMA_K(2,2*SLOTB);
  WAIT_BAR(4);
  qkt(pA0,pA1,Kbase,qr,CIN,r32,hi);asm volatile("s_nop 15\n\ts_nop 7":"+v"(pA0),"+v"(pA1));FADD(pA0,pA1,0);CMASK(pA0,pA1,0);
  START(pA0,pA1);
  _Pragma("unroll") for(int r=0;r<16;++r)pA1[r]=__builtin_amdgcn_exp2f(pA1[r]-mhat);
  WAIT_BAR(0);
  DMA_K(3,0);DMA_V(1,SLOTB);
  ROT();
  kload8(kf,kp0+sl_cur);
  WAIT_BAR(3);
  s16x4 vlo[8],vhi[8]; u32x4 pw0,pw1,pw2,pw3;
  #define PKW(P,B) cvtpk_s(P[B],P[B+1])
  #define PAF(k) __builtin_bit_cast(bf16x8,pw##k)
  #define VFR(i) (bf16x8){vlo[i][0],vlo[i][1],vlo[i][2],vlo[i][3],vhi[i][0],vhi[i][1],vhi[i][2],vhi[i][3]}
  #define PIN(x) asm volatile("":"+v"(x))
  #define MX3(a,b,c) __builtin_fmaxf(__builtin_fmaxf((a),(b)),(c))
  #define GAPA(MF,A0,A1,A2,A3,W0,W1,PW) do{ MF; sacc+=A0; sacc+=A1; sacc+=A2; sacc+=A3; PIN(sacc); W0; W1; PIN(PW); SBAR(); }while(0)
  #define EX(v) __builtin_amdgcn_exp2f(v)
  #define GAPB(MF,X,B) do{ MF; X[B]=EX(X[B]-mhat); X[B+1]=EX(X[B+1]-mhat); X[B+2]=EX(X[B+2]-mhat); X[B+3]=EX(X[B+3]-mhat); PIN(X); SBAR(); }while(0)
  #define GAPC(MF) do{ MF; SBAR(); }while(0)
  #define GAPB2(MF,X,B) do{ MF; X[B]=EX(X[B]-mhat); X[B+1]=EX(X[B+1]-mhat); PIN(X); SBAR(); }while(0)
  #define VRD2(i) do{ vlo[i]=vtr(vp_+((((i)>>2)+2)*4096+((i)&3)*1024)); vhi[i]=vtr(vp_+((((i)>>2)+2)*4096+((i)&3)*1024+512)); SBAR(); }while(0)
  #define VRD(i) do{ vlo[i]=vtr(vp_+(((i)>>2)*4096+((i)&3)*1024)); vhi[i]=vtr(vp_+(((i)>>2)*4096+((i)&3)*1024+512)); }while(0)
  #define KRD(G,j) do{ if(G){ kload2(kf,kp0+sl_next,j); SBAR(); } }while(0)
  #define STEP(C0,C1,P0,P1,t,GK,GV,GL) do{ SBAR(); \
    const lds_cptr vp_=vp0+2*sl_prev; \
    VRD(0); SBAR(); float sacc=(P0[0]+P0[1]); \
    GAPA(C0=__builtin_amdgcn_mfma_f32_32x32x16_bf16(kf[0],qr[0],CIN,0,0,0), P0[2],P0[3],P0[4],P0[5],     pw0[0]=PKW(P0,0), pw0[1]=PKW(P0,2), pw0); \
    VRD(4); SBAR(); GAPA(C1=__builtin_amdgcn_mfma_f32_32x32x16_bf16(kf[1],qr[0],CIN,0,0,0), P0[6],P0[7],P0[8],P0[9],     pw0[2]=PKW(P0,4), pw0[3]=PKW(P0,6), pw0); \
    VRD(1); SBAR(); GAPA(C0=__builtin_amdgcn_mfma_f32_32x32x16_bf16(kf[2],qr[1],C0,0,0,0),   P0[10],P0[11],P0[12],P0[13], pw1[0]=PKW(P0,8), pw1[1]=PKW(P0,10), pw1); \
    VRD(5); SBAR(); GAPA(C1=__builtin_amdgcn_mfma_f32_32x32x16_bf16(kf[3],qr[1],C1,0,0,0),   P0[14],P0[15],P1[0],P1[1],   pw1[2]=PKW(P0,12),pw1[3]=PKW(P0,14), pw1); \
    VRD(2); SBAR(); GAPA(C0=__builtin_amdgcn_mfma_f32_32x32x16_bf16(kf[4],qr[2],C0,0,0,0),   P1[2],P1[3],P1[4],P1[5],     pw2[0]=PKW(P1,0), pw2[1]=PKW(P1,2), pw2); \
    VRD(6); SBAR(); GAPA(C1=__builtin_amdgcn_mfma_f32_32x32x16_bf16(kf[5],qr[2],C1,0,0,0),   P1[6],P1[7],P1[8],P1[9],     pw2[2]=PKW(P1,4), pw2[3]=PKW(P1,6), pw2); \
    VRD(3); SBAR(); GAPA(C0=__builtin_amdgcn_mfma_f32_32x32x16_bf16(kf[6],qr[3],C0,0,0,0),   P1[10],P1[11],P1[12],P1[13], pw3[0]=PKW(P1,8), pw3[1]=PKW(P1,10), pw3); \
    VRD(7); SBAR(); GAPA(C1=__builtin_amdgcn_mfma_f32_32x32x16_bf16(kf[7],qr[3],C1,0,0,0),   P1[14],P1[15],0.f,0.f,       pw3[2]=PKW(P1,12),pw3[3]=PKW(P1,14), pw3); \
    l_reg+=sacc; \
    if(GK){DMA_K((t)+3,sl_cur);} if(GV){DMA_V((t)+1,sl_next);} \
    FADD(C0,C1,t); CMASK(C0,C1,t); \
    { float a=MX3(C0[0],C0[1],C1[0]),b=MX3(C0[2],C0[3],C1[1]); a=MX3(a,C1[2],C1[3]); \
      _Pragma("unroll") for(int r=4;r<16;r+=4){a=MX3(a,C0[r],C0[r+1]);b=MX3(b,C0[r+2],C0[r+3]);a=MX3(a,C1[r],C1[r+1]);b=MX3(b,C1[r+2],C1[r+3]);} \
      float rm=__builtin_fmaxf(a,b); { auto rr=__builtin_amdgcn_permlane32_swap(__float_as_uint(rm),__float_as_uint(rm),false,false); rm=__builtin_fmaxf(__uint_as_float(rr[0]),__uint_as_float(rr[1])); } \
      resc=false; \
      const float rmr=rm-mhat; \
      if(__builtin_expect(__any(rmr>(float)THRL),0)){ const float dl=__builtin_fmaxf(rmr,0.f); mhat+=dl; \
        const float f=__builtin_amdgcn_exp2f(-dl); l_reg*=f; { int lq_=tid_in; asm volatile("":"+v"(lq_)); if((lq_&32)==0)wsf[lq_&31]=f; } resc=true; } } \
    SBAR(); \
    GAPB2(o[0]=__builtin_amdgcn_mfma_f32_32x32x16_bf16(PAF(0),VFR(0),o[0],0,0,0), C0,0); VRD2(0); \
    GAPB2(o[1]=__builtin_amdgcn_mfma_f32_32x32x16_bf16(PAF(0),VFR(4),o[1],0,0,0), C0,2); VRD2(4); \
    KRD(GL,0); GAPB2(o[0]=__builtin_amdgcn_mfma_f32_32x32x16_bf16(PAF(1),VFR(1),o[0],0,0,0), C0,4); VRD2(1); \
    KRD(GL,1); GAPB2(o[1]=__builtin_amdgcn_mfma_f32_32x32x16_bf16(PAF(1),VFR(5),o[1],0,0,0), C0,6); VRD2(5); \
    KRD(GL,2); GAPB2(o[0]=__builtin_amdgcn_mfma_f32_32x32x16_bf16(PAF(2),VFR(2),o[0],0,0,0), C0,8); VRD2(2); \
    KRD(GL,3); GAPB2(o[1]=__builtin_amdgcn_mfma_f32_32x32x16_bf16(PAF(2),VFR(6),o[1],0,0,0), C0,10); VRD2(6); \
    GAPB2(o[0]=__builtin_amdgcn_mfma_f32_32x32x16_bf16(PAF(3),VFR(3),o[0],0,0,0), C0,12); VRD2(3); \
    GAPB2(o[1]=__builtin_amdgcn_mfma_f32_32x32x16_bf16(PAF(3),VFR(7),o[1],0,0,0), C0,14); VRD2(7); \
    GAPB2(o[2]=__builtin_amdgcn_mfma_f32_32x32x16_bf16(PAF(0),VFR(0),o[2],0,0,0), C1,0); GAPB2(o[3]=__builtin_amdgcn_mfma_f32_32x32x16_bf16(PAF(0),VFR(4),o[3],0,0,0), C1,2); \
    GAPB2(o[2]=__builtin_amdgcn_mfma_f32_32x32x16_bf16(PAF(1),VFR(1),o[2],0,0,0), C1,4); GAPB2(o[3]=__builtin_amdgcn_mfma_f32_32x32x16_bf16(PAF(1),VFR(5),o[3],0,0,0), C1,6); \
    GAPB2(o[2]=__builtin_amdgcn_mfma_f32_32x32x16_bf16(PAF(2),VFR(2),o[2],0,0,0), C1,8); GAPB2(o[3]=__builtin_amdgcn_mfma_f32_32x32x16_bf16(PAF(2),VFR(6),o[3],0,0,0), C1,10); \
    GAPB2(o[2]=__builtin_amdgcn_mfma_f32_32x32x16_bf16(PAF(3),VFR(3),o[2],0,0,0), C1,12); GAPB2(o[3]=__builtin_amdgcn_mfma_f32_32x32x16_bf16(PAF(3),VFR(7),o[3],0,0,0), C1,14); \
    }while(0)
  int t=1;
  #undef CMASK
  #define CMASK(P0,P1,t) do{}while(0)
  for(;t+(MODE==0?7:5)<NT;t+=2){
    STEP(pB0,pB1,pA0,pA1,t,true,true,true);     WAIT_BAR(3); RESC(); ROT();
    STEP(pA0,pA1,pB0,pB1,t+1,true,true,true);   WAIT_BAR(3); RESC(); ROT();
  }
  #undef CMASK
  #define CMASK(P0,P1,t) do{int jb_=(t)-(NT-4); if(MODE==1){ if(jb_>=0)cmask(P0,P1,jb_,qrel,hi); } else { if(jb_>=-2)biasmask(P0,P1,jb_,qrel,hi,tab3); } }while(0)
  #define ENDW(tt) do{ if((tt)+3<NT){WAIT_BAR(3);} else if((tt)+2<NT){WAIT_BAR(2);} else {WAIT_BAR(0);} }while(0)
  for(;t+1<NT;t+=2){
    STEP(pB0,pB1,pA0,pA1,t,(t+3<NT),(t+1<NT),(t+1<NT));       ENDW(t);   RESC(); ROT();
    STEP(pA0,pA1,pB0,pB1,t+1,(t+4<NT),(t+2<NT),(t+2<NT));     ENDW(t+1); RESC(); ROT();
  }
  STEP(pB0,pB1,pA0,pA1,NT-1,false,false,false); RESC();
  { float sacc=pB0[0]+pB0[1]; _Pragma("unroll") for(int r=2;r<16;++r)sacc+=pB0[r]; _Pragma("unroll") for(int r=0;r<16;++r)sacc+=pB1[r]; l_reg+=sacc;
    pw0=(u32x4){PKW(pB0,0),PKW(pB0,2),PKW(pB0,4),PKW(pB0,6)};pw1=(u32x4){PKW(pB0,8),PKW(pB0,10),PKW(pB0,12),PKW(pB0,14)};pw2=(u32x4){PKW(pB1,0),PKW(pB1,2),PKW(pB1,4),PKW(pB1,6)};pw3=(u32x4){PKW(pB1,8),PKW(pB1,10),PKW(pB1,12),PKW(pB1,14)};
    SBAR(); pv_w(o,vb0+2*sl_cur,PAF(0),PAF(1),PAF(2),PAF(3)); }
  #undef PKW
  #undef PAF
  #undef VFR
  #undef PIN
  #undef MX3
  #undef GAPA
  #undef GAPB
  #undef GAPC
  #undef GAPB2
  #undef VRD2
  #undef EX
  #undef VRD
  #undef KRD
  #undef STEP
  #undef ENDW
  {auto rr=__builtin_amdgcn_permlane32_swap(__float_as_uint(l_reg),__float_as_uint(l_reg),false,false);l_reg=__uint_as_float(rr[0])+__uint_as_float(rr[1]);}
  if(hi==0)wsf[32+r32]=l_reg;asm volatile("s_waitcnt lgkmcnt(0)":::"memory");
  float rli[16];
  #pragma unroll
  for(int r=0;r<16;++r)rli[r]=__builtin_amdgcn_rcpf(wsf[32+crow(r,hi)]);
  bf16*Ow=O+(rowbase+q0+wid*QBLK)*DM+oc;
  int lane2=tid_in; asm volatile("":"+v"(lane2)); lane2&=63;
  { bf16*stg=(bf16*)(shm+WLDS_OST)+wid*2048;
    float gcol[4]={1.f,1.f,1.f,1.f};
    if constexpr(COMB){
      const bf16*O0w=O0r+(rowbase+q0+wid*QBLK)*DM+oc;
      #pragma unroll
      for(int hh=0;hh<2;++hh){
        #pragma unroll
        for(int i=0;i<4;++i){const int row=i*8+(lane2>>3),ch=lane2&7; const u32x4 v=*(const u32x4*)(O0w+(long)row*DM+hh*64+ch*8); *(u32x4*)(stg+row*64+ch*8)=v;}
        asm volatile("s_waitcnt vmcnt(0) lgkmcnt(0)":::"memory");
        #pragma unroll
        for(int r=0;r<16;++r){const int orow=crow(r,hi);
          #pragma unroll
          for(int d0=0;d0<2;++d0){ const float x0=__bfloat162float(stg[orow*64+d0*32+r32]); o[2*hh+d0][r]=x0-lam*(o[2*hh+d0][r]*rli[r]); } }
        asm volatile("s_waitcnt lgkmcnt(0)":::"memory"); }
      #pragma unroll
      for(int d=0;d<4;++d)gcol[d]=subg[d*32+r32]*0.8f;
      #pragma unroll
      for(int r=0;r<16;++r){ float ss=(o[0][r]*o[0][r]+o[1][r]*o[1][r])+(o[2][r]*o[2][r]+o[3][r]*o[3][r]);
        ss=xadd<1>(ss);ss=xadd<2>(ss);ss=xadd<4>(ss);ss=xadd<8>(ss);ss=xadd<16>(ss);
        rli[r]=__builtin_amdgcn_rsqf(ss*(1.f/128.f)+1e-6f); }
    }
    #pragma unroll
    for(int hh=0;hh<2;++hh){
      #pragma unroll
      for(int r=0;r<16;++r){const int orow=crow(r,hi);
        #pragma unroll
        for(int d0=0;d0<2;++d0)stg[orow*64+d0*32+r32]=__float2bfloat16(COMB?(o[2*hh+d0][r]*rli[r]*gcol[2*hh+d0]):(o[2*hh+d0][r]*rli[r]));}
      asm volatile("s_waitcnt lgkmcnt(0)":::"memory");
      #pragma unroll
      for(int i=0;i<4;++i){const int row=i*8+(lane2>>3),ch=lane2&7; const u32x4 v=*(const u32x4*)(stg+row*64+ch*8); ATTN_STORE16(Ow+(long)row*DM+hh*64+ch*8,v);}
      asm volatile("s_waitcnt lgkmcnt(0)":::"memory"); } }
  asm volatile("s_waitcnt lgkmcnt(0)\n\ts_barrier":::"memory");
  #undef FADD
  #undef CIN
  #undef DMA_K
  #undef DMA_V
  #undef CMASK
  #undef START
  #undef RESC
  #undef ROT
}
constexpr int ATTN_W_LDS_BYTES=WLDS_BYTES+1024;
constexpr int ATTN_LDS_BYTES=LDS_BYTES;
#undef SBAR
#undef WAIT_BAR
}
namespace cg = cooperative_groups;
constexpr int NWAVES = 8;
constexpr int BATCH = 4, T = 8192, D = 1024, FF = 2816, NIN = 2 * FF, M = BATCH * T, NMOD = 9 * D;
constexpr float EPS = 1e-6f, LOG2E = 1.4426950408889634f;
constexpr size_t MiB = 1u << 20;
constexpr size_t WS_CNT = 6 * MiB, WS_XBUF = 7 * MiB, WS_BAR = 1 * MiB + 832 * 1024, WS_QCTR = 1 * MiB + 768 * 1024, WS_KPART = 1 * MiB + 512 * 1024, WS_MOD = 1 * MiB, WS_LOGF = 2 * MiB, WS_NF2 = 4 * MiB, WS_WB = 8 * MiB, WS_XN = 52 * MiB, WS_R1 = 116 * MiB, WS_R2 = 308 * MiB, WS_XN2 = 436 * MiB, WS_WA = 436 * MiB, WS_END = 500 * MiB;
constexpr size_t WO_IN0 = 0, WO_IN1 = 11 * MiB, WO_OUT0 = 22 * MiB, WO_OUT1 = 22 * MiB + 5767168, WO_X1 = 33 * MiB, WO_AWO = 39 * MiB, WO_BWQ = 37 * MiB, WO_BWO = 39 * MiB;
constexpr size_t BUF64 = 64 * MiB;
constexpr int RING_BYTES = 131072, LDS_BYTES = 147456;
static_assert(attn_body::ATTN_LDS_BYTES + 32768 <= RING_BYTES && attn_body::ATTN_W_LDS_BYTES <= RING_BYTES, "attention LDS");

#define LAS __attribute__((address_space(3)))
typedef unsigned short bf16;
typedef unsigned v4u __attribute__((ext_vector_type(4)));
typedef float f32x4 __attribute__((ext_vector_type(4)));
#define LDS_WAIT() asm volatile("s_waitcnt lgkmcnt(0)" ::: "memory")

#define XB_TMO      128
#define XB_XCNT(j)  (256  + 64 * (j))
#define XB_XSUB(j)  (1280 + 64 * (j))
#define XB_XGEN(j)  (2304 + 64 * (j))
#define XB_TOP      3328
#define XB_TOPGEN   3392
#define XCD_BAR_WORDS 3456
#define XB_SPIN_CAP (1u << 18)

__device__ __forceinline__ unsigned xb_ld(unsigned* p)              { return __hip_atomic_load(p, __ATOMIC_RELAXED, __HIP_MEMORY_SCOPE_AGENT); }
__device__ __forceinline__ unsigned xb_add(unsigned* p, unsigned v) { return __hip_atomic_fetch_add(p, v, __ATOMIC_RELAXED, __HIP_MEMORY_SCOPE_AGENT); }
__device__ __forceinline__ unsigned xb_xcc_id() { return (unsigned)__builtin_amdgcn_s_getreg((3 << 11) | 20) & 0xFu; }
#define XB_SPIN(cond, bar) do { unsigned _sp = 0; while (cond) { __builtin_amdgcn_s_sleep(1); \
    if ((++_sp & 255u) == 0u) { if (xb_ld(&(bar)[XB_TMO])) break; if (_sp > XB_SPIN_CAP) { atomicAdd(&(bar)[XB_TMO], 1u); break; } } } } while (0)

struct XcdBarrier {
    unsigned* bar; unsigned x;
    volatile LAS unsigned* st;
};

__device__ __forceinline__ XcdBarrier xcd_barrier_post(unsigned* bar, volatile LAS unsigned* st, int tid) {
    XcdBarrier b; b.bar = bar; b.x = xb_xcc_id(); b.st = st;
    if (tid == 0) (void)xb_add(&bar[XB_XCNT(b.x)], 1u);
    return b;
}
__device__ __forceinline__ void xcd_barrier_complete(unsigned* bar, unsigned x, unsigned& nloc, unsigned& nx) {
    const unsigned G = gridDim.x * gridDim.y * gridDim.z;
    unsigned sum, cnt, mine, sp = 0u;
    for (;;) {
        sum = 0u; cnt = 0u; mine = 0u;
#pragma unroll
        for (unsigned j = 0; j < 16; ++j) { const unsigned c = xb_ld(&bar[XB_XCNT(j)]); sum += c; cnt += (c > 0u) ? 1u : 0u; mine = (j == x) ? c : mine; }
        if (sum == G) break;
        __builtin_amdgcn_s_sleep(1);
        if ((++sp & 255u) == 0u) { if (xb_ld(&bar[XB_TMO])) break; if (sp > XB_SPIN_CAP) { atomicAdd(&bar[XB_TMO], 1u); break; } }
    }
    nloc = mine > 0u ? mine : 1u; nx = cnt > 0u ? cnt : 1u;
}

__device__ __forceinline__ void xcd_barrier(const XcdBarrier& b, int tid) {
    asm volatile("s_waitcnt vmcnt(0)" ::: "memory");
    __syncthreads();
    if (tid == 0) {
        unsigned* bar = b.bar;
        __builtin_amdgcn_s_waitcnt(0);
        unsigned nloc = b.st[0], nx = b.st[1];
        if (nloc == 0u) { xcd_barrier_complete(bar, b.x, nloc, nx); b.st[0] = nloc; b.st[1] = nx; }
        const unsigned old = xb_add(&bar[XB_XSUB(b.x)], 1u);
        const unsigned gen = old / nloc;
        if (old + 1u == (gen + 1u) * nloc) {
            __builtin_amdgcn_fence(__ATOMIC_RELEASE, "agent");
            asm volatile("s_waitcnt vmcnt(0)" ::: "memory");
            const unsigned og = xb_add(&bar[XB_TOP], 1u);
            const unsigned tg = og / nx;
            if (og + 1u == (tg + 1u) * nx) xb_add(&bar[XB_TOPGEN], 1u);
            else XB_SPIN(xb_ld(&bar[XB_TOPGEN]) == tg, bar);
            __builtin_amdgcn_fence(__ATOMIC_ACQUIRE, "agent");
            xb_add(&bar[XB_XGEN(b.x)], 1u);
            asm volatile("s_waitcnt vmcnt(0)" ::: "memory");
        } else {
            XB_SPIN(xb_ld(&bar[XB_XGEN(b.x)]) == gen, bar);
            __builtin_amdgcn_fence(__ATOMIC_ACQUIRE, "agent");
            asm volatile("s_waitcnt vmcnt(0)" ::: "memory");
        }
    }
    __syncthreads();
}


__device__ __forceinline__ float wave_sum(float v) {
    return wave_sum64(v);
}
__device__ __forceinline__ unsigned pk2(float lo, float hi) { return pg8::cvt_pk_bf16(lo, hi); }
__device__ __forceinline__ float bf_lo(unsigned u) { return __uint_as_float(u << 16); }
__device__ __forceinline__ float bf_hi(unsigned u) { return __uint_as_float(u & 0xffff0000u); }

__device__ __forceinline__ void p0_transpose_item(const float* W, int K, int N, bf16* WT, int perm, LAS float* scr, int item, int lane) {
    const int nblk = N / 32, kb = item / nblk, nb = item % nblk, k0 = 64 * kb, n0 = 32 * nb;
    int nd = n0;
    if (perm) nd = (n0 < FF) ? 256 * (n0 >> 7) + (n0 & 127) : 256 * ((n0 - FF) >> 7) + 128 + ((n0 - FF) & 127);
    float wv[32];
#pragma unroll
    for (int i = 0; i < 32; ++i) wv[i] = W[(size_t)(k0 + 2 * i + (lane >> 5)) * N + n0 + (lane & 31)];
#pragma unroll
    for (int i = 0; i < 32; ++i) scr[(2 * i + (lane >> 5)) * 33 + (lane & 31)] = wv[i];
    LDS_WAIT(); asm volatile("" ::: "memory");
    const int c = lane & 7;
#pragma unroll
    for (int j = 0; j < 4; ++j) { const int n = (lane >> 3) + 8 * j; const LAS float* s = scr + (8 * c) * 33 + n;
        v4u o; o.x = pk2(s[0 * 33], s[1 * 33]); o.y = pk2(s[2 * 33], s[3 * 33]); o.z = pk2(s[4 * 33], s[5 * 33]); o.w = pk2(s[6 * 33], s[7 * 33]);
        *(v4u*)(WT + (size_t)(nd + n) * K + k0 + 8 * c) = o; }
    LDS_WAIT(); asm volatile("" ::: "memory");
}
__device__ __forceinline__ void p0_mod_item(int item, const float* c, const float* ada_w, const float* ada_b, const float* kvw, const float* kvb, float* mod, LAS unsigned char* lds, int tid) {
    LAS float* cact = (LAS float*)lds; LAS float* red = (LAS float*)(lds + 16384);
    for (int i = tid; i < 4096; i += 512) { const int b = i >> 10, k = i & 1023; const float v = c[i]; cact[k * 4 + b] = v * __builtin_amdgcn_rcpf(1.f + __builtin_amdgcn_exp2f(-LOG2E * v)); }
    __syncthreads();
    const float* W; const float* bias; int N, col0, dstride; float* dst;
    if (item < 36) { W = ada_w; bias = ada_b; N = NMOD; col0 = 256 * item; dst = mod; dstride = NMOD; }
    else if (item < 72) { W = ada_w + (size_t)D * NMOD; bias = ada_b + NMOD; N = NMOD; col0 = 256 * (item - 36); dst = mod + 4 * NMOD; dstride = NMOD; }
    else { W = kvw; bias = kvb; N = 2 * D; col0 = 256 * (item - 72); dst = mod + 8 * NMOD; dstride = 2 * D; }
    const int wave = tid >> 6, lane = tid & 63;
    f32x4 a0 = {0.f, 0.f, 0.f, 0.f}, a1 = a0, a2 = a0, a3 = a0;
    const float* wp = W + (size_t)(128 * wave) * N + col0 + 4 * lane;
#pragma unroll 8
    for (int kk = 0; kk < 128; ++kk) { const f32x4 w = *(const f32x4*)(wp + (size_t)kk * N); const f32x4 cv = *(const LAS f32x4*)(cact + (128 * wave + kk) * 4);
        a0 += w * cv.x; a1 += w * cv.y; a2 += w * cv.z; a3 += w * cv.w; }
    LAS f32x4* rp = (LAS f32x4*)(red + (wave * 64 + lane) * 16);
    rp[0] = a0; rp[1] = a1; rp[2] = a2; rp[3] = a3;
    __syncthreads();
    for (int o = tid; o < 1024; o += 512) { const int b = o >> 8, j = o & 255; float s = 0.f;
#pragma unroll
        for (int w = 0; w < 8; ++w) s += red[(w * 64 + (j >> 2)) * 16 + 4 * b + (j & 3)];
        dst[(size_t)b * dstride + col0 + j] = s + bias[col0 + j]; }
    __syncthreads();
}
__device__ __forceinline__ void norm_rows(const float* src, const float* g, const float* shift, const float* scale, int mstride, bf16* dst, int gw, int NGW, int lane) {
    f32x4 nx[4];
    if (gw < M) {
#pragma unroll
        for (int j = 0; j < 4; ++j) nx[j] = ((const f32x4*)(src + (size_t)gw * D) + lane)[64 * j]; }
    for (int m = gw; m < M; m += NGW) {
        const int b = m >> 13;
        f32x4 v[4]; float s = 0.f;
#pragma unroll
        for (int j = 0; j < 4; ++j) v[j] = nx[j];
        if (m + NGW < M) { const f32x4* xn_ = (const f32x4*)(src + (size_t)(m + NGW) * D) + lane;
#pragma unroll
            for (int j = 0; j < 4; ++j) nx[j] = xn_[64 * j]; }
#pragma unroll
        for (int j = 0; j < 4; ++j) s += (v[j].x * v[j].x + v[j].y * v[j].y) + (v[j].z * v[j].z + v[j].w * v[j].w);
        const float rs = __builtin_amdgcn_rsqf(wave_sum(s) * (1.f / D) + EPS);
        const f32x4* g4 = (const f32x4*)g + lane; const f32x4* sh4 = (const f32x4*)(shift + (size_t)b * mstride) + lane; const f32x4* sc4 = (const f32x4*)(scale + (size_t)b * mstride) + lane;
        unsigned long long* o8 = (unsigned long long*)(dst + (size_t)m * D) + lane;
#pragma unroll
        for (int j = 0; j < 4; ++j) { const f32x4 y = v[j] * rs * g4[64 * j] * (sc4[64 * j] + 1.f) + sh4[64 * j];
            o8[64 * j] = (unsigned long long)pk2(y.x, y.y) | ((unsigned long long)pk2(y.z, y.w) << 32); }
    }
}
__device__ __forceinline__ void norm_rows_kv(const bf16* src, const float* gA, const float* shA, const float* scA, int strideA, bf16* dstA,
                                             const float* gB, const float* shB, const float* scB, int strideB, bf16* dstB,
                                             const LAS float* fgT, const float* fgb, float* logf_out, int gw, int NGW, int lane) {
    unsigned long long nw[4] = {0ull, 0ull, 0ull, 0ull};
    if (gw < M) { const unsigned long long* x0_ = (const unsigned long long*)(src + (size_t)gw * D) + lane;
#pragma unroll
        for (int j = 0; j < 4; ++j) nw[j] = x0_[64 * j]; }
    for (int m = gw; m < M; m += NGW) {
        const int b = m >> 13;
        unsigned long long cw[4];
#pragma unroll
        for (int j = 0; j < 4; ++j) cw[j] = nw[j];
        if (m + NGW < M) { const unsigned long long* xn_ = (const unsigned long long*)(src + (size_t)(m + NGW) * D) + lane;
#pragma unroll
            for (int j = 0; j < 4; ++j) nw[j] = xn_[64 * j]; }
        f32x4 v[4]; float s = 0.f;
#pragma unroll
        for (int j = 0; j < 4; ++j) { const unsigned long long w = cw[j]; const unsigned lo = (unsigned)w, hi = (unsigned)(w >> 32);
            { const pg8::f32x2s_t a = pg8::up_h2(lo), b = pg8::up_h2(hi); v[j] = (f32x4){a.x, a.y, b.x, b.y}; } s += (v[j].x * v[j].x + v[j].y * v[j].y) + (v[j].z * v[j].z + v[j].w * v[j].w); }
        const float rs = __builtin_amdgcn_rsqf(wave_sum(s) * (1.f / D) + EPS);
        {   const f32x4* g4 = (const f32x4*)gB + lane; const f32x4* sh4 = (const f32x4*)(shB + (size_t)b * strideB) + lane; const f32x4* sc4 = (const f32x4*)(scB + (size_t)b * strideB) + lane;
            unsigned long long* o8 = (unsigned long long*)(dstB + (size_t)m * D) + lane;
#pragma unroll
            for (int j = 0; j < 4; ++j) { const f32x4 y = v[j] * rs * g4[64 * j] * (sc4[64 * j] + 1.f) + sh4[64 * j];
                o8[64 * j] = (unsigned long long)pk2(y.x, y.y) | ((unsigned long long)pk2(y.z, y.w) << 32); } }
        {   const f32x4* g4 = (const f32x4*)gA + lane; const f32x4* sh4 = (const f32x4*)(shA + (size_t)b * strideA) + lane; const f32x4* sc4 = (const f32x4*)(scA + (size_t)b * strideA) + lane;
            unsigned long long* o8 = (unsigned long long*)(dstA + (size_t)m * D) + lane;
#pragma unroll
            for (int j = 0; j < 4; ++j) { v[j] = v[j] * rs * g4[64 * j] * (sc4[64 * j] + 1.f) + sh4[64 * j];
                o8[64 * j] = (unsigned long long)pk2(v[j].x, v[j].y) | ((unsigned long long)pk2(v[j].z, v[j].w) << 32); } }
        float zmine = 0.f;
#pragma unroll
        for (int hh = 0; hh < 16; ++hh) { float p = 0.f;
#pragma unroll
            for (int j = 0; j < 4; ++j) { const f32x4 w = *(const LAS f32x4*)(fgT + hh * 1024 + 256 * j + 4 * lane); p += (v[j].x * w.x + v[j].y * w.y) + (v[j].z * w.z + v[j].w * w.w); }
            p = wave_sum(p); if (lane == hh) zmine = p; }
        if (lane < 16) { const float z = zmine + fgb[lane]; const float lf = fminf(z, 0.f) - 0.6931471805599453f * __builtin_amdgcn_logf(1.f + __builtin_amdgcn_exp2f(-LOG2E * fabsf(z)));     logf_out[(size_t)m * 16 + lane] = lf; }
    }
}
__device__ __forceinline__ void combine_rows(const bf16* O0, const bf16* O1, const float* lamp, const float* subg, bf16* dst, int gw, int NGW, int lane) {
    const float pa = lamp[lane] * lamp[64 + lane], pb = lamp[128 + lane] * lamp[192 + lane];
    const float lam = __builtin_amdgcn_exp2f(LOG2E * wave_sum(pa)) - __builtin_amdgcn_exp2f(LOG2E * wave_sum(pb)) + 0.2f;
    float gg[16];
#pragma unroll
    for (int e = 0; e < 16; ++e) gg[e] = subg[16 * (lane & 7) + e] * 0.8f;
    v4u na0, na1, nb0, nb1;
    if (gw < M) { const v4u* p0 = (const v4u*)(O0 + (size_t)gw * D + 16 * lane); const v4u* p1 = (const v4u*)(O1 + (size_t)gw * D + 16 * lane); na0 = p0[0]; na1 = p0[1]; nb0 = p1[0]; nb1 = p1[1]; }
    for (int m = gw; m < M; m += NGW) {
        const v4u a0 = na0, a1 = na1, b0 = nb0, b1 = nb1;
        if (m + NGW < M) { const v4u* p0 = (const v4u*)(O0 + (size_t)(m + NGW) * D + 16 * lane); const v4u* p1 = (const v4u*)(O1 + (size_t)(m + NGW) * D + 16 * lane); na0 = p0[0]; na1 = p0[1]; nb0 = p1[0]; nb1 = p1[1]; }
        float v[16];
#pragma unroll
        for (int i = 0; i < 4; ++i) { v[2 * i] = bf_lo(a0[i]) - lam * bf_lo(b0[i]); v[2 * i + 1] = bf_hi(a0[i]) - lam * bf_hi(b0[i]);
            v[8 + 2 * i] = bf_lo(a1[i]) - lam * bf_lo(b1[i]); v[8 + 2 * i + 1] = bf_hi(a1[i]) - lam * bf_hi(b1[i]); }
        float ss = 0.f;
#pragma unroll
        for (int e = 0; e < 16; ++e) ss += v[e] * v[e];
        ss = xadd<1>(ss); ss = xadd<2>(ss); ss = xadd<4>(ss);
        const float rs = __builtin_amdgcn_rsqf(ss * (1.f / 128.f) + EPS);
        v4u o0, o1;
#pragma unroll
        for (int i = 0; i < 4; ++i) { o0[i] = pk2(v[2 * i] * rs * gg[2 * i], v[2 * i + 1] * rs * gg[2 * i + 1]); o1[i] = pk2(v[8 + 2 * i] * rs * gg[8 + 2 * i], v[8 + 2 * i + 1] * rs * gg[8 + 2 * i + 1]); }
        v4u* q = (v4u*)(dst + (size_t)m * D + 16 * lane); q[0] = o0; q[1] = o1;
    }
}
__device__ __forceinline__ void scan_seq(int seq, const float* logf_in, float* nf2, LAS unsigned char* lds, int tid) {
    const int b = seq >> 4, hh = seq & 15, s0 = 16 * tid, lane = tid & 63, wave = tid >> 6;
    float v[16]; float run = 0.f;
#pragma unroll
    for (int i = 0; i < 16; ++i) { run += logf_in[((size_t)(b * T + s0 + i)) * 16 + hh]; v[i] = run; }
    float incl = run;
#pragma unroll
    for (int o = 1; o < 64; o <<= 1) { const float t = __int_as_float(__builtin_amdgcn_ds_bpermute((lane - o) << 2, __float_as_int(incl))); if (lane >= o) incl += t; }
    LAS float* wt = (LAS float*)lds;
    if (lane == 63) wt[wave] = incl;
    __syncthreads();
    float off = incl - run;
    for (int w = 0; w < wave; ++w) off += wt[w];
#pragma unroll
    for (int i = 0; i < 16; ++i) nf2[(size_t)seq * T + s0 + i] = -(off + v[i]) * LOG2E;
    __syncthreads();
}

__device__ __forceinline__ void kmax_rows(const bf16* KB, float* kpart, LAS unsigned char* lds, int gw, int NGW, int tid, int lane, int bx) {
    LAS unsigned* lm = (LAS unsigned*)lds;
    if (tid < 64) lm[tid] = 0u;
    __syncthreads();
    float run = 0.f; int cb = -1;
    v4u ka0 = {0u, 0u, 0u, 0u}, ka1 = ka0;
    if (gw < M) { const v4u* p0_ = (const v4u*)(KB + (size_t)gw * D + 16 * lane); ka0 = p0_[0]; ka1 = p0_[1]; }
    for (int m = gw; m < M; m += NGW) {
        const int b = m >> 13;
        if (b != cb) { if (cb >= 0 && (lane & 3) == 0) atomicMax((unsigned*)(lm + cb * 16 + (lane >> 2)), __float_as_uint(run)); run = 0.f; cb = b; }
        const v4u a0 = ka0, a1 = ka1;
        if (m + NGW < M) { const v4u* pn_ = (const v4u*)(KB + (size_t)(m + NGW) * D + 16 * lane); ka0 = pn_[0]; ka1 = pn_[1]; }
        float ss = 0.f;
#pragma unroll
        for (int i = 0; i < 4; ++i) { const float x0 = bf_lo(a0[i]), x1 = bf_hi(a0[i]), x2 = bf_lo(a1[i]), x3 = bf_hi(a1[i]); ss += (x0 * x0 + x1 * x1) + (x2 * x2 + x3 * x3); }
        ss = xadd<1>(ss); ss = xadd<2>(ss);
        run = fmaxf(run, ss);
    }
    if (cb >= 0 && (lane & 3) == 0) atomicMax((unsigned*)(lm + cb * 16 + (lane >> 2)), __float_as_uint(run));
    __syncthreads();
    if (tid < 64) kpart[(size_t)bx * 64 + tid] = __uint_as_float(lm[tid]);
    __syncthreads();
}

struct Args { const float* in[21]; float* out; unsigned char* ws; int pad0, pad1; };
enum { K_PRO = 0, K_NORM, K_SWIGLU, K_RESID, K_SPLIT, K_ATTNA, K_COMB, K_NORMKV, K_ATTNB, K_RESIDN, K_NOP };
constexpr int NPH = 23;

__global__ void __launch_bounds__(NWAVES * 64, 2) skel_fwd(Args args) {
    extern __shared__ __attribute__((aligned(16))) unsigned char lds[];
    cg::grid_group grid = cg::this_grid();
    LAS unsigned char* ldsL = (LAS unsigned char*)lds;
    typedef __attribute__((address_space(4))) const Args CArgs;
    {   volatile LAS unsigned* bst0 = (volatile LAS unsigned*)(ldsL + RING_BYTES + 512);
        if (threadIdx.x < 2) bst0[threadIdx.x] = 0u;
        if (blockIdx.x == 0) { unsigned* bw = (unsigned*)(args.ws + WS_BAR); for (int i = threadIdx.x; i < XCD_BAR_WORDS; i += NWAVES * 64) bw[i] = 0u;
            unsigned* cw = (unsigned*)(args.ws + WS_CNT); for (int i = threadIdx.x; i < 5 * 128 * 64; i += NWAVES * 64) cw[i] = 0u; }
        __syncthreads(); }
    int prep = 0;
    const int wave_s = __builtin_amdgcn_readfirstlane(threadIdx.x >> 6);
#pragma nounroll
    for (int ph = 0; ph < NPH; ++ph) {
        CArgs* ap = (CArgs*)__builtin_amdgcn_kernarg_segment_ptr();
        asm volatile("" : "+s"(ap));
        const int wave = wave_s;
#define TID() opq_tid(wave_s)
        int G = gridDim.x, bx = blockIdx.x; asm volatile("" : "+s"(G), "+s"(bx));
        const int vcu = (G % 8 == 0) ? (bx % 8) * (G / 8) + bx / 8 : bx;
        const int gw = vcu * NWAVES + wave, NGW = G * NWAVES;
        unsigned char* ws = ap->ws;
        const float* x = ap->in[0];
        float* OUTF = ap->out; bf16* XB = (bf16*)ap->out;
        bf16* XB2 = (bf16*)(ws + WS_XN2);
        float* mod = (float*)(ws + WS_MOD);
        float* kvmod = mod + 8 * NMOD;
        float* logfb = (float*)(ws + WS_LOGF);
        float* nf2 = (float*)(ws + WS_NF2);
        bf16* XN = (bf16*)(ws + WS_XN); bf16* XN2 = (bf16*)(ws + WS_XN2);
        bf16* R1 = (bf16*)(ws + WS_R1); bf16* R2 = (bf16*)(ws + WS_R2);
        const float* norm_g = ap->in[4];
        int kind = K_NORM; bool sync_after = true;
        const bf16* gA = XN; const bf16* gB = nullptr; int gN = D, gK = D;
        const float* nsrc = x; const float* ng = norm_g; const float* nsh = mod; const float* nsc = mod;
        const void* rbase = XB; int rbase_bf = 1; bf16* rout = XB; const float* rgate = mod; float rcoef = 0.5f;
        bf16* sO = R1; float sscale = 1.f;
        int bank = 0, fin = 0;
        const int L = (ph >= 12) ? 1 : 0;
        unsigned char* wl = ws + (L ? WS_WB : WS_WA);
        const float* modl = mod + (size_t)L * 4 * NMOD;
        switch (ph) {
            case 0: kind = K_PRO; break;
            case 1: kind = K_NORM; nsrc = x; ng = norm_g; nsh = modl; nsc = modl + D; break;
            case 2: kind = K_SWIGLU; gB = (const bf16*)(wl + WO_IN0); gN = NIN; gK = D; break;
            case 3: kind = K_RESIDN; gA = R1; gB = (const bf16*)(wl + WO_OUT0); gN = D; gK = FF; rbase = x; rbase_bf = 0; rgate = modl + 2 * D; rcoef = 0.5f; bank = 0; ng = norm_g + D; nsh = modl + 3 * D; nsc = modl + 4 * D; break;
            case 4: kind = K_NOP; sync_after = false; break;
            case 5: kind = K_SPLIT; gB = (const bf16*)(wl + WO_X1); gN = 3 * D; gK = D; sO = R1; sscale = attn_body::C2; break;
            case 6: kind = K_ATTNA; break;
            case 7: kind = K_NOP; sync_after = false; break;
            case 8: kind = K_RESIDN; gA = R1; gB = (const bf16*)(wl + WO_AWO); gN = D; gK = D; rgate = modl + 5 * D; rcoef = 1.f; bank = 1; ng = norm_g + 2 * D; nsh = modl + 6 * D; nsc = modl + 7 * D; break;
            case 9: kind = K_NOP; sync_after = false; break;
            case 10: kind = K_SWIGLU; gB = (const bf16*)(wl + WO_IN1); gN = NIN; gK = D; break;
            case 11: kind = K_RESID; gA = R1; gB = (const bf16*)(wl + WO_OUT1); gN = D; gK = FF; rgate = modl + 8 * D; rcoef = 0.5f; break;
            case 12: kind = K_NORMKV; break;
            case 13: kind = K_SPLIT; gB = (const bf16*)(wl + WO_X1); gN = 2 * D; gK = D; sO = R2; sscale = 1.f; sync_after = false; break;
            case 14: kind = K_SWIGLU; gA = XN2; gB = (const bf16*)(wl + WO_IN0); gN = NIN; gK = D; break;
            case 15: kind = K_RESIDN; gA = R1; gB = (const bf16*)(wl + WO_OUT0); gN = D; gK = FF; rgate = modl + 2 * D; rcoef = 0.5f; bank = 2; ng = norm_g + 4 * D; nsh = modl + 3 * D; nsc = modl + 4 * D; break;
            case 16: kind = K_NOP; sync_after = false; break;
            case 17: kind = K_SPLIT; gB = (const bf16*)(wl + WO_BWQ); gN = D; gK = D; sO = R1; sscale = attn_body::C2; break;
            case 18: kind = K_ATTNB; break;
            case 19: kind = K_RESIDN; gA = R1; gB = (const bf16*)(wl + WO_BWO); gN = D; gK = D; rgate = modl + 5 * D; rcoef = 1.f; bank = 3; rout = XB2; ng = norm_g + 5 * D; nsh = modl + 6 * D; nsc = modl + 7 * D; break;
            case 20: kind = K_NOP; sync_after = false; break;
            case 21: kind = K_SWIGLU; gB = (const bf16*)(wl + WO_IN1); gN = NIN; gK = D; break;
            case 22: kind = K_RESIDN; gA = R1; gB = (const bf16*)(wl + WO_OUT1); gN = D; gK = FF; rgate = modl + 8 * D; rcoef = 0.5f; bank = 4; fin = 1; rbase = XB2; ng = ap->in[20]; sync_after = false; break;
            default: kind = K_NOP; sync_after = false; break;
        }
#ifndef PROBE_REP
#define PROBE_REP 0
#endif
#ifndef PROBE_SYNC
#define PROBE_SYNC 1
#endif
        if (kind == K_PRO) {
            if (bx == 0 && TID() == 0) *(unsigned*)(ws + WS_QCTR) = 0u;
            if (PROBE_REP != 0 && bx == 1 && TID() == 0) ((unsigned*)(ws + WS_QCTR))[1] = 0u;
            for (int it = bx; it < 80; it += G) p0_mod_item(it, ap->in[1], ap->in[2], ap->in[3], ap->in[12], ap->in[13], mod, ldsL, TID());
            LAS float* scr = (LAS float*)(ldsL + wave * 16384);
            constexpr int I_IN = (D / 64) * (NIN / 32), I_OUT = (FF / 64) * (D / 32), I_QKV = (D / 64) * (3 * D / 32), I_SQ = (D / 64) * (D / 32), I_KV = (D / 64) * (2 * D / 32);
            constexpr int NITEMS = 4 * I_IN + 4 * I_OUT + I_QKV + I_SQ + I_KV + 2 * I_SQ;
            for (int it = gw; it < NITEMS; it += NGW) {
                int r = it; const float* W; int K, N, perm = 0; bf16* WT;
                if (r < 4 * I_IN) { const int w = r / I_IN; r -= w * I_IN; W = ap->in[5] + (size_t)w * D * NIN; K = D; N = NIN; perm = 1;
                    WT = (bf16*)(ws + ((w >> 1) ? WS_WB : WS_WA) + ((w & 1) ? WO_IN1 : WO_IN0)); }
                else if ((r -= 4 * I_IN) < 4 * I_OUT) { const int w = r / I_OUT; r -= w * I_OUT; W = ap->in[6] + (size_t)w * FF * D; K = FF; N = D;
                    WT = (bf16*)(ws + ((w >> 1) ? WS_WB : WS_WA) + ((w & 1) ? WO_OUT1 : WO_OUT0)); }
                else if ((r -= 4 * I_OUT) < I_QKV) { W = ap->in[7]; K = D; N = 3 * D; WT = (bf16*)(ws + WS_WA + WO_X1); }
                else if ((r -= I_QKV) < I_SQ) { W = ap->in[8]; K = D; N = D; WT = (bf16*)(ws + WS_WA + WO_AWO); }
                else if ((r -= I_SQ) < I_KV) { W = ap->in[15]; K = D; N = 2 * D; WT = (bf16*)(ws + WS_WB + WO_X1); }
                else if ((r -= I_KV) < I_SQ) { W = ap->in[18]; K = D; N = D; WT = (bf16*)(ws + WS_WB + WO_BWQ); }
                else { r -= I_SQ; W = ap->in[19]; K = D; N = D; WT = (bf16*)(ws + WS_WB + WO_BWO); }
                p0_transpose_item(W, K, N, WT, perm, scr, r, TID() & 63);
            }
        } else if (kind == K_NORM) {
            norm_rows(nsrc, ng, nsh, nsc, NMOD, XN, gw, NGW, TID() & 63);
        } else if (kind == K_NORMKV) {
            LAS float* fgT = (LAS float*)ldsL;
            for (int i = TID(); i < 16 * D; i += NWAVES * 64) { const int c = i >> 4, hh = i & 15; fgT[hh * 1024 + c] = ap->in[16][i]; }
            __syncthreads();
            norm_rows_kv(XB, ap->in[14], kvmod, kvmod + D, 2 * D, XN, norm_g + 3 * D, modl, modl + D, NMOD, XN2, fgT, ap->in[17], logfb, gw, NGW, TID() & 63);
            __syncthreads();
        } else if (kind == K_SWIGLU) {
            pg8::Gemm g{gA, gB, M, gN, gK}; pg8::StaticOrder S; S.init(M, gN, G, bx);
            pg8::EpiSwiglu E{R1, FF};
            pg8::gemm_phase<pg8::EpiSwiglu, pg8::StaticOrder, true, true>(ldsL, g, S, E, TID());
        } else if (kind == K_RESID) {
            pg8::Gemm g{gA, gB, M, gN, gK}; pg8::StaticOrder S; S.init(M, gN, G, bx);
            pg8::EpiResid E{(const bf16*)rbase, rout, rgate, NMOD, rcoef};
            pg8::gemm_phase<pg8::EpiResid, pg8::StaticOrder, true, true>(ldsL, g, S, E, TID());
        } else if (kind == K_RESIDN) {
            pg8::Gemm g{gA, gB, M, D, gK}; pg8::StaticOrder S; S.init(M, D, G, bx);
            pg8::RmsStats st{(unsigned*)(ws + WS_XBUF), (unsigned*)(ws + WS_CNT) + (size_t)bank * 128 * 64, EPS};
#define RUN_RESIDN(BH, FN) do { pg8::EpiResidNorm<BH, FN> E{rbase, rout, OUTF, rgate, NMOD, rcoef, ng, nsh, nsc, NMOD, XN, st, ldsL + RING_BYTES + 1024}; \
                pg8::gemm_phase<pg8::EpiResidNorm<BH, FN>, pg8::StaticOrder, true, true>(ldsL, g, S, E, TID()); } while (0)
            if (fin) RUN_RESIDN(true, true); else if (rbase_bf) RUN_RESIDN(true, false); else RUN_RESIDN(false, false);
#undef RUN_RESIDN
        } else if (kind == K_SPLIT) {
            if (ph == 17) { const int t_ = TID(); kmax_rows(R2, (float*)(ws + WS_KPART), ldsL, gw, NGW, t_, t_ & 63, bx); }
            pg8::Gemm g{gA, gB, M, gN, gK}; pg8::StaticOrder S; S.init(M, gN, G, bx);
            pg8::EpiBf16<0> E{sO, D, nullptr, D, BUF64 / 2, sscale};
            pg8::gemm_phase<pg8::EpiBf16<0>, pg8::StaticOrder, true, true>(ldsL, g, S, E, TID());
            if (ph == 13) { for (int seq = bx; seq < 64; seq += G) scan_seq(seq, logfb, nf2, ldsL, TID()); }
        } else if (kind == K_ATTNA) {
            const attn_body::bf16* Qp = (const attn_body::bf16*)R1; const attn_body::bf16* Kp = Qp + BUF64 / 2; const attn_body::bf16* Vp = Kp + BUF64 / 2;
            attn_body::bf16* O0 = (attn_body::bf16*)R2;
            float lam;
            { const float* lamp = ap->in[9]; const int l_ = TID() & 63; const float pa = lamp[l_] * lamp[64 + l_], pb = lamp[128 + l_] * lamp[192 + l_];
              lam = __builtin_amdgcn_exp2f(LOG2E * wave_sum(pa)) - __builtin_amdgcn_exp2f(LOG2E * wave_sum(pb)) + 0.2f;
              lam = __int_as_float(__builtin_amdgcn_readfirstlane(__float_as_int(lam))); }
            for (int pi = vcu; pi < 512; pi += G) { const int combo = pi >> 4, s = pi & 15, b = combo >> 3, hd = combo & 7;
                const int vc = hd * 128;
                for (int k = 0; k < 2; ++k) { const int qb = k ? s : 31 - s;
                    attn_body::attn_unit_w<8, false>(b, (2 * hd) * 64, (2 * hd) * 64, vc, vc, qb, Qp, Kp, Vp, O0, (char*)lds, ap->in[11], hd, nullptr, 0, TID(), nullptr, 0.f, nullptr);
                    attn_body::attn_unit_w<8, true>(b, (2 * hd + 1) * 64, (2 * hd + 1) * 64, vc, vc, qb, Qp, Kp, Vp, (attn_body::bf16*)R1, (char*)lds, ap->in[11], hd, nullptr, 0, TID(), O0, lam, ap->in[10]); } }
        } else if (kind == K_ATTNB) {
            const attn_body::bf16* Qp = (const attn_body::bf16*)R1; const attn_body::bf16* Kp = (const attn_body::bf16*)R2; const attn_body::bf16* Vp = Kp + BUF64 / 2;
            LAS int* ordl = (LAS int*)(ldsL + RING_BYTES); LAS unsigned* slotl = (LAS unsigned*)(ldsL + RING_BYTES + 256);
            if (wave == 0) { const int lane = TID() & 63; const float v = nf2[(size_t)lane * T + T - 1]; int rank = 0;
                for (int j = 0; j < 64; ++j) { const float vj = __int_as_float(__builtin_amdgcn_readlane(__float_as_int(v), j)); rank += (vj < v || (vj == v && j < lane)) ? 1 : 0; }
                ordl[rank] = lane; }
            __syncthreads();
            unsigned* qctr = (unsigned*)(ws + WS_QCTR) + (PROBE_REP ? prep : 0);
            for (;;) {
                if (TID() == 0) slotl[0] = atomicAdd(qctr, 1u);
                __syncthreads();
                const unsigned u = slotl[0];
                __syncthreads();
                if (u >= 2048u) break;
                const int combo = ordl[u >> 5], qb = 31 - (int)(u & 31u), b = combo >> 4, h = combo & 15;
                attn_body::attn_unit<8, 1>(b, h * 64, h * 64, h * 64, h * 64, qb, Qp, Kp, Vp, (attn_body::bf16*)R1, (char*)lds, nf2 + (size_t)combo * T, 0, (const float*)(ws + WS_KPART) + combo, G, TID());
            }
        } else if (kind == K_COMB) {
            combine_rows(R2, R2 + BUF64 / 2, ap->in[9], ap->in[10], R1, gw, NGW, TID() & 63);
        }
        if (PROBE_REP != 0 && prep == 0 && ((PROBE_REP >> kind) & 1) && kind != K_RESID && kind != K_RESIDN && kind != K_NOP) { prep = 1; --ph; if (ph < 0) { grid.sync(); } else { XcdBarrier bar; bar.bar = (unsigned*)(ws + WS_BAR); bar.x = xb_xcc_id(); bar.st = (volatile LAS unsigned*)(ldsL + RING_BYTES + 512); xcd_barrier(bar, TID()); } continue; }
        prep = 0;
        if (sync_after) {
            XcdBarrier bar; bar.bar = (unsigned*)(ws + WS_BAR); bar.x = xb_xcc_id(); bar.st = (volatile LAS unsigned*)(ldsL + RING_BYTES + 512);
            if (ph == 0) { grid.sync(); if (TID() == 0) (void)xb_add(&bar.bar[XB_XCNT(bar.x)], 1u); }
            else { for (int sy = 0; sy < PROBE_SYNC; ++sy) xcd_barrier(bar, TID()); }
        }
    }
}

extern "C" void kernel_launch(void* const* d_in, const int* in_sizes, int n_in, void* d_out, int out_size, void* d_ws, size_t ws_size, hipStream_t stream) {
    static int grid = 0;
    if (grid == 0) {
        if (n_in != 21 || in_sizes[0] != M * D || out_size != M * D || ws_size < WS_END) { fprintf(stderr, "kernel_launch: unexpected shapes (n_in %d in0 %d out %d ws %zu); nothing launched\n", n_in, n_in > 0 ? in_sizes[0] : -1, out_size, ws_size); grid = -1; return; }
        int dev = 0, cus = 0, per_cu = 0;
        (void)hipGetDevice(&dev);
        (void)hipDeviceGetAttribute(&cus, hipDeviceAttributeMultiprocessorCount, dev);
        (void)hipFuncSetAttribute((const void*)skel_fwd, hipFuncAttributeMaxDynamicSharedMemorySize, LDS_BYTES);
        (void)hipOccupancyMaxActiveBlocksPerMultiprocessor(&per_cu, (const void*)skel_fwd, NWAVES * 64, LDS_BYTES);
        if (per_cu < 1) per_cu = 1;
        grid = cus * per_cu;
    }
    if (grid < 0) return;
    Args a{};
    for (int i = 0; i < 21; ++i) a.in[i] = (const float*)d_in[i];
    a.out = (float*)d_out; a.ws = (unsigned char*)d_ws;
    void* kargs[] = {&a};
    hipError_t e = hipLaunchCooperativeKernel((const void*)skel_fwd, dim3(grid), dim3(NWAVES * 64), kargs, LDS_BYTES, stream);
    if (e != hipSuccess) fprintf(stderr, "cooperative launch failed: %s (grid %d)\n", hipGetErrorString(e), grid);
}
```

```cpp
#include <hip/hip_cooperative_groups.h>
#include <hip/hip_runtime.h>
#include <cstdio>
#include <cstdint>
__device__ __forceinline__ int opq_tid(int wave_s) { int l; asm volatile("v_mbcnt_lo_u32_b32 %0, -1, 0\n\tv_mbcnt_hi_u32_b32 %0, -1, %0" : "=v"(l)); return (wave_s << 6) | l; }
template <int O> __device__ __forceinline__ float xlane_partner_lt32(float v) { return __int_as_float(__builtin_amdgcn_ds_swizzle(__float_as_int(v), (O << 10) | 0x1f)); }
template <int O> __device__ __forceinline__ float xadd(float v) {
    if constexpr (O == 32) { auto rr = __builtin_amdgcn_permlane32_swap(__float_as_uint(v), __float_as_uint(v), false, false); return __uint_as_float(rr[0]) + __uint_as_float(rr[1]); }
    else return v + xlane_partner_lt32<O>(v); }
template <int O> __device__ __forceinline__ float xmax(float v) {
    if constexpr (O == 32) { auto rr = __builtin_amdgcn_permlane32_swap(__float_as_uint(v), __float_as_uint(v), false, false); return fmaxf(__uint_as_float(rr[0]), __uint_as_float(rr[1])); }
    else return fmaxf(v, xlane_partner_lt32<O>(v)); }
__device__ __forceinline__ float wave_sum64(float v) { v = xadd<1>(v); v = xadd<2>(v); v = xadd<4>(v); v = xadd<8>(v); v = xadd<16>(v); return xadd<32>(v); }
__device__ __forceinline__ float wave_max32(float v) { v = xmax<1>(v); v = xmax<2>(v); v = xmax<4>(v); v = xmax<8>(v); return xmax<16>(v); }
__device__ __forceinline__ float wave_max64(float v) { return xmax<32>(wave_max32(v)); }
namespace pg8 {
#define PG8_LAS __attribute__((address_space(3)))
typedef unsigned short bf16_t;
typedef short bf16x8 __attribute__((ext_vector_type(8)));
typedef float f32x4 __attribute__((ext_vector_type(4)));
typedef unsigned u32x4 __attribute__((ext_vector_type(4)));
constexpr int BM = 256, BK = 64, HALF = 128, HTB = HALF * BK * 2  , STAGE_BYTES = 8 * HTB, NXCD = 8, WGM = 8;

__host__ __device__ __forceinline__ int lds_byte(int r, int c) { const int st = (r >> 4) * 2 + (c >> 5), rr = r & 15, cc = c & 31, ob = rr * 64 + cc * 2; return st * 1024 + (ob ^ (((ob >> 9) & 1) << 5)); }
__host__ __device__ __forceinline__ void stage_rc(int b, int& R, int& C) { const int st = b / 1024, sb = b % 1024, swz = sb ^ (((sb >> 9) & 1) << 5); R = (st >> 1) * 16 + swz / 64; C = (st & 1) * 32 + (swz % 64) / 2; }
__host__ __device__ __forceinline__ int perm32(int rho) { const int n = rho >> 4, i = rho & 15; return 8 * (i >> 2) + 4 * n + (i & 3); }

struct Unit { int pm, pn; };
struct Gemm { const bf16_t* A; const bf16_t* Bt; int M, N, K; };

struct StaticOrder {
    int nM, nN, nwg, G, c;
    __host__ __device__ void init(int M, int N, int G_, int c_) { nM = M / BM; nN = N / BM; nwg = nM * nN; G = G_; c = c_; }
    __host__ __device__ bool next(int i, Unit& u) const {
        const long L = (long)i * G + c; if (L >= nwg) return false;
        int wgid = (int)L; { const int q = nwg / NXCD, r = nwg % NXCD, xcd = wgid % NXCD, off = wgid / NXCD; wgid = (xcd < r ? xcd * (q + 1) : r * (q + 1) + (xcd - r) * q) + off; }
        const int nig = WGM * nN, gid = wgid / nig, fm = gid * WGM, gsz = (nM - fm) < WGM ? (nM - fm) : WGM;
        u.pm = fm + ((wgid % nig) % gsz); u.pn = (wgid % nig) / gsz; return true;
    }
    __device__ __forceinline__ void a_ready(const Unit&) const {}
    __device__ __forceinline__ void done(const Unit&) const {}
};

__device__ __forceinline__ unsigned cvt_pk_bf16(float lo, float hi) { unsigned r; asm volatile("v_cvt_pk_bf16_f32 %0, %1, %2" : "=v"(r) : "v"(lo), "v"(hi)); return r; }
typedef float f32x2 __attribute__((ext_vector_type(2)));
__device__ __forceinline__ f32x2 gelu_pk(f32x2 v) {
    const f32x2 av = __builtin_elementwise_abs(v), d = av * 0.2316418882f + 1.0f;
    f32x2 t; t.x = __builtin_amdgcn_rcpf(d.x); t.y = __builtin_amdgcn_rcpf(d.y);
    f32x2 q = t * 0.5307027145f + (-0.7265760135f); q = q * t + 0.7107068705f; q = q * t + (-0.142248368f); q = q * t + 0.127414796f; q = q * t;
    const f32x2 s = (v * v) * (-0.72134752044f);
    f32x2 e; e.x = __builtin_amdgcn_exp2f(s.x); e.y = __builtin_amdgcn_exp2f(s.y);
    const f32x2 m = v * (q * e), r = v - m;
    f32x2 o; o.x = v.x < 0.f ? m.x : r.x; o.y = v.y < 0.f ? m.y : r.y; return o;
}

template <int ACT  > struct EpiBf16 {
    static constexpr bool PERM = true, AFTER_DRAIN = false; static_assert(ACT == 0 || ACT == 1, "EpiBf16: ACT is 0 (none) or 1 (gelu_pk)");
    bf16_t* O; int ldc; const float* bias; int split_cols; size_t split_stride; float scale0;
    __device__ __forceinline__ void operator()(const f32x4 (&acc)[2][2][4][2], const Unit& u, int wr, int wc, int fr, int fq) const {
        const int row0 = u.pm * BM + wr * 64 + fr; int colt = u.pn * BM; bf16_t* base = O;
        float sc = 1.f; if (split_cols) { const int t = colt / split_cols; base += (size_t)t * split_stride; colt -= t * split_cols; if (t == 0) sc = scale0; }
        const int col0 = colt + wc * 32 + 8 * fq, bcol0 = u.pn * BM + wc * 32 + 8 * fq;
        f32x4 bv[2][2];
#pragma unroll
        for (int bj = 0; bj < 2; ++bj)
#pragma unroll
            for (int n = 0; n < 2; ++n) bv[bj][n] = bias ? *(const f32x4*)(bias + bcol0 + bj * HALF + 4 * n) : (f32x4){0.f, 0.f, 0.f, 0.f};
#pragma unroll
        for (int ai = 0; ai < 2; ++ai)
#pragma unroll
            for (int m = 0; m < 4; ++m) { bf16_t* rowp = base + (size_t)(row0 + ai * HALF + m * 16) * ldc + col0;
#pragma unroll
                for (int bj = 0; bj < 2; ++bj) { f32x4 v0 = acc[ai][bj][m][0] + bv[bj][0], v1 = acc[ai][bj][m][1] + bv[bj][1];
                    if (ACT == 1) { f32x2 a = gelu_pk((f32x2){v0[0], v0[1]}), b = gelu_pk((f32x2){v0[2], v0[3]}), c = gelu_pk((f32x2){v1[0], v1[1]}), d = gelu_pk((f32x2){v1[2], v1[3]});
                        v0 = (f32x4){a.x, a.y, b.x, b.y}; v1 = (f32x4){c.x, c.y, d.x, d.y}; }
                    v0 = v0 * sc; v1 = v1 * sc; u32x4 w; w.x = cvt_pk_bf16(v0[0], v0[1]); w.y = cvt_pk_bf16(v0[2], v0[3]); w.z = cvt_pk_bf16(v1[0], v1[1]); w.w = cvt_pk_bf16(v1[2], v1[3]);
                    *(u32x4*)(rowp + bj * HALF) = w; } }
    }
};

struct EpiSwiglu {
    static constexpr bool PERM = true, AFTER_DRAIN = false;
    bf16_t* H; int ldh;
    __device__ __forceinline__ void operator()(const f32x4 (&acc)[2][2][4][2], const Unit& u, int wr, int wc, int fr, int fq) const {
        const int row0 = u.pm * BM + wr * 64 + fr, col0 = u.pn * HALF + wc * 32 + 8 * fq;
#pragma unroll
        for (int ai = 0; ai < 2; ++ai)
#pragma unroll
            for (int m = 0; m < 4; ++m) { bf16_t* rowp = H + (size_t)(row0 + ai * HALF + m * 16) * ldh + col0;
                float hv[8];
#pragma unroll
                for (int n = 0; n < 2; ++n)
#pragma unroll
                    for (int i = 0; i < 4; ++i) { const float g = acc[ai][0][m][n][i], uu = acc[ai][1][m][n][i];
                        const float sg = g * __builtin_amdgcn_rcpf(1.0f + __builtin_amdgcn_exp2f(-1.4426950408889634f * g)); hv[4 * n + i] = sg * uu; }
                u32x4 w; w.x = cvt_pk_bf16(hv[0], hv[1]); w.y = cvt_pk_bf16(hv[2], hv[3]); w.z = cvt_pk_bf16(hv[4], hv[5]); w.w = cvt_pk_bf16(hv[6], hv[7]);
                *(u32x4*)rowp = w; }
    }
};
typedef _Float16 h16x2_t __attribute__((ext_vector_type(2)));
typedef float f32x2s_t __attribute__((ext_vector_type(2)));
__device__ __forceinline__ unsigned pk_h2(float a, float b) { f32x2s_t v = {__builtin_fminf(__builtin_fmaxf(a, -65504.f), 65504.f), __builtin_fminf(__builtin_fmaxf(b, -65504.f), 65504.f)}; h16x2_t h = __builtin_convertvector(v, h16x2_t); return __builtin_bit_cast(unsigned, h); }
__device__ __forceinline__ f32x2s_t up_h2(unsigned w) { h16x2_t h = __builtin_bit_cast(h16x2_t, w); return __builtin_convertvector(h, f32x2s_t); }
__device__ __forceinline__ f32x4 bfx4_lo(const u32x4& w) { const f32x2s_t a = up_h2(w.x), b = up_h2(w.y); return (f32x4){a.x, a.y, b.x, b.y}; }
__device__ __forceinline__ f32x4 bfx4_hi(const u32x4& w) { const f32x2s_t a = up_h2(w.z), b = up_h2(w.w); return (f32x4){a.x, a.y, b.x, b.y}; }
struct EpiResid {
    static constexpr bool PERM = true, AFTER_DRAIN = false;
    const bf16_t* base; bf16_t* out; const float* gate; int gstride; float coef;
    __device__ __forceinline__ void operator()(const f32x4 (&acc)[2][2][4][2], const Unit& u, int wr, int wc, int fr, int fq) const {
        const int row0 = u.pm * BM + wr * 64 + fr, col0 = u.pn * BM + wc * 32 + 8 * fq;
        const float* gp = gate + (size_t)((u.pm * BM) >> 13) * gstride + col0;
        f32x4 gv[2][2];
#pragma unroll
        for (int bj = 0; bj < 2; ++bj)
#pragma unroll
            for (int n = 0; n < 2; ++n) gv[bj][n] = *(const f32x4*)(gp + bj * HALF + 4 * n) * coef;
        u32x4 bwa[2][4][2];
#pragma unroll
        for (int ai = 0; ai < 2; ++ai)
#pragma unroll
            for (int m = 0; m < 4; ++m)
#pragma unroll
                for (int bj = 0; bj < 2; ++bj) bwa[ai][m][bj] = *(const u32x4*)(base + (size_t)(row0 + ai * HALF + m * 16) * 1024 + col0 + bj * HALF);
#pragma unroll
        for (int ai = 0; ai < 2; ++ai)
#pragma unroll
            for (int m = 0; m < 4; ++m) { const size_t off = (size_t)(row0 + ai * HALF + m * 16) * 1024 + col0;
#pragma unroll
                for (int bj = 0; bj < 2; ++bj) { const u32x4 bw = bwa[ai][m][bj];
                    const f32x4 v0 = bfx4_lo(bw) + gv[bj][0] * acc[ai][bj][m][0], v1 = bfx4_hi(bw) + gv[bj][1] * acc[ai][bj][m][1];
                    u32x4 w; w.x = pk_h2(v0[0], v0[1]); w.y = pk_h2(v0[2], v0[3]); w.z = pk_h2(v1[0], v1[1]); w.w = pk_h2(v1[2], v1[3]);
                    *(u32x4*)(out + off + bj * HALF) = w; } }
    }
};
struct OneUnit { int pm, pn;
    __device__ __forceinline__ bool next(int i, Unit& u) const { if (i) return false; u.pm = pm; u.pn = pn; return true; }
    __device__ __forceinline__ void a_ready(const Unit&) const {}
    __device__ __forceinline__ void done(const Unit&) const {} };
struct RmsStats {
    unsigned* xbuf;
    unsigned* cnt;
    float eps;
    __device__ __forceinline__ void run(const f32x4 (&v)[2][2][4][2], const Unit& u, int wr, int wc, int fr, int fq, PG8_LAS unsigned char* lds, int wid, int lane) const {
        PG8_LAS float* P = (PG8_LAS float*)lds;
        PG8_LAS float* S = (PG8_LAS float*)(lds + 8192);
#pragma unroll
        for (int ai = 0; ai < 2; ++ai)
#pragma unroll
            for (int m = 0; m < 4; ++m) { float q = 0.f;
#pragma unroll
                for (int bj = 0; bj < 2; ++bj)
#pragma unroll
                    for (int n = 0; n < 2; ++n) { const f32x4 x = v[ai][bj][m][n]; q += (x[0] * x[0] + x[1] * x[1]) + (x[2] * x[2] + x[3] * x[3]); }
                q = xadd<16>(q); q = xadd<32>(q);
                if (fq == 0) P[(ai * HALF + wr * 64 + m * 16 + fr) * 4 + wc] = q; }
        asm volatile("s_waitcnt lgkmcnt(0)" ::: "memory"); __builtin_amdgcn_s_barrier(); asm volatile("" ::: "memory");
        const int row = wid * 32 + (lane & 31);
        if (lane < 32) { const float s = (P[row * 4 + 0] + P[row * 4 + 1]) + (P[row * 4 + 2] + P[row * 4 + 3]);
            __hip_atomic_store(xbuf + ((size_t)(u.pm * BM + row) * 4 + u.pn), __float_as_uint(s), __ATOMIC_RELAXED, __HIP_MEMORY_SCOPE_AGENT); }
        asm volatile("s_waitcnt vmcnt(0)" ::: "memory");
        if (lane == 0) __hip_atomic_fetch_add(cnt + 64 * u.pm, 1u, __ATOMIC_RELAXED, __HIP_MEMORY_SCOPE_AGENT);
        if (wid == 0) { unsigned sp = 0;
            while ((unsigned)__builtin_amdgcn_readfirstlane(__hip_atomic_load(cnt + 64 * u.pm, __ATOMIC_RELAXED, __HIP_MEMORY_SCOPE_AGENT)) < 32u) { __builtin_amdgcn_s_sleep(2); if (++sp > (1u << 22)) break; }
            __builtin_amdgcn_fence(__ATOMIC_ACQUIRE, "agent"); }
        asm volatile("s_waitcnt vmcnt(0) lgkmcnt(0)" ::: "memory"); __builtin_amdgcn_s_barrier(); asm volatile("" ::: "memory");
        if (lane < 32) { const unsigned* slot = xbuf + (size_t)(u.pm * BM + row) * 4; float t = 0.f;
#pragma unroll
            for (int k = 0; k < 4; ++k) t += __uint_as_float(__hip_atomic_load(slot + k, __ATOMIC_RELAXED, __HIP_MEMORY_SCOPE_AGENT));
            S[row] = __builtin_amdgcn_rsqf(t * (1.0f / 1024.0f) + eps); }
        asm volatile("s_waitcnt lgkmcnt(0)" ::: "memory"); __builtin_amdgcn_s_barrier(); asm volatile("" ::: "memory");
    }
    __device__ __forceinline__ void publish(const f32x4 (&v)[2][2][4][2], const Unit& u, int wr, int wc, int fr, int fq, PG8_LAS unsigned char* lds, int wid, int lane) const {
        PG8_LAS float* P = (PG8_LAS float*)lds;
#pragma unroll
        for (int ai = 0; ai < 2; ++ai)
#pragma unroll
            for (int m = 0; m < 4; ++m) { float q = 0.f;
#pragma unroll
                for (int bj = 0; bj < 2; ++bj)
#pragma unroll
                    for (int n = 0; n < 2; ++n) { const f32x4 x = v[ai][bj][m][n]; q += (x[0] * x[0] + x[1] * x[1]) + (x[2] * x[2] + x[3] * x[3]); }
                q = xadd<16>(q); q = xadd<32>(q);
                if (fq == 0) P[(ai * HALF + wr * 64 + m * 16 + fr) * 4 + wc] = q; }
        asm volatile("s_waitcnt lgkmcnt(0)" ::: "memory"); __builtin_amdgcn_s_barrier(); asm volatile("" ::: "memory");
        const int row = wid * 32 + (lane & 31);
        if (lane < 32) { const float s = (P[row * 4 + 0] + P[row * 4 + 1]) + (P[row * 4 + 2] + P[row * 4 + 3]);
            __hip_atomic_store(xbuf + ((size_t)(u.pm * BM + row) * 4 + u.pn), __float_as_uint(s), __ATOMIC_RELAXED, __HIP_MEMORY_SCOPE_AGENT); }
        asm volatile("s_waitcnt vmcnt(0)" ::: "memory");
        if (lane == 0) __hip_atomic_fetch_add(cnt + 64 * u.pm, 1u, __ATOMIC_RELAXED, __HIP_MEMORY_SCOPE_AGENT);
    }
    __device__ __forceinline__ void collect(const Unit& u, PG8_LAS unsigned char* lds, int wid, int lane) const {
        PG8_LAS float* S = (PG8_LAS float*)(lds + 8192);
        const int row = wid * 32 + (lane & 31);
        if (wid == 0) { unsigned sp = 0;
            while ((unsigned)__builtin_amdgcn_readfirstlane(__hip_atomic_load(cnt + 64 * u.pm, __ATOMIC_RELAXED, __HIP_MEMORY_SCOPE_AGENT)) < 32u) { __builtin_amdgcn_s_sleep(2); if (++sp > (1u << 22)) break; }
            __builtin_amdgcn_fence(__ATOMIC_ACQUIRE, "agent"); }
        asm volatile("s_waitcnt lgkmcnt(0)" ::: "memory"); __builtin_amdgcn_s_barrier(); asm volatile("" ::: "memory");
        if (lane < 32) { const unsigned* slot = xbuf + (size_t)(u.pm * BM + row) * 4; float t = 0.f;
#pragma unroll
            for (int k = 0; k < 4; ++k) t += __uint_as_float(__hip_atomic_load(slot + k, __ATOMIC_RELAXED, __HIP_MEMORY_SCOPE_AGENT));
            S[row] = __builtin_amdgcn_rsqf(t * (1.0f / 1024.0f) + eps); }
        asm volatile("s_waitcnt lgkmcnt(0)" ::: "memory"); __builtin_amdgcn_s_barrier(); asm volatile("" ::: "memory");
    }
};
template <bool BASE_H, bool FIN> struct EpiResidNorm {
    static constexpr bool PERM = true, AFTER_DRAIN = false;
    const void* base; bf16_t* outb; float* outf; const float* gate; int gstride; float coef;
    const float* ng; const float* shift; const float* scale; int mstride; bf16_t* xn; RmsStats st; PG8_LAS unsigned char* tabs;
    __device__ __forceinline__ void operator()(const f32x4 (&acc_c)[2][2][4][2], const Unit& u, int wr, int wc, int fr, int fq) const {
        f32x4 (&acc)[2][2][4][2] = const_cast<f32x4 (&)[2][2][4][2]>(acc_c);
        asm volatile("" : "+v"(fr), "+v"(fq));
        PG8_LAS unsigned char* lds = tabs; const int wid = wr * 4 + wc, lane = fq * 16 + fr;
        const int row0 = u.pm * BM + wr * 64 + fr, col0 = u.pn * BM + wc * 32 + 8 * fq, b = (u.pm * BM) >> 13;
        {   const float* gp = gate + (size_t)b * gstride + col0;
            f32x4 gv[2][2];
#pragma unroll
            for (int bj = 0; bj < 2; ++bj)
#pragma unroll
                for (int n = 0; n < 2; ++n) gv[bj][n] = *(const f32x4*)(gp + bj * HALF + 4 * n) * coef;
            if constexpr (BASE_H) {
                u32x4 bw[2][4][2];
#pragma unroll
                for (int ai = 0; ai < 2; ++ai)
#pragma unroll
                    for (int m = 0; m < 4; ++m)
#pragma unroll
                        for (int bj = 0; bj < 2; ++bj) bw[ai][m][bj] = *(const u32x4*)((const bf16_t*)base + (size_t)(row0 + ai * HALF + m * 16) * 1024 + col0 + bj * HALF);
#pragma unroll
                for (int ai = 0; ai < 2; ++ai)
#pragma unroll
                    for (int m = 0; m < 4; ++m) { const size_t off = (size_t)(row0 + ai * HALF + m * 16) * 1024 + col0;
#pragma unroll
                        for (int bj = 0; bj < 2; ++bj) {
                            acc[ai][bj][m][0] = bfx4_lo(bw[ai][m][bj]) + gv[bj][0] * acc[ai][bj][m][0]; acc[ai][bj][m][1] = bfx4_hi(bw[ai][m][bj]) + gv[bj][1] * acc[ai][bj][m][1];
                        } }
            } else {
#pragma unroll
                for (int ai = 0; ai < 2; ++ai)
#pragma unroll
                    for (int mp = 0; mp < 2; ++mp) { f32x4 bf[2][2][2];
#pragma unroll
                        for (int mm = 0; mm < 2; ++mm)
#pragma unroll
                            for (int bj = 0; bj < 2; ++bj)
#pragma unroll
                                for (int n = 0; n < 2; ++n) bf[mm][bj][n] = *(const f32x4*)((const float*)base + (size_t)(row0 + ai * HALF + (2 * mp + mm) * 16) * 1024 + col0 + bj * HALF + 4 * n);
#pragma unroll
                        for (int mm = 0; mm < 2; ++mm) { const int m = 2 * mp + mm; const size_t off = (size_t)(row0 + ai * HALF + m * 16) * 1024 + col0;
#pragma unroll
                            for (int bj = 0; bj < 2; ++bj) {
                                acc[ai][bj][m][0] = bf[mm][bj][0] + gv[bj][0] * acc[ai][bj][m][0]; acc[ai][bj][m][1] = bf[mm][bj][1] + gv[bj][1] * acc[ai][bj][m][1];
                                if constexpr (!FIN) { const f32x4 v0 = acc[ai][bj][m][0], v1 = acc[ai][bj][m][1];
                                    u32x4 w; w.x = pk_h2(v0[0], v0[1]); w.y = pk_h2(v0[2], v0[3]); w.z = pk_h2(v1[0], v1[1]); w.w = pk_h2(v1[2], v1[3]);
                                    *(u32x4*)(outb + off + bj * HALF) = w; } } }
                        asm volatile("" ::: "memory"); }
            } }
        if constexpr (BASE_H) {
            st.publish(acc, u, wr, wc, fr, fq, lds, wid, lane);
            if constexpr (!FIN) {
#pragma unroll
                for (int ai = 0; ai < 2; ++ai)
#pragma unroll
                    for (int m = 0; m < 4; ++m) { const size_t off = (size_t)(row0 + ai * HALF + m * 16) * 1024 + col0;
#pragma unroll
                        for (int bj = 0; bj < 2; ++bj) { const f32x4 v0 = acc[ai][bj][m][0], v1 = acc[ai][bj][m][1];
                            u32x4 w; w.x = pk_h2(v0[0], v0[1]); w.y = pk_h2(v0[2], v0[3]); w.z = pk_h2(v1[0], v1[1]); w.w = pk_h2(v1[2], v1[3]);
                            *(u32x4*)(outb + off + bj * HALF) = w; } } }
            st.collect(u, lds, wid, lane);
        } else st.run(acc, u, wr, wc, fr, fq, lds, wid, lane);
        const PG8_LAS float* S = (const PG8_LAS float*)(lds + 8192);
        f32x4 gm[2][2], sh[2][2];
#pragma unroll
        for (int bj = 0; bj < 2; ++bj)
#pragma unroll
            for (int n = 0; n < 2; ++n) { const int c = col0 + bj * HALF + 4 * n; const f32x4 g = *(const f32x4*)(ng + c);
                if constexpr (FIN) { gm[bj][n] = g; sh[bj][n] = (f32x4){0.f, 0.f, 0.f, 0.f}; }
                else { gm[bj][n] = g * (*(const f32x4*)(scale + (size_t)b * mstride + c) + 1.0f); sh[bj][n] = *(const f32x4*)(shift + (size_t)b * mstride + c); } }
#pragma unroll
        for (int ai = 0; ai < 2; ++ai)
#pragma unroll
            for (int m = 0; m < 4; ++m) { const int r = ai * HALF + wr * 64 + m * 16 + fr; const float rs = S[r]; const size_t off = (size_t)(u.pm * BM + r) * 1024 + col0;
                if constexpr (FIN) {
#pragma unroll
                    for (int bj = 0; bj < 2; ++bj)
#pragma unroll
                        for (int n = 0; n < 2; ++n) *(f32x4*)(outf + off + bj * HALF + 4 * n) = acc[ai][bj][m][n] * rs * gm[bj][n];
                } else {
#pragma unroll
                    for (int bj = 0; bj < 2; ++bj) { const f32x4 v0 = acc[ai][bj][m][0] * rs * gm[bj][0] + sh[bj][0], v1 = acc[ai][bj][m][1] * rs * gm[bj][1] + sh[bj][1];
                        u32x4 w; w.x = cvt_pk_bf16(v0[0], v0[1]); w.y = cvt_pk_bf16(v0[2], v0[3]); w.z = cvt_pk_bf16(v1[0], v1[1]); w.w = cvt_pk_bf16(v1[2], v1[3]);
                        *(u32x4*)(xn + off + bj * HALF) = w; } } }
    }
};
template <class Epi, class Sched, bool ALIGN_EPI = false, bool SP2 = false>
__device__ __forceinline__ void gemm_phase(PG8_LAS unsigned char* lds, const Gemm g, const Sched& S, const Epi& E, const int tid_in) {
    int tid = tid_in; asm volatile("" : "+v"(tid));
    const int wid = __builtin_amdgcn_readfirstlane(tid >> 6), lane = tid & 63, wr = wid >> 2, wc = wid & 3, fr = lane & 15, fq = lane >> 4;
    const int K = g.K, nt = K / BK;
    unsigned voffA[2], voffB[2];
#pragma unroll
    for (int i = 0; i < 2; ++i) { int R, C; stage_rc(tid * 16 + i * 8192, R, C); const int Rb = Epi::PERM ? ((R & ~31) + perm32(R & 31)) : R;
        voffA[i] = (unsigned)(R * K + C) * 2u; voffB[i] = (unsigned)(Rb * K + C) * 2u; }
    const size_t kstep = (size_t)(BK * 2);
    const size_t hstep = (size_t)HALF * K * 2;
    const size_t tstep = 2 * hstep;
    const unsigned ldsw = (unsigned)wid * 1024u;
    const int aoff = lds_byte(wr * 64 + fr, fq * 8), boff = lds_byte(wc * 32 + fr, fq * 8);
#define PG8_SA(b, h) (((b) * 2 + (h)) * HTB)
#define PG8_SB(b, h) ((4 + (b) * 2 + (h)) * HTB)
#define PG8_STAGE(bufoff, gbase, voff) do { _Pragma("unroll") for (int _i = 0; _i < 2; ++_i) \
        __builtin_amdgcn_global_load_lds((const unsigned*)((const char*)(gbase) + (voff)[_i]), (PG8_LAS unsigned*)(lds + (bufoff) + ldsw + _i * 8192), 16, 0, 0); } while (0)
#define PG8_LDA(dst, b, h) do { _Pragma("unroll") for (int m = 0; m < 4; ++m) _Pragma("unroll") for (int k = 0; k < 2; ++k) dst[m][k] = *(const PG8_LAS bf16x8*)(lds + PG8_SA(b, h) + aoff + m * 2048 + k * 1024); } while (0)
#define PG8_LDB(dst, b, h) do { _Pragma("unroll") for (int n = 0; n < 2; ++n) _Pragma("unroll") for (int k = 0; k < 2; ++k) dst[n][k] = *(const PG8_LAS bf16x8*)(lds + PG8_SB(b, h) + boff + n * 2048 + k * 1024); } while (0)
#define PG8_MMA(ai, bj, At, Bt) do { __builtin_amdgcn_s_setprio(1); _Pragma("unroll") for (int m = 0; m < 4; ++m) _Pragma("unroll") for (int n = 0; n < 2; ++n) _Pragma("unroll") for (int k = 0; k < 2; ++k) \
        acc[ai][bj][m][n] = __builtin_amdgcn_mfma_f32_16x16x32_bf16(Bt[n][k], At[m][k], acc[ai][bj][m][n], 0, 0, 0); __builtin_amdgcn_s_setprio(0); } while (0)
#define PG8_WAIT_V(n) asm volatile("s_waitcnt vmcnt(" #n ")" ::: "memory")
#define PG8_WAIT_L(n) asm volatile("s_waitcnt lgkmcnt(" #n ")" ::: "memory")
#define PG8_BAR __builtin_amdgcn_s_barrier()
#define PG8_SCHED __builtin_amdgcn_sched_barrier(0)
    Unit cur, nxt; int ui = 0;
    if (!S.next(0, cur)) return;
    f32x4 acc[2][2][4][2];
#pragma unroll
    for (int a = 0; a < 2; ++a)
#pragma unroll
        for (int b = 0; b < 2; ++b)
#pragma unroll
            for (int m = 0; m < 4; ++m)
#pragma unroll
                for (int n = 0; n < 2; ++n) acc[a][b][m][n] = (f32x4){0.f, 0.f, 0.f, 0.f};
    bf16x8 At[4][2], B0[2][2], B1[2][2];
    const char* cA = (const char*)g.A + (size_t)cur.pm * tstep; const char* cB = (const char*)g.Bt + (size_t)cur.pn * tstep;
    S.a_ready(cur);
    if constexpr (SP2) {
        PG8_STAGE(PG8_SB(0, 0), cB, voffB); PG8_STAGE(PG8_SB(0, 1), cB + hstep, voffB); PG8_STAGE(PG8_SA(0, 0), cA, voffA); PG8_STAGE(PG8_SA(0, 1), cA + hstep, voffA);
        if (wr == 1) PG8_BAR;
        PG8_WAIT_V(2); PG8_BAR;
        PG8_STAGE(PG8_SB(1, 0), cB + kstep, voffB); PG8_STAGE(PG8_SA(1, 0), cA + kstep, voffA); PG8_STAGE(PG8_SB(1, 1), cB + hstep + kstep, voffB);
        PG8_WAIT_V(6); PG8_BAR;
    } else {
        PG8_STAGE(PG8_SB(0, 0), cB, voffB); PG8_STAGE(PG8_SA(0, 0), cA, voffA); PG8_STAGE(PG8_SB(0, 1), cB + hstep, voffB); PG8_STAGE(PG8_SA(0, 1), cA + hstep, voffA);
        if (wr == 1) PG8_BAR;
        PG8_WAIT_V(4); PG8_BAR;
        PG8_STAGE(PG8_SB(1, 0), cB + kstep, voffB); PG8_STAGE(PG8_SA(1, 0), cA + kstep, voffA); PG8_STAGE(PG8_SB(1, 1), cB + hstep + kstep, voffB);
        PG8_WAIT_V(6); PG8_BAR;
    }
    for (;;) {
        const bool has_next = S.next(ui + 1, nxt);
        const char* nA = has_next ? (const char*)g.A + (size_t)nxt.pm * tstep : cA; const char* nB = has_next ? (const char*)g.Bt + (size_t)nxt.pn * tstep : cB;
        for (int t = 0; t < nt; t += 2) {
            const bool last = (t == nt - 2);
            const char* a1 = cA + (size_t)(t + 1) * kstep;
            const char* a2 = last ? nA : cA + (size_t)(t + 2) * kstep; const char* b2 = last ? nB : cB + (size_t)(t + 2) * kstep;
            const char* a3 = a2 + kstep; const char* b3 = b2 + kstep;
            if (last && has_next) S.a_ready(nxt);
            if constexpr (SP2) {
            PG8_LDB(B0, 0, 0); PG8_LDB(B1, 0, 1); PG8_SCHED; PG8_LDA(At, 0, 0); PG8_STAGE(PG8_SA(1, 1), a1 + hstep, voffA);
            PG8_WAIT_V(8); PG8_WAIT_L(0); PG8_BAR; PG8_MMA(0, 0, At, B0); PG8_MMA(0, 1, At, B1); PG8_BAR; PG8_SCHED;
            PG8_LDA(At, 0, 1); PG8_STAGE(PG8_SB(0, 0), b2, voffB); PG8_STAGE(PG8_SB(0, 1), b2 + hstep, voffB); PG8_STAGE(PG8_SA(0, 0), a2, voffA);
            PG8_WAIT_V(8); PG8_WAIT_L(0); PG8_BAR; PG8_MMA(1, 0, At, B0); PG8_MMA(1, 1, At, B1); PG8_BAR; PG8_SCHED;
            PG8_LDB(B0, 1, 0); PG8_LDB(B1, 1, 1); PG8_SCHED; PG8_LDA(At, 1, 0); PG8_STAGE(PG8_SA(0, 1), a2 + hstep, voffA);
            PG8_WAIT_V(8); PG8_WAIT_L(0); PG8_BAR; PG8_MMA(0, 0, At, B0); PG8_MMA(0, 1, At, B1); PG8_BAR; PG8_SCHED;
            PG8_LDA(At, 1, 1); PG8_STAGE(PG8_SB(1, 0), b3, voffB); PG8_STAGE(PG8_SB(1, 1), b3 + hstep, voffB); PG8_STAGE(PG8_SA(1, 0), a3, voffA);
            PG8_WAIT_V(8); PG8_WAIT_L(0); PG8_BAR; PG8_MMA(1, 0, At, B0); PG8_MMA(1, 1, At, B1); PG8_BAR; PG8_SCHED;
            } else {
            PG8_LDB(B0, 0, 0); PG8_SCHED; PG8_LDA(At, 0, 0); PG8_STAGE(PG8_SA(1, 1), a1 + hstep, voffA);
            PG8_WAIT_L(8); PG8_BAR; PG8_WAIT_L(0); PG8_MMA(0, 0, At, B0); PG8_BAR; PG8_SCHED;
            PG8_LDB(B1, 0, 1); PG8_STAGE(PG8_SB(0, 0), b2, voffB);
            PG8_BAR; PG8_WAIT_L(0); PG8_MMA(0, 1, At, B1); PG8_BAR;
            PG8_LDA(At, 0, 1); PG8_STAGE(PG8_SA(0, 0), a2, voffA);
            PG8_BAR; PG8_WAIT_L(0); PG8_MMA(1, 0, At, B0); PG8_BAR; PG8_SCHED;
            PG8_STAGE(PG8_SB(0, 1), b2 + hstep, voffB);
            PG8_WAIT_V(6); PG8_BAR; PG8_MMA(1, 1, At, B1); PG8_BAR;
            PG8_LDB(B0, 1, 0); PG8_SCHED; PG8_LDA(At, 1, 0); PG8_STAGE(PG8_SA(0, 1), a2 + hstep, voffA);
            PG8_WAIT_L(8); PG8_BAR; PG8_WAIT_L(0); PG8_MMA(0, 0, At, B0); PG8_BAR; PG8_SCHED;
            PG8_LDB(B1, 1, 1); PG8_STAGE(PG8_SB(1, 0), b3, voffB);
            PG8_BAR; PG8_WAIT_L(0); PG8_MMA(0, 1, At, B1); PG8_BAR;
            PG8_LDA(At, 1, 1); PG8_STAGE(PG8_SA(1, 0), a3, voffA);
            PG8_BAR; PG8_WAIT_L(0); PG8_MMA(1, 0, At, B0); PG8_BAR; PG8_SCHED;
            PG8_STAGE(PG8_SB(1, 1), b3 + hstep, voffB);
            PG8_WAIT_V(6); PG8_BAR; PG8_MMA(1, 1, At, B1); PG8_BAR;
            }
        }
        if constexpr (ALIGN_EPI) { if (wr == 0) PG8_BAR; }
        if constexpr (!Epi::AFTER_DRAIN) { E(acc, cur, wr, wc, fr, fq); S.done(cur); }
        if (!has_next) break;
#pragma unroll
        for (int a = 0; a < 2; ++a)
#pragma unroll
            for (int b = 0; b < 2; ++b)
#pragma unroll
                for (int m = 0; m < 4; ++m)
#pragma unroll
                    for (int n = 0; n < 2; ++n) acc[a][b][m][n] = (f32x4){0.f, 0.f, 0.f, 0.f};
        cur = nxt; cA = nA; cB = nB; ++ui;
        if constexpr (ALIGN_EPI) { if (wr == 1) PG8_BAR; }
    }
    PG8_WAIT_V(0);
    if constexpr (!ALIGN_EPI) { if (wr == 0) PG8_BAR; }
    PG8_BAR;
    if constexpr (Epi::AFTER_DRAIN) { E.fused(acc, cur, wr, wc, fr, fq, lds, wid, lane); S.done(cur); }
#undef PG8_SA
#undef PG8_SB
#undef PG8_STAGE
#undef PG8_LDA
#undef PG8_LDB
#undef PG8_MMA
#undef PG8_WAIT_V
#undef PG8_WAIT_L
#undef PG8_BAR
#undef PG8_SCHED
}
}

#ifndef PG8_SP2
#define PG8_SP2 true
#endif
#ifndef PG8_ALIGN
#define PG8_ALIGN true
#endif
#include <hip/hip_bf16.h>
#include <cmath>
namespace attn_body {
using bf16=__hip_bfloat16;
using bf16x8=__attribute__((ext_vector_type(8)))short;
using s16x4=__attribute__((ext_vector_type(4)))short;
using f32x16=__attribute__((ext_vector_type(16)))float;
using u32x4=__attribute__((ext_vector_type(4)))unsigned;
constexpr int BATCH=4,NHEAD=16,SEQ=8192,D=64,DM=NHEAD*D;
constexpr int NW=8,QBLK=32,QB=QBLK*NW,KVBLK=64,NQB=SEQ/QB;
constexpr int ATTN_PITCH=DM, ATTN_UNIT_ROWS=QB;
__device__ __forceinline__ int crow(int r,int hi){return (r&3)+8*(r>>2)+4*hi;}
#define SBAR() __builtin_amdgcn_sched_barrier(0)
__device__ __forceinline__ void cmask(f32x16&p0,f32x16&p1,int jb,int qrel,int hi){
  const float NEG=-INFINITY; int kb=64*jb+4*hi;
  #pragma unroll
  for(int r=0;r<16;++r){int kv=kb+(r&3)+8*(r>>2); if(kv>qrel)p0[r]=NEG; if(kv+32>qrel)p1[r]=NEG;}
}


typedef float f32x4v __attribute__((ext_vector_type(4)));
#define ALAS __attribute__((address_space(3)))
__device__ __forceinline__ void biasmask(f32x16&p0,f32x16&p1,int jb,int qrel,int hi,const ALAS float*tab){
  const int nb=qrel-64*jb-4*hi;
  #pragma unroll
  for(int r=0;r<16;++r){ const int n0=nb-((r&3)+8*(r>>2)); int i0=n0<-1?-1:n0; i0=(i0>128?128:i0)+1; int i1=n0-32; i1=i1<-1?-1:i1; i1=(i1>128?128:i1)+1; p0[r]+=tab[i0]; p1[r]+=tab[i1]; }
}
constexpr int NSLOT=3, SLOTB=8192;
constexpr int LDS_K=0, LDS_V=NSLOT*SLOTB, LDS_WS=2*NSLOT*SLOTB, LDS_OST=LDS_WS+NW*64*4, LDS_BYTES=LDS_OST+NW*4096;
constexpr float C2=0.125f*1.4426950408889634f;
__device__ __forceinline__ void glds16(const void*gsrc,unsigned lds_dst){unsigned keep;
  asm volatile("s_mov_b32 %0, m0\n\ts_mov_b32 m0, %2\n\ts_nop 0\n\tglobal_load_lds_dwordx4 %1, off\n\ts_mov_b32 m0, %0":"=&s"(keep):"v"(gsrc),"s"(lds_dst):"memory");}
__device__ __forceinline__ float max3f(float a,float b,float c){float r;asm("v_max3_f32 %0, %1, %2, %3":"=v"(r):"v"(a),"v"(b),"v"(c));return r;}
__device__ __forceinline__ float max2f(float a,float b){float r;asm("v_max_f32_e32 %0, %1, %2":"=v"(r):"v"(a),"v"(b));return r;}
__device__ __forceinline__ float fadd_s(float a,float b){float r;asm("v_add_f32_e32 %0, %1, %2":"=v"(r):"v"(a),"v"(b));return r;}
__device__ __forceinline__ float fsub_s(float a,float b){float r;asm("v_sub_f32_e32 %0, %1, %2":"=v"(r):"v"(a),"v"(b));return r;}
typedef float f32x2_t __attribute__((ext_vector_type(2))); typedef __bf16 bf16x2_t __attribute__((ext_vector_type(2)));
__device__ __forceinline__ unsigned cvtpk_s(float lo,float hi){f32x2_t v={lo,hi};bf16x2_t b=__builtin_convertvector(v,bf16x2_t);return __builtin_bit_cast(unsigned,b);}
#define WAIT_BAR(N) asm volatile("s_waitcnt vmcnt(" #N ") lgkmcnt(0)\n\ts_barrier":::"memory")

__device__ __forceinline__ void qkt(f32x16&p0,f32x16&p1,const char*Kslot,const bf16x8*qr,const f32x16&negm,int r32,int hi){
  const char*kb=Kslot+hi*1024+r32*16;
  #pragma unroll
  for(int d0=0;d0<4;++d0){
    const bf16x8 b0=*reinterpret_cast<const bf16x8*>(kb+d0*2048);
    const bf16x8 b1=*reinterpret_cast<const bf16x8*>(kb+d0*2048+512);
    if(d0==0){p0=__builtin_amdgcn_mfma_f32_32x32x16_bf16(b0,qr[0],negm,0,0,0);p1=__builtin_amdgcn_mfma_f32_32x32x16_bf16(b1,qr[0],negm,0,0,0);}
    else{p0=__builtin_amdgcn_mfma_f32_32x32x16_bf16(b0,qr[d0],p0,0,0,0);p1=__builtin_amdgcn_mfma_f32_32x32x16_bf16(b1,qr[d0],p1,0,0,0);}}
}
typedef __attribute__((address_space(3))) const char* lds_cptr;
typedef short v4i16_t __attribute__((ext_vector_type(4)));
__device__ __forceinline__ void kload8(bf16x8*kf,lds_cptr kp){
  kf[0]=*(const __attribute__((address_space(3))) bf16x8*)(kp);      kf[1]=*(const __attribute__((address_space(3))) bf16x8*)(kp+512);
  kf[2]=*(const __attribute__((address_space(3))) bf16x8*)(kp+2048); kf[3]=*(const __attribute__((address_space(3))) bf16x8*)(kp+2560);
  kf[4]=*(const __attribute__((address_space(3))) bf16x8*)(kp+4096); kf[5]=*(const __attribute__((address_space(3))) bf16x8*)(kp+4608);
  kf[6]=*(const __attribute__((address_space(3))) bf16x8*)(kp+6144); kf[7]=*(const __attribute__((address_space(3))) bf16x8*)(kp+6656);
}
__device__ __forceinline__ void kload2(bf16x8*kf,lds_cptr kp,int j){ kf[2*j]=*(const __attribute__((address_space(3))) bf16x8*)(kp+j*2048); kf[2*j+1]=*(const __attribute__((address_space(3))) bf16x8*)(kp+j*2048+512); }
__device__ __forceinline__ s16x4 vtr(lds_cptr p){ return __builtin_bit_cast(s16x4,__builtin_amdgcn_ds_read_tr16_b64_v4i16((__attribute__((address_space(3))) v4i16_t*)p)); }
__device__ __forceinline__ float rowmax(const f32x16&p0,const f32x16&p1){
  float a=max3f(p0[0],p0[1],p1[0]),b=max3f(p0[2],p0[3],p1[1]);a=max3f(a,p1[2],p1[3]);
  #pragma unroll
  for(int r=4;r<16;r+=4){a=max3f(a,p0[r],p0[r+1]);b=max3f(b,p0[r+2],p0[r+3]);a=max3f(a,p1[r],p1[r+1]);b=max3f(b,p1[r+2],p1[r+3]);}
  const float m=max2f(a,b);
  auto rr=__builtin_amdgcn_permlane32_swap(__float_as_uint(m),__float_as_uint(m),false,false);
  return max2f(__uint_as_float(rr[0]),__uint_as_float(rr[1]));
}
__device__ __forceinline__ void pv(f32x16*o,int vb,bf16x8 pa0,bf16x8 pa1,bf16x8 pa2,bf16x8 pa3){
  #pragma unroll
  for(int d0=0;d0<2;++d0){s16x4 lo[4],hi[4];
    #pragma unroll
    for(int ks=0;ks<4;++ks){
      asm volatile("ds_read_b64_tr_b16 %0,%1 offset:%c2":"=&v"(lo[ks]):"v"(vb),"i"(d0*4096+ks*1024):"memory");
      asm volatile("ds_read_b64_tr_b16 %0,%1 offset:%c2":"=&v"(hi[ks]):"v"(vb),"i"(d0*4096+ks*1024+512):"memory");}
    asm volatile("s_waitcnt lgkmcnt(0)":::"memory");SBAR();
    #define PK(k) (bf16x8){lo[k][0],lo[k][1],lo[k][2],lo[k][3],hi[k][0],hi[k][1],hi[k][2],hi[k][3]}
    o[d0]=__builtin_amdgcn_mfma_f32_32x32x16_bf16(pa0,PK(0),o[d0],0,0,0);
    o[d0]=__builtin_amdgcn_mfma_f32_32x32x16_bf16(pa1,PK(1),o[d0],0,0,0);
    o[d0]=__builtin_amdgcn_mfma_f32_32x32x16_bf16(pa2,PK(2),o[d0],0,0,0);
    o[d0]=__builtin_amdgcn_mfma_f32_32x32x16_bf16(pa3,PK(3),o[d0],0,0,0);
    #undef PK
  }
}

#ifndef ATTN_STORE16
#define ATTN_STORE16(p,v) (*(u32x4*)(p)=(v))
#endif
template<int THRL,int MODE> __device__ __forceinline__ void attn_unit(int b,int qc,int kc,int vc,int oc,int qb,const bf16*Q,const bf16*__restrict__ K,const bf16*__restrict__ V,bf16*O,char*shm,const float*aux,int hidx,const float*kpart,int npart,const int tid_in){
  int tid=tid_in; asm volatile("":"+v"(tid));
  const int lane=tid&63,r32=lane&31,hi=lane>>5; const int wid=__builtin_amdgcn_readfirstlane(tid>>6);
  const long rowbase=(long)b*SEQ; const int q0=qb*QB;
  const bf16*Qw=Q+(rowbase+q0+wid*QBLK)*DM+qc;
  const bf16*Kh=K+rowbase*DM+kc; const bf16*Vh=V+rowbase*DM+vc;
  const unsigned lds0=(unsigned)(uintptr_t)shm;
  float*wsf=(float*)(shm+LDS_WS)+wid*64;
  int tskip=0; float mfix=0.f;
  if(MODE==1){
    bf16x8 qv[4];
    #pragma unroll
    for(int d0=0;d0<4;++d0) qv[d0]=*reinterpret_cast<const bf16x8*>(&Qw[(long)r32*DM+d0*16+hi*8]);
    float kmv[4];
    #pragma unroll
    for(int j=0;j<4;++j){ const int i=lane+64*j; kmv[j]=(i<npart)?kpart[(long)i*64]:0.f; }
    const int NT0=(q0+QB)/KVBLK;
    const float a_q0=aux[q0], a_row=aux[q0+wid*QBLK+r32], a_t0=aux[64*lane+63], a_t1=aux[64*(lane+64)+63];
    const int n4=(q0+QB)>>2; f32x4v tv[4];
    #pragma unroll
    for(int j=0;j<4;++j){ const int i=tid+512*j; if(i<n4) tv[j]=((const f32x4v*)aux)[i]; }
    float km=fmaxf(fmaxf(kmv[0],kmv[1]),fmaxf(kmv[2],kmv[3]));
    for(int i=lane+256;i<npart;i+=64) km=fmaxf(km,kpart[(long)i*64]);
    float ss=0.f;
    #pragma unroll
    for(int d0=0;d0<4;++d0){
      #pragma unroll
      for(int e=0;e<8;++e){ const float f=__uint_as_float(((unsigned)(unsigned short)qv[d0][e])<<16); ss+=f*f; } }
    { auto rr=__builtin_amdgcn_permlane32_swap(__float_as_uint(ss),__float_as_uint(ss),false,false); ss=__uint_as_float(rr[0])+__uint_as_float(rr[1]); }
    const float ssrow=ss;
    ss=wave_max32(ss);
    km=wave_max64(km);
    ALAS float*wsl=(ALAS float*)((__attribute__((address_space(3))) char*)shm+LDS_WS);
    if(lane==0)wsl[wid*64]=ss;
    { ALAS f32x4v*tabw=(ALAS f32x4v*)((__attribute__((address_space(3))) char*)shm+LDS_BYTES);
      #pragma unroll
      for(int j=0;j<4;++j){ const int i=tid+512*j; if(i<n4) tabw[i]=tv[j]; } }
    asm volatile("s_waitcnt lgkmcnt(0)\n\ts_barrier":::"memory");
    float qm=wsl[0];
    #pragma unroll
    for(int w=1;w<NW;++w)qm=fmaxf(qm,wsl[w*64]);
    const float smax2=2.f*(__builtin_amdgcn_sqrtf(qm*km)*1.01f+1.f);
    constexpr float SKIP_T=64.f;
    const float thr=a_q0-SKIP_T-smax2;
    mfix=a_row+(__builtin_amdgcn_sqrtf(ssrow*km)*1.01f+1.f);
    const bool sk0=(lane<NT0-6)&&(a_t0<thr);
    const bool sk1=(lane+64<NT0-6)&&(a_t1<thr);
    const unsigned long long m0=~__ballot(sk0), m1=~__ballot(sk1);
    const int nlead=m0?__builtin_ctzll(m0):64+(m1?__builtin_ctzll(m1):64);
    tskip=__builtin_amdgcn_readfirstlane(nlead&~1);
    Kh+=(long)tskip*KVBLK*DM; Vh+=(long)tskip*KVBLK*DM;
  }
  const bf16*ksrc=Kh+(long)lane*DM+wid*8;
  const bf16*vsrc=Vh+(long)(16*(wid&3)+(lane>>2))*DM+(wid>>2)*32+(lane&3)*8;
  const unsigned kdst=lds0+LDS_K+wid*1024, vdst=lds0+LDS_V+wid*1024;
  #define DMA_K(t,slot) glds16(ksrc+(long)(t)*KVBLK*DM,(unsigned)__builtin_amdgcn_readfirstlane(kdst+(slot)))
  #define DMA_V(t,slot) glds16(vsrc+(long)(t)*KVBLK*DM,(unsigned)__builtin_amdgcn_readfirstlane(vdst+(slot)))
  const int vb0=(int)(lds0+LDS_V)+((lane>>4)&1)*32+(lane&3)*8+(4*hi+((lane&15)>>2))*64;
  const char*Kbase=shm+LDS_K; bf16x8 kf[8];
  const lds_cptr shm3=(lds_cptr)shm; const lds_cptr kp0=shm3+LDS_K+hi*1024+r32*16; const lds_cptr vp0=shm3+LDS_V+((lane>>4)&1)*32+(lane&3)*8+(4*hi+((lane&15)>>2))*64;
  const int NT=(q0+QB)/KVBLK-tskip;
  const ALAS float*tab3=(const ALAS float*)(shm3+LDS_BYTES);
  { ALAS float*tabf=(ALAS float*)(shm3+LDS_BYTES);
    if(MODE==0){ if(tid<130){ float v; if(tid==0)v=-INFINITY; else if(tid==129)v=0.f; else{ const int n=tid-1; int bk; if(n<16)bk=n; else{ const int lg=16+(int)(__builtin_amdgcn_logf((float)n*0.0625f)*(16.0f/3.0f));     bk=lg<31?lg:31; } v=(aux[bk*8+hidx]-aux[31*8+hidx])*1.4426950408889634f; } tabf[tid]=v; } }
    asm volatile("s_waitcnt vmcnt(0) lgkmcnt(0)":::"memory"); }
  DMA_K(0,0);DMA_V(0,0);DMA_K(1,SLOTB);
  bf16x8 qr[4];
  #pragma unroll
  for(int d0=0;d0<4;++d0)qr[d0]=*reinterpret_cast<const bf16x8*>(&Qw[(long)r32*DM+d0*16+hi*8]);
  float mhat=(MODE==1)?mfix:0.f,l_reg=0.f;f32x16 o[2];o[0]=f32x16{};o[1]=f32x16{};f32x16 negm=f32x16{};asm volatile("":"+v"(negm));
  const f32x16 zero16=f32x16{};
  #define CIN ((MODE==1)?zero16:negm)
  const int qrel=wid*QBLK+r32;
  #define CMASK(P0,P1,t) do{int jb_=(t)-(NT-4); if(MODE==1){ if(jb_>=0)cmask(P0,P1,jb_,qrel,hi); } else { if(jb_>=-2)biasmask(P0,P1,jb_,qrel,hi,tab3); } }while(0)
  #define FADD(P0,P1,t) do{ if(MODE==1){ const ALAS f32x4v*fp_=(const ALAS f32x4v*)(shm3+LDS_BYTES)+(16*((t)+tskip)+hi); \
    _Pragma("unroll") for(int g_=0;g_<4;++g_){ const f32x4v a_=fp_[2*g_]-mhat, b_=fp_[8+2*g_]-mhat; \
      P0[4*g_]+=a_[0];P0[4*g_+1]+=a_[1];P0[4*g_+2]+=a_[2];P0[4*g_+3]+=a_[3]; P1[4*g_]+=b_[0];P1[4*g_+1]+=b_[1];P1[4*g_+2]+=b_[2];P1[4*g_+3]+=b_[3]; } } }while(0)
  bool resc=false;
  #define START(P0,P1) do{ resc=false; if(MODE==1){ \
      _Pragma("unroll") for(int r=0;r<16;++r)P0[r]=__builtin_amdgcn_exp2f(P0[r]); } else { const float rm=rowmax(P0,P1); \
    { const float dl=rm; mhat=fadd_s(mhat,dl); \
      _Pragma("unroll") for(int r=0;r<16;++r){P0[r]=fsub_s(P0[r],dl);P1[r]=fsub_s(P1[r],dl);} \
      _Pragma("unroll") for(int r=0;r<16;++r)negm[r]=-mhat; asm volatile("":"+v"(negm)); } \
    _Pragma("unroll") for(int r=0;r<16;++r)P0[r]=__builtin_amdgcn_exp2f(P0[r]); } }while(0)
  #define RESC() do{ if(resc){ asm volatile("s_waitcnt lgkmcnt(0)":::"memory"); \
      _Pragma("unroll") for(int d_=0;d_<2;++d_) _Pragma("unroll") for(int r=0;r<16;++r)o[d_][r]*=wsf[crow(r,hi)]; } }while(0)
  f32x16 pA0,pA1,pB0,pB1;
  int sl_prev=0,sl_cur=0,sl_next=SLOTB;
  #define ROT() do{sl_prev=sl_cur;sl_cur=sl_next;sl_next=(sl_next==(NSLOT-1)*SLOTB)?0:sl_next+SLOTB;}while(0)
  DMA_K(2,2*SLOTB);
  WAIT_BAR(3);
  qkt(pA0,pA1,Kbase,qr,CIN,r32,hi);asm volatile("s_nop 15\n\ts_nop 7":"+v"(pA0),"+v"(pA1));FADD(pA0,pA1,0);CMASK(pA0,pA1,0);
  START(pA0,pA1);
  _Pragma("unroll") for(int r=0;r<16;++r)pA1[r]=__builtin_amdgcn_exp2f(pA1[r]);
  WAIT_BAR(0);
  DMA_K(3,0);DMA_V(1,SLOTB);
  ROT();
  kload8(kf,kp0+sl_cur);
  WAIT_BAR(2);
  s16x4 vlo[8],vhi[8]; u32x4 pw0,pw1,pw2,pw3;
  #define PKW(P,B) cvtpk_s(P[B],P[B+1])
  #define PAF(k) __builtin_bit_cast(bf16x8,pw##k)
  #define VFR(i) (bf16x8){vlo[i][0],vlo[i][1],vlo[i][2],vlo[i][3],vhi[i][0],vhi[i][1],vhi[i][2],vhi[i][3]}
  #define PIN(x) asm volatile("":"+v"(x))
  #define MX3(a,b,c) __builtin_fmaxf(__builtin_fmaxf((a),(b)),(c))
  #define GAPA(MF,A0,A1,A2,A3,W0,W1,PW) do{ MF; sacc+=A0; sacc+=A1; sacc+=A2; sacc+=A3; PIN(sacc); W0; W1; PIN(PW); SBAR(); }while(0)
  #define EX(v) __builtin_amdgcn_exp2f(v)
  #define GAPB(MF,X,B) do{ MF; X[B]=EX(X[B]); X[B+1]=EX(X[B+1]); X[B+2]=EX(X[B+2]); X[B+3]=EX(X[B+3]); PIN(X); SBAR(); }while(0)
  #define VRD(i) do{ vlo[i]=vtr(vp_+(((i)>>2)*4096+((i)&3)*1024)); vhi[i]=vtr(vp_+(((i)>>2)*4096+((i)&3)*1024+512)); }while(0)
  #define KRD(G,j) do{ if(G){ kload2(kf,kp0+sl_next,j); SBAR(); } }while(0)
  #define STEP(C0,C1,P0,P1,t,GK,GV,GL) do{ SBAR(); \
    const lds_cptr vp_=vp0+sl_prev; \
    VRD(0); SBAR(); float sacc=(P0[0]+P0[1]); \
    GAPA(C0=__builtin_amdgcn_mfma_f32_32x32x16_bf16(kf[0],qr[0],CIN,0,0,0), P0[2],P0[3],P0[4],P0[5],     pw0[0]=PKW(P0,0), pw0[1]=PKW(P0,2), pw0); \
    VRD(4); SBAR(); GAPA(C1=__builtin_amdgcn_mfma_f32_32x32x16_bf16(kf[1],qr[0],CIN,0,0,0), P0[6],P0[7],P0[8],P0[9],     pw0[2]=PKW(P0,4), pw0[3]=PKW(P0,6), pw0); \
    VRD(1); SBAR(); GAPA(C0=__builtin_amdgcn_mfma_f32_32x32x16_bf16(kf[2],qr[1],C0,0,0,0),   P0[10],P0[11],P0[12],P0[13], pw1[0]=PKW(P0,8), pw1[1]=PKW(P0,10), pw1); \
    VRD(5); SBAR(); GAPA(C1=__builtin_amdgcn_mfma_f32_32x32x16_bf16(kf[3],qr[1],C1,0,0,0),   P0[14],P0[15],P1[0],P1[1],   pw1[2]=PKW(P0,12),pw1[3]=PKW(P0,14), pw1); \
    VRD(2); SBAR(); GAPA(C0=__builtin_amdgcn_mfma_f32_32x32x16_bf16(kf[4],qr[2],C0,0,0,0),   P1[2],P1[3],P1[4],P1[5],     pw2[0]=PKW(P1,0), pw2[1]=PKW(P1,2), pw2); \
    VRD(6); SBAR(); GAPA(C1=__builtin_amdgcn_mfma_f32_32x32x16_bf16(kf[5],qr[2],C1,0,0,0),   P1[6],P1[7],P1[8],P1[9],     pw2[2]=PKW(P1,4), pw2[3]=PKW(P1,6), pw2); \
    VRD(3); SBAR(); GAPA(C0=__builtin_amdgcn_mfma_f32_32x32x16_bf16(kf[6],qr[3],C0,0,0,0),   P1[10],P1[11],P1[12],P1[13], pw3[0]=PKW(P1,8), pw3[1]=PKW(P1,10), pw3); \
    VRD(7); SBAR(); GAPA(C1=__builtin_amdgcn_mfma_f32_32x32x16_bf16(kf[7],qr[3],C1,0,0,0),   P1[14],P1[15],0.f,0.f,       pw3[2]=PKW(P1,12),pw3[3]=PKW(P1,14), pw3); \
    l_reg+=sacc; \
    if(GK){DMA_K((t)+3,sl_cur);} if(GV){DMA_V((t)+1,sl_next);} \
    FADD(C0,C1,t); CMASK(C0,C1,t); \
    resc=false; if(MODE!=1) { float a=MX3(C0[0],C0[1],C1[0]),b=MX3(C0[2],C0[3],C1[1]); a=MX3(a,C1[2],C1[3]); \
      _Pragma("unroll") for(int r=4;r<16;r+=4){a=MX3(a,C0[r],C0[r+1]);b=MX3(b,C0[r+2],C0[r+3]);a=MX3(a,C1[r],C1[r+1]);b=MX3(b,C1[r+2],C1[r+3]);} \
      float rm=__builtin_fmaxf(a,b); { auto rr=__builtin_amdgcn_permlane32_swap(__float_as_uint(rm),__float_as_uint(rm),false,false); rm=__builtin_fmaxf(__uint_as_float(rr[0]),__uint_as_float(rr[1])); } \
      resc=false; \
      if(__builtin_expect(__any(rm>(float)THRL),0)){ const float dl=__builtin_fmaxf(rm,0.f); mhat+=dl; \
        _Pragma("unroll") for(int r=0;r<16;++r){C0[r]-=dl;C1[r]-=dl;} \
        if(MODE==0){ _Pragma("unroll") for(int r=0;r<16;++r)negm[r]=-mhat; asm volatile("":"+v"(negm)); } \
        const float f=__builtin_amdgcn_exp2f(-dl); l_reg*=f; if(hi==0)wsf[r32]=f; resc=true; } } \
    SBAR(); \
    GAPB(o[0]=__builtin_amdgcn_mfma_f32_32x32x16_bf16(PAF(0),VFR(0),o[0],0,0,0), C0,0); \
    GAPB(o[1]=__builtin_amdgcn_mfma_f32_32x32x16_bf16(PAF(0),VFR(4),o[1],0,0,0), C0,4); \
    KRD(GL,0); GAPB(o[0]=__builtin_amdgcn_mfma_f32_32x32x16_bf16(PAF(1),VFR(1),o[0],0,0,0), C0,8); \
    KRD(GL,1); GAPB(o[1]=__builtin_amdgcn_mfma_f32_32x32x16_bf16(PAF(1),VFR(5),o[1],0,0,0), C0,12); \
    KRD(GL,2); GAPB(o[0]=__builtin_amdgcn_mfma_f32_32x32x16_bf16(PAF(2),VFR(2),o[0],0,0,0), C1,0); \
    KRD(GL,3); GAPB(o[1]=__builtin_amdgcn_mfma_f32_32x32x16_bf16(PAF(2),VFR(6),o[1],0,0,0), C1,4); \
    GAPB(o[0]=__builtin_amdgcn_mfma_f32_32x32x16_bf16(PAF(3),VFR(3),o[0],0,0,0), C1,8); \
    GAPB(o[1]=__builtin_amdgcn_mfma_f32_32x32x16_bf16(PAF(3),VFR(7),o[1],0,0,0), C1,12); \
    }while(0)
  int t=1;
  #undef CMASK
  #define CMASK(P0,P1,t) do{}while(0)
  for(;t+(MODE==0?7:5)<NT;t+=2){
    STEP(pB0,pB1,pA0,pA1,t,true,true,true);     WAIT_BAR(2); RESC(); ROT();
    STEP(pA0,pA1,pB0,pB1,t+1,true,true,true);   WAIT_BAR(2); RESC(); ROT();
  }
  #undef CMASK
  #define CMASK(P0,P1,t) do{int jb_=(t)-(NT-4); if(MODE==1){ if(jb_>=0)cmask(P0,P1,jb_,qrel,hi); } else { if(jb_>=-2)biasmask(P0,P1,jb_,qrel,hi,tab3); } }while(0)
  #define ENDW(tt) do{ if((tt)+3<NT){WAIT_BAR(2);} else if((tt)+2<NT){WAIT_BAR(1);} else {WAIT_BAR(0);} }while(0)
  for(;t+1<NT;t+=2){
    STEP(pB0,pB1,pA0,pA1,t,(t+3<NT),(t+1<NT),(t+1<NT));       ENDW(t);   RESC(); ROT();
    STEP(pA0,pA1,pB0,pB1,t+1,(t+4<NT),(t+2<NT),(t+2<NT));     ENDW(t+1); RESC(); ROT();
  }
  STEP(pB0,pB1,pA0,pA1,NT-1,false,false,false); RESC();
  { float sacc=pB0[0]+pB0[1]; _Pragma("unroll") for(int r=2;r<16;++r)sacc+=pB0[r]; _Pragma("unroll") for(int r=0;r<16;++r)sacc+=pB1[r]; l_reg+=sacc;
    pw0=(u32x4){PKW(pB0,0),PKW(pB0,2),PKW(pB0,4),PKW(pB0,6)};pw1=(u32x4){PKW(pB0,8),PKW(pB0,10),PKW(pB0,12),PKW(pB0,14)};pw2=(u32x4){PKW(pB1,0),PKW(pB1,2),PKW(pB1,4),PKW(pB1,6)};pw3=(u32x4){PKW(pB1,8),PKW(pB1,10),PKW(pB1,12),PKW(pB1,14)};
    SBAR(); pv(o,vb0+sl_cur,PAF(0),PAF(1),PAF(2),PAF(3)); }
  #undef PKW
  #undef PAF
  #undef VFR
  #undef PIN
  #undef MX3
  #undef GAPA
  #undef GAPB
  #undef EX
  #undef VRD
  #undef KRD
  #undef STEP
  #undef ENDW
  {auto rr=__builtin_amdgcn_permlane32_swap(__float_as_uint(l_reg),__float_as_uint(l_reg),false,false);l_reg=__uint_as_float(rr[0])+__uint_as_float(rr[1]);}
  if(hi==0)wsf[32+r32]=l_reg;asm volatile("s_waitcnt lgkmcnt(0)":::"memory");
  float rli[16];
  #pragma unroll
  for(int r=0;r<16;++r)rli[r]=__builtin_amdgcn_rcpf(wsf[32+crow(r,hi)]);
  bf16*Ow=O+(rowbase+q0+wid*QBLK)*DM+oc;
  { bf16*stg=(bf16*)(shm+LDS_OST)+wid*2048;
    #pragma unroll
    for(int r=0;r<16;++r){const int orow=crow(r,hi);
      #pragma unroll
      for(int d0=0;d0<2;++d0)stg[orow*64+d0*32+r32]=__float2bfloat16(o[d0][r]*rli[r]);}
    asm volatile("s_waitcnt lgkmcnt(0)":::"memory");
    #pragma unroll
    for(int i=0;i<4;++i){const int row=i*8+(lane>>3),ch=lane&7; const u32x4 v=*(const u32x4*)(stg+row*64+ch*8); ATTN_STORE16(Ow+(long)row*DM+ch*8,v);} }
  asm volatile("s_waitcnt lgkmcnt(0)\n\ts_barrier":::"memory");
  #undef FADD
  #undef CIN
  #undef DMA_K
  #undef DMA_V
  #undef CMASK
  #undef START
  #undef RESC
  #undef ROT
}
constexpr int WLDS_V=NSLOT*SLOTB, WLDS_WS=WLDS_V+NSLOT*2*SLOTB, WLDS_OST=WLDS_WS+NW*64*4, WLDS_BYTES=WLDS_OST+NW*4096;
__device__ __forceinline__ void pv_w(f32x16*o,int vb,bf16x8 pa0,bf16x8 pa1,bf16x8 pa2,bf16x8 pa3){
  #pragma unroll
  for(int d0=0;d0<4;++d0){s16x4 lo[4],hi[4];
    #pragma unroll
    for(int ks=0;ks<4;++ks){
      asm volatile("ds_read_b64_tr_b16 %0,%1 offset:%c2":"=&v"(lo[ks]):"v"(vb),"i"(d0*4096+ks*1024):"memory");
      asm volatile("ds_read_b64_tr_b16 %0,%1 offset:%c2":"=&v"(hi[ks]):"v"(vb),"i"(d0*4096+ks*1024+512):"memory");}
    asm volatile("s_waitcnt lgkmcnt(0)":::"memory");SBAR();
    #define PK(k) (bf16x8){lo[k][0],lo[k][1],lo[k][2],lo[k][3],hi[k][0],hi[k][1],hi[k][2],hi[k][3]}
    o[d0]=__builtin_amdgcn_mfma_f32_32x32x16_bf16(pa0,PK(0),o[d0],0,0,0);
    o[d0]=__builtin_amdgcn_mfma_f32_32x32x16_bf16(pa1,PK(1),o[d0],0,0,0);
    o[d0]=__builtin_amdgcn_mfma_f32_32x32x16_bf16(pa2,PK(2),o[d0],0,0,0);
    o[d0]=__builtin_amdgcn_mfma_f32_32x32x16_bf16(pa3,PK(3),o[d0],0,0,0);
    #undef PK
  }
}
template<int THRL> __device__ __forceinline__ void attn_unit_w(int b,int qc,int kc,int vc,int oc,int qb,const bf16*Q,const bf16*__restrict__ K,const bf16*__restrict__ V,bf16*O,char*shm,const float*aux,int hidx,const float*kpart,int npart,const int tid_in){
  int tid=tid_in; asm volatile("":"+v"(tid));
  constexpr int MODE=0;
  const int lane=tid&63,r32=lane&31,hi=lane>>5; const int wid=__builtin_amdgcn_readfirstlane(tid>>6);
  const long rowbase=(long)b*SEQ; const int q0=qb*QB;
  const bf16*Qw=Q+(rowbase+q0+wid*QBLK)*DM+qc;
  const bf16*Kh=K+rowbase*DM+kc; const bf16*Vh=V+rowbase*DM+vc;
  const unsigned lds0=(unsigned)(uintptr_t)shm;
  float*wsf=(float*)(shm+WLDS_WS)+wid*64;
  int tskip=0;
  if(MODE==1){
    float ss=0.f;
    #pragma unroll
    for(int d0=0;d0<4;++d0){ const bf16x8 qv=*reinterpret_cast<const bf16x8*>(&Qw[(long)r32*DM+d0*16+hi*8]);
      #pragma unroll
      for(int e=0;e<8;++e){ const float f=__uint_as_float(((unsigned)(unsigned short)qv[e])<<16); ss+=f*f; } }
    { auto rr=__builtin_amdgcn_permlane32_swap(__float_as_uint(ss),__float_as_uint(ss),false,false); ss=__uint_as_float(rr[0])+__uint_as_float(rr[1]); }
    ss=wave_max32(ss);
    float km=0.f; for(int i=lane;i<npart;i+=64) km=fmaxf(km,kpart[(long)i*64]);
    km=wave_max64(km);
    ALAS float*wsl=(ALAS float*)((__attribute__((address_space(3))) char*)shm+WLDS_WS);
    if(lane==0)wsl[wid*64]=ss;
    asm volatile("s_waitcnt lgkmcnt(0)\n\ts_barrier":::"memory");
    float qm=wsl[0];
    #pragma unroll
    for(int w=1;w<NW;++w)qm=fmaxf(qm,wsl[w*64]);
    const float smax2=2.f*(__builtin_amdgcn_sqrtf(qm*km)*1.01f+1.f);
    const int NT0=(q0+QB)/KVBLK;
    const float thr=aux[q0]-160.f-smax2;
    const bool sk0=(lane<NT0-6)&&(aux[64*lane+63]<thr);
    const bool sk1=(lane+64<NT0-6)&&(aux[64*(lane+64)+63]<thr);
    const unsigned long long m0=~__ballot(sk0), m1=~__ballot(sk1);
    const int nlead=m0?__builtin_ctzll(m0):64+(m1?__builtin_ctzll(m1):64);
    tskip=__builtin_amdgcn_readfirstlane(nlead&~1);
    Kh+=(long)tskip*KVBLK*DM; Vh+=(long)tskip*KVBLK*DM; aux+=64*tskip;
  }
  const bf16*ksrc=Kh+(long)lane*DM+wid*8;
  const bf16*vsrc=Vh+(long)(16*(wid&3)+(lane>>2))*DM+(wid>>2)*32+(lane&3)*8;
  const unsigned kdst=lds0+LDS_K+wid*1024, vdst=lds0+WLDS_V+wid*1024;
  #define DMA_K(t,slot) glds16(ksrc+(long)(t)*KVBLK*DM,(unsigned)__builtin_amdgcn_readfirstlane(kdst+(slot)))
  #define DMA_V(t,slot) do{ glds16(vsrc+(long)(t)*KVBLK*DM,(unsigned)__builtin_amdgcn_readfirstlane(vdst+2*(slot))); glds16(vsrc+64+(long)(t)*KVBLK*DM,(unsigned)__builtin_amdgcn_readfirstlane(vdst+2*(slot)+8192)); }while(0)
  const int vb0=(int)(lds0+WLDS_V)+((lane>>4)&1)*32+(lane&3)*8+(4*hi+((lane&15)>>2))*64;
  const char*Kbase=shm+LDS_K; bf16x8 kf[8];
  const lds_cptr shm3=(lds_cptr)shm; const lds_cptr kp0=shm3+LDS_K+hi*1024+r32*16; const lds_cptr vp0=shm3+WLDS_V+((lane>>4)&1)*32+(lane&3)*8+(4*hi+((lane&15)>>2))*64;
  const int NT=(q0+QB)/KVBLK-tskip;
  const ALAS float*tab3=(const ALAS float*)(shm3+WLDS_BYTES);
  { ALAS float*tabf=(ALAS float*)(shm3+WLDS_BYTES);
    if(MODE==0){ if(tid<130){ float v; if(tid==0)v=-INFINITY; else if(tid==129)v=0.f; else{ const int n=tid-1; int bk; if(n<16)bk=n; else{ const int lg=16+(int)(__builtin_amdgcn_logf((float)n*0.0625f)*(16.0f/3.0f));     bk=lg<31?lg:31; } v=(aux[bk*8+hidx]-aux[31*8+hidx])*1.4426950408889634f; } tabf[tid]=v; } }
    else{ const int n4=(q0+QB-64*tskip)>>2; for(int i=tid;i<n4;i+=512) ((ALAS f32x4v*)tabf)[i]=((const f32x4v*)aux)[i]; }
    asm volatile("s_waitcnt vmcnt(0) lgkmcnt(0)":::"memory"); }
  DMA_K(0,0);DMA_V(0,0);DMA_K(1,SLOTB);
  bf16x8 qr[4];
  #pragma unroll
  for(int d0=0;d0<4;++d0)qr[d0]=*reinterpret_cast<const bf16x8*>(&Qw[(long)r32*DM+d0*16+hi*8]);
  float mhat=0.f,l_reg=0.f;f32x16 o[4];o[0]=f32x16{};o[1]=f32x16{};o[2]=f32x16{};o[3]=f32x16{};
  const f32x16 zero16=f32x16{};
  #define CIN zero16
  const int qrel=wid*QBLK+r32;
  #define CMASK(P0,P1,t) do{int jb_=(t)-(NT-4); if(MODE==1){ if(jb_>=0)cmask(P0,P1,jb_,qrel,hi); } else { if(jb_>=-2)biasmask(P0,P1,jb_,qrel,hi,tab3); } }while(0)
  #define FADD(P0,P1,t) do{ if(MODE==1){ const ALAS f32x4v*fp_=(const ALAS f32x4v*)(shm3+WLDS_BYTES)+(16*(t)+hi); \
    _Pragma("unroll") for(int g_=0;g_<4;++g_){ const f32x4v a_=fp_[2*g_]-mhat, b_=fp_[8+2*g_]-mhat; \
      P0[4*g_]+=a_[0];P0[4*g_+1]+=a_[1];P0[4*g_+2]+=a_[2];P0[4*g_+3]+=a_[3]; P1[4*g_]+=b_[0];P1[4*g_+1]+=b_[1];P1[4*g_+2]+=b_[2];P1[4*g_+3]+=b_[3]; } } }while(0)
  bool resc=false;
  #define START(P0,P1) do{ const float rm=rowmax(P0,P1); resc=false; mhat=rm; \
    _Pragma("unroll") for(int r=0;r<16;++r)P0[r]=__builtin_amdgcn_exp2f(fsub_s(P0[r],mhat)); }while(0)
  #define RESC() do{ if(resc){ asm volatile("s_waitcnt lgkmcnt(0)":::"memory"); \
      _Pragma("unroll") for(int d_=0;d_<4;++d_) _Pragma("unroll") for(int r=0;r<16;++r)o[d_][r]*=wsf[crow(r,hi)]; } }while(0)
  f32x16 pA0,pA1,pB0,pB1;
  int sl_prev=0,sl_cur=0,sl_next=SLOTB;
  #define ROT() do{sl_prev=sl_cur;sl_cur=sl_next;sl_next=(sl_next==(NSLOT-1)*SLOTB)?0:sl_next+SLOTB;}while(0)
  DMA_K(2,2*SLOTB);
  WAIT_BAR(4);
  qkt(pA0,pA1,Kbase,qr,CIN,r32,hi);asm volatile("s_nop 15\n\ts_nop 7":"+v"(pA0),"+v"(pA1));FADD(pA0,pA1,0);CMASK(pA0,pA1,0);
  START(pA0,pA1);
  _Pragma("unroll") for(int r=0;r<16;++r)pA1[r]=__builtin_amdgcn_exp2f(pA1[r]-mhat);
  WAIT_BAR(0);
  DMA_K(3,0);DMA_V(1,SLOTB);
  ROT();
  kload8(kf,kp0+sl_cur);
  WAIT_BAR(3);
  s16x4 vlo[8],vhi[8]; u32x4 pw0,pw1,pw2,pw3;
  #define PKW(P,B) cvtpk_s(P[B],P[B+1])
  #define PAF(k) __builtin_bit_cast(bf16x8,pw##k)
  #define VFR(i) (bf16x8){vlo[i][0],vlo[i][1],vlo[i][2],vlo[i][3],vhi[i][0],vhi[i][1],vhi[i][2],vhi[i][3]}
  #define PIN(x) asm volatile("":"+v"(x))
  #define MX3(a,b,c) __builtin_fmaxf(__builtin_fmaxf((a),(b)),(c))
  #define GAPA(MF,A0,A1,A2,A3,W0,W1,PW) do{ MF; sacc+=A0; sacc+=A1; sacc+=A2; sacc+=A3; PIN(sacc); W0; W1; PIN(PW); SBAR(); }while(0)
  #define EX(v) __builtin_amdgcn_exp2f(v)
  #define GAPB(MF,X,B) do{ MF; X[B]=EX(X[B]-mhat); X[B+1]=EX(X[B+1]-mhat); X[B+2]=EX(X[B+2]-mhat); X[B+3]=EX(X[B+3]-mhat); PIN(X); SBAR(); }while(0)
  #define GAPC(MF) do{ MF; SBAR(); }while(0)
  #define GAPB2(MF,X,B) do{ MF; X[B]=EX(X[B]-mhat); X[B+1]=EX(X[B+1]-mhat); PIN(X); SBAR(); }while(0)
  #define VRD2(i) do{ vlo[i]=vtr(vp_+((((i)>>2)+2)*4096+((i)&3)*1024)); vhi[i]=vtr(vp_+((((i)>>2)+2)*4096+((i)&3)*1024+512)); SBAR(); }while(0)
  #define VRD(i) do{ vlo[i]=vtr(vp_+(((i)>>2)*4096+((i)&3)*1024)); vhi[i]=vtr(vp_+(((i)>>2)*4096+((i)&3)*1024+512)); }while(0)
  #define KRD(G,j) do{ if(G){ kload2(kf,kp0+sl_next,j); SBAR(); } }while(0)
  #define STEP(C0,C1,P0,P1,t,GK,GV,GL) do{ SBAR(); \
    const lds_cptr vp_=vp0+2*sl_prev; \
    VRD(0); SBAR(); float sacc=(P0[0]+P0[1]); \
    GAPA(C0=__builtin_amdgcn_mfma_f32_32x32x16_bf16(kf[0],qr[0],CIN,0,0,0), P0[2],P0[3],P0[4],P0[5],     pw0[0]=PKW(P0,0), pw0[1]=PKW(P0,2), pw0); \
    VRD(4); SBAR(); GAPA(C1=__builtin_amdgcn_mfma_f32_32x32x16_bf16(kf[1],qr[0],CIN,0,0,0), P0[6],P0[7],P0[8],P0[9],     pw0[2]=PKW(P0,4), pw0[3]=PKW(P0,6), pw0); \
    VRD(1); SBAR(); GAPA(C0=__builtin_amdgcn_mfma_f32_32x32x16_bf16(kf[2],qr[1],C0,0,0,0),   P0[10],P0[11],P0[12],P0[13], pw1[0]=PKW(P0,8), pw1[1]=PKW(P0,10), pw1); \
    VRD(5); SBAR(); GAPA(C1=__builtin_amdgcn_mfma_f32_32x32x16_bf16(kf[3],qr[1],C1,0,0,0),   P0[14],P0[15],P1[0],P1[1],   pw1[2]=PKW(P0,12),pw1[3]=PKW(P0,14), pw1); \
    VRD(2); SBAR(); GAPA(C0=__builtin_amdgcn_mfma_f32_32x32x16_bf16(kf[4],qr[2],C0,0,0,0),   P1[2],P1[3],P1[4],P1[5],     pw2[0]=PKW(P1,0), pw2[1]=PKW(P1,2), pw2); \
    VRD(6); SBAR(); GAPA(C1=__builtin_amdgcn_mfma_f32_32x32x16_bf16(kf[5],qr[2],C1,0,0,0),   P1[6],P1[7],P1[8],P1[9],     pw2[2]=PKW(P1,4), pw2[3]=PKW(P1,6), pw2); \
    VRD(3); SBAR(); GAPA(C0=__builtin_amdgcn_mfma_f32_32x32x16_bf16(kf[6],qr[3],C0,0,0,0),   P1[10],P1[11],P1[12],P1[13], pw3[0]=PKW(P1,8), pw3[1]=PKW(P1,10), pw3); \
    VRD(7); SBAR(); GAPA(C1=__builtin_amdgcn_mfma_f32_32x32x16_bf16(kf[7],qr[3],C1,0,0,0),   P1[14],P1[15],0.f,0.f,       pw3[2]=PKW(P1,12),pw3[3]=PKW(P1,14), pw3); \
    l_reg+=sacc; \
    if(GK){DMA_K((t)+3,sl_cur);} if(GV){DMA_V((t)+1,sl_next);} \
    FADD(C0,C1,t); CMASK(C0,C1,t); \
    { float a=MX3(C0[0],C0[1],C1[0]),b=MX3(C0[2],C0[3],C1[1]); a=MX3(a,C1[2],C1[3]); \
      _Pragma("unroll") for(int r=4;r<16;r+=4){a=MX3(a,C0[r],C0[r+1]);b=MX3(b,C0[r+2],C0[r+3]);a=MX3(a,C1[r],C1[r+1]);b=MX3(b,C1[r+2],C1[r+3]);} \
      float rm=__builtin_fmaxf(a,b); { auto rr=__builtin_amdgcn_permlane32_swap(__float_as_uint(rm),__float_as_uint(rm),false,false); rm=__builtin_fmaxf(__uint_as_float(rr[0]),__uint_as_float(rr[1])); } \
      resc=false; \
      const float rmr=rm-mhat; \
      if(__builtin_expect(__any(rmr>(float)THRL),0)){ const float dl=__builtin_fmaxf(rmr,0.f); mhat+=dl; \
        const float f=__builtin_amdgcn_exp2f(-dl); l_reg*=f; if(hi==0)wsf[r32]=f; resc=true; } } \
    SBAR(); \
    GAPB2(o[0]=__builtin_amdgcn_mfma_f32_32x32x16_bf16(PAF(0),VFR(0),o[0],0,0,0), C0,0); VRD2(0); \
    GAPB2(o[1]=__builtin_amdgcn_mfma_f32_32x32x16_bf16(PAF(0),VFR(4),o[1],0,0,0), C0,2); VRD2(4); \
    KRD(GL,0); GAPB2(o[0]=__builtin_amdgcn_mfma_f32_32x32x16_bf16(PAF(1),VFR(1),o[0],0,0,0), C0,4); VRD2(1); \
    KRD(GL,1); GAPB2(o[1]=__builtin_amdgcn_mfma_f32_32x32x16_bf16(PAF(1),VFR(5),o[1],0,0,0), C0,6); VRD2(5); \
    KRD(GL,2); GAPB2(o[0]=__builtin_amdgcn_mfma_f32_32x32x16_bf16(PAF(2),VFR(2),o[0],0,0,0), C0,8); VRD2(2); \
    KRD(GL,3); GAPB2(o[1]=__builtin_amdgcn_mfma_f32_32x32x16_bf16(PAF(2),VFR(6),o[1],0,0,0), C0,10); VRD2(6); \
    GAPB2(o[0]=__builtin_amdgcn_mfma_f32_32x32x16_bf16(PAF(3),VFR(3),o[0],0,0,0), C0,12); VRD2(3); \
    GAPB2(o[1]=__builtin_amdgcn_mfma_f32_32x32x16_bf16(PAF(3),VFR(7),o[1],0,0,0), C0,14); VRD2(7); \
    GAPB2(o[2]=__builtin_amdgcn_mfma_f32_32x32x16_bf16(PAF(0),VFR(0),o[2],0,0,0), C1,0); GAPB2(o[3]=__builtin_amdgcn_mfma_f32_32x32x16_bf16(PAF(0),VFR(4),o[3],0,0,0), C1,2); \
    GAPB2(o[2]=__builtin_amdgcn_mfma_f32_32x32x16_bf16(PAF(1),VFR(1),o[2],0,0,0), C1,4); GAPB2(o[3]=__builtin_amdgcn_mfma_f32_32x32x16_bf16(PAF(1),VFR(5),o[3],0,0,0), C1,6); \
    GAPB2(o[2]=__builtin_amdgcn_mfma_f32_32x32x16_bf16(PAF(2),VFR(2),o[2],0,0,0), C1,8); GAPB2(o[3]=__builtin_amdgcn_mfma_f32_32x32x16_bf16(PAF(2),VFR(6),o[3],0,0,0), C1,10); \
    GAPB2(o[2]=__builtin_amdgcn_mfma_f32_32x32x16_bf16(PAF(3),VFR(3),o[2],0,0,0), C1,12); GAPB2(o[3]=__builtin_amdgcn_mfma_f32_32x32x16_bf16(PAF(3),VFR(7),o[3],0,0,0), C1,14); \
    }while(0)
  int t=1;
  #undef CMASK
  #define CMASK(P0,P1,t) do{}while(0)
  for(;t+(MODE==0?7:5)<NT;t+=2){
    STEP(pB0,pB1,pA0,pA1,t,true,true,true);     WAIT_BAR(3); RESC(); ROT();
    STEP(pA0,pA1,pB0,pB1,t+1,true,true,true);   WAIT_BAR(3); RESC(); ROT();
  }
  #undef CMASK
  #define CMASK(P0,P1,t) do{int jb_=(t)-(NT-4); if(MODE==1){ if(jb_>=0)cmask(P0,P1,jb_,qrel,hi); } else { if(jb_>=-2)biasmask(P0,P1,jb_,qrel,hi,tab3); } }while(0)
  #define ENDW(tt) do{ if((tt)+3<NT){WAIT_BAR(3);} else if((tt)+2<NT){WAIT_BAR(2);} else {WAIT_BAR(0);} }while(0)
  for(;t+1<NT;t+=2){
    STEP(pB0,pB1,pA0,pA1,t,(t+3<NT),(t+1<NT),(t+1<NT));       ENDW(t);   RESC(); ROT();
    STEP(pA0,pA1,pB0,pB1,t+1,(t+4<NT),(t+2<NT),(t+2<NT));     ENDW(t+1); RESC(); ROT();
  }
  STEP(pB0,pB1,pA0,pA1,NT-1,false,false,false); RESC();
  { float sacc=pB0[0]+pB0[1]; _Pragma("unroll") for(int r=2;r<16;++r)sacc+=pB0[r]; _Pragma("unroll") for(int r=0;r<16;++r)sacc+=pB1[r]; l_reg+=sacc;
    pw0=(u32x4){PKW(pB0,0),PKW(pB0,2),PKW(pB0,4),PKW(pB0,6)};pw1=(u32x4){PKW(pB0,8),PKW(pB0,10),PKW(pB0,12),PKW(pB0,14)};pw2=(u32x4){PKW(pB1,0),PKW(pB1,2),PKW(pB1,4),PKW(pB1,6)};pw3=(u32x4){PKW(pB1,8),PKW(pB1,10),PKW(pB1,12),PKW(pB1,14)};
    SBAR(); pv_w(o,vb0+2*sl_cur,PAF(0),PAF(1),PAF(2),PAF(3)); }
  #undef PKW
  #undef PAF
  #undef VFR
  #undef PIN
  #undef MX3
  #undef GAPA
  #undef GAPB
  #undef GAPC
  #undef GAPB2
  #undef VRD2
  #undef EX
  #undef VRD
  #undef KRD
  #undef STEP
  #undef ENDW
  {auto rr=__builtin_amdgcn_permlane32_swap(__float_as_uint(l_reg),__float_as_uint(l_reg),false,false);l_reg=__uint_as_float(rr[0])+__uint_as_float(rr[1]);}
  if(hi==0)wsf[32+r32]=l_reg;asm volatile("s_waitcnt lgkmcnt(0)":::"memory");
  float rli[16];
  #pragma unroll
  for(int r=0;r<16;++r)rli[r]=__builtin_amdgcn_rcpf(wsf[32+crow(r,hi)]);
  bf16*Ow=O+(rowbase+q0+wid*QBLK)*DM+oc;
  int lane2=tid_in; asm volatile("":"+v"(lane2)); lane2&=63;
  { bf16*stg=(bf16*)(shm+WLDS_OST)+wid*2048;
    #pragma unroll
    for(int hh=0;hh<2;++hh){
      #pragma unroll
      for(int r=0;r<16;++r){const int orow=crow(r,hi);
        #pragma unroll
        for(int d0=0;d0<2;++d0)stg[orow*64+d0*32+r32]=__float2bfloat16(o[2*hh+d0][r]*rli[r]);}
      asm volatile("s_waitcnt lgkmcnt(0)":::"memory");
      #pragma unroll
      for(int i=0;i<4;++i){const int row=i*8+(lane2>>3),ch=lane2&7; const u32x4 v=*(const u32x4*)(stg+row*64+ch*8); ATTN_STORE16(Ow+(long)row*DM+hh*64+ch*8,v);}
      asm volatile("s_waitcnt lgkmcnt(0)":::"memory"); } }
  asm volatile("s_waitcnt lgkmcnt(0)\n\ts_barrier":::"memory");
  #undef FADD
  #undef CIN
  #undef DMA_K
  #undef DMA_V
  #undef CMASK
  #undef START
  #undef RESC
  #undef ROT
}
constexpr int ATTN_W_LDS_BYTES=WLDS_BYTES+1024;
constexpr int ATTN_LDS_BYTES=LDS_BYTES;
#undef SBAR
#undef WAIT_BAR
}
namespace cg = cooperative_groups;
constexpr int NWAVES = 8;
constexpr int BATCH = 4, T = 8192, D = 1024, FF = 2816, NIN = 2 * FF, M = BATCH * T, NMOD = 9 * D;
constexpr float EPS = 1e-6f, LOG2E = 1.4426950408889634f;
constexpr size_t MiB = 1u << 20;
constexpr size_t WS_CNT = 6 * MiB, WS_XBUF = 7 * MiB, WS_BAR = 1 * MiB + 832 * 1024, WS_QCTR = 1 * MiB + 768 * 1024, WS_KPART = 1 * MiB + 512 * 1024, WS_MOD = 1 * MiB, WS_LOGF = 2 * MiB, WS_NF2 = 4 * MiB, WS_WB = 8 * MiB, WS_XN = 52 * MiB, WS_R1 = 116 * MiB, WS_R2 = 308 * MiB, WS_XN2 = 436 * MiB, WS_WA = 436 * MiB, WS_END = 500 * MiB;
constexpr size_t WO_IN0 = 0, WO_IN1 = 11 * MiB, WO_OUT0 = 22 * MiB, WO_OUT1 = 22 * MiB + 5767168, WO_X1 = 33 * MiB, WO_AWO = 39 * MiB, WO_BWQ = 37 * MiB, WO_BWO = 39 * MiB;
constexpr size_t BUF64 = 64 * MiB;
constexpr int RING_BYTES = 131072, LDS_BYTES = 147456;
static_assert(attn_body::ATTN_LDS_BYTES + 32768 <= RING_BYTES && attn_body::ATTN_W_LDS_BYTES <= RING_BYTES, "attention LDS");

#define LAS __attribute__((address_space(3)))
typedef unsigned short bf16;
typedef unsigned v4u __attribute__((ext_vector_type(4)));
typedef float f32x4 __attribute__((ext_vector_type(4)));
#define LDS_WAIT() asm volatile("s_waitcnt lgkmcnt(0)" ::: "memory")

#define XB_TMO      128
#define XB_XCNT(j)  (256  + 64 * (j))
#define XB_XSUB(j)  (1280 + 64 * (j))
#define XB_XGEN(j)  (2304 + 64 * (j))
#define XB_TOP      3328
#define XB_TOPGEN   3392
#define XCD_BAR_WORDS 3456
#define XB_SPIN_CAP (1u << 18)

__device__ __forceinline__ unsigned xb_ld(unsigned* p)              { return __hip_atomic_load(p, __ATOMIC_RELAXED, __HIP_MEMORY_SCOPE_AGENT); }
__device__ __forceinline__ unsigned xb_add(unsigned* p, unsigned v) { return __hip_atomic_fetch_add(p, v, __ATOMIC_RELAXED, __HIP_MEMORY_SCOPE_AGENT); }
__device__ __forceinline__ unsigned xb_xcc_id() { return (unsigned)__builtin_amdgcn_s_getreg((3 << 11) | 20) & 0xFu; }
#define XB_SPIN(cond, bar) do { unsigned _sp = 0; while (cond) { __builtin_amdgcn_s_sleep(1); \
    if ((++_sp & 255u) == 0u) { if (xb_ld(&(bar)[XB_TMO])) break; if (_sp > XB_SPIN_CAP) { atomicAdd(&(bar)[XB_TMO], 1u); break; } } } } while (0)

struct XcdBarrier {
    unsigned* bar; unsigned x;
    volatile LAS unsigned* st;
};

__device__ __forceinline__ XcdBarrier xcd_barrier_post(unsigned* bar, volatile LAS unsigned* st, int tid) {
    XcdBarrier b; b.bar = bar; b.x = xb_xcc_id(); b.st = st;
    if (tid == 0) (void)xb_add(&bar[XB_XCNT(b.x)], 1u);
    return b;
}
__device__ __forceinline__ void xcd_barrier_complete(unsigned* bar, unsigned x, unsigned& nloc, unsigned& nx) {
    const unsigned G = gridDim.x * gridDim.y * gridDim.z;
    unsigned sum, cnt, mine, sp = 0u;
    for (;;) {
        sum = 0u; cnt = 0u; mine = 0u;
#pragma unroll
        for (unsigned j = 0; j < 16; ++j) { const unsigned c = xb_ld(&bar[XB_XCNT(j)]); sum += c; cnt += (c > 0u) ? 1u : 0u; mine = (j == x) ? c : mine; }
        if (sum == G) break;
        __builtin_amdgcn_s_sleep(1);
        if ((++sp & 255u) == 0u) { if (xb_ld(&bar[XB_TMO])) break; if (sp > XB_SPIN_CAP) { atomicAdd(&bar[XB_TMO], 1u); break; } }
    }
    nloc = mine > 0u ? mine : 1u; nx = cnt > 0u ? cnt : 1u;
}

__device__ __forceinline__ void xcd_barrier(const XcdBarrier& b, int tid) {
    asm volatile("s_waitcnt vmcnt(0)" ::: "memory");
    __syncthreads();
    if (tid == 0) {
        unsigned* bar = b.bar;
        __builtin_amdgcn_s_waitcnt(0);
        unsigned nloc = b.st[0], nx = b.st[1];
        if (nloc == 0u) { xcd_barrier_complete(bar, b.x, nloc, nx); b.st[0] = nloc; b.st[1] = nx; }
        const unsigned old = xb_add(&bar[XB_XSUB(b.x)], 1u);
        const unsigned gen = old / nloc;
        if (old + 1u == (gen + 1u) * nloc) {
            __builtin_amdgcn_fence(__ATOMIC_RELEASE, "agent");
            asm volatile("s_waitcnt vmcnt(0)" ::: "memory");
            const unsigned og = xb_add(&bar[XB_TOP], 1u);
            const unsigned tg = og / nx;
            if (og + 1u == (tg + 1u) * nx) xb_add(&bar[XB_TOPGEN], 1u);
            else XB_SPIN(xb_ld(&bar[XB_TOPGEN]) == tg, bar);
            __builtin_amdgcn_fence(__ATOMIC_ACQUIRE, "agent");
            xb_add(&bar[XB_XGEN(b.x)], 1u);
            asm volatile("s_waitcnt vmcnt(0)" ::: "memory");
        } else {
            XB_SPIN(xb_ld(&bar[XB_XGEN(b.x)]) == gen, bar);
            __builtin_amdgcn_fence(__ATOMIC_ACQUIRE, "agent");
            asm volatile("s_waitcnt vmcnt(0)" ::: "memory");
        }
    }
    __syncthreads();
}


__device__ __forceinline__ float wave_sum(float v) {
    return wave_sum64(v);
}
__device__ __forceinline__ unsigned pk2(float lo, float hi) { return pg8::cvt_pk_bf16(lo, hi); }
__device__ __forceinline__ float bf_lo(unsigned u) { return __uint_as_float(u << 16); }
__device__ __forceinline__ float bf_hi(unsigned u) { return __uint_as_float(u & 0xffff0000u); }

__device__ __forceinline__ void p0_transpose_item(const float* W, int K, int N, bf16* WT, int perm, LAS float* scr, int item, int lane) {
    const int nblk = N / 32, kb = item / nblk, nb = item % nblk, k0 = 64 * kb, n0 = 32 * nb;
    int nd = n0;
    if (perm) nd = (n0 < FF) ? 256 * (n0 >> 7) + (n0 & 127) : 256 * ((n0 - FF) >> 7) + 128 + ((n0 - FF) & 127);
    float wv[32];
#pragma unroll
    for (int i = 0; i < 32; ++i) wv[i] = W[(size_t)(k0 + 2 * i + (lane >> 5)) * N + n0 + (lane & 31)];
#pragma unroll
    for (int i = 0; i < 32; ++i) scr[(2 * i + (lane >> 5)) * 33 + (lane & 31)] = wv[i];
    LDS_WAIT(); asm volatile("" ::: "memory");
    const int c = lane & 7;
#pragma unroll
    for (int j = 0; j < 4; ++j) { const int n = (lane >> 3) + 8 * j; const LAS float* s = scr + (8 * c) * 33 + n;
        v4u o; o.x = pk2(s[0 * 33], s[1 * 33]); o.y = pk2(s[2 * 33], s[3 * 33]); o.z = pk2(s[4 * 33], s[5 * 33]); o.w = pk2(s[6 * 33], s[7 * 33]);
        *(v4u*)(WT + (size_t)(nd + n) * K + k0 + 8 * c) = o; }
    LDS_WAIT(); asm volatile("" ::: "memory");
}
__device__ __forceinline__ void p0_mod_item(int item, const float* c, const float* ada_w, const float* ada_b, const float* kvw, const float* kvb, float* mod, LAS unsigned char* lds, int tid) {
    LAS float* cact = (LAS float*)lds; LAS float* red = (LAS float*)(lds + 16384);
    for (int i = tid; i < 4096; i += 512) { const int b = i >> 10, k = i & 1023; const float v = c[i]; cact[k * 4 + b] = v * __builtin_amdgcn_rcpf(1.f + __builtin_amdgcn_exp2f(-LOG2E * v)); }
    __syncthreads();
    const float* W; const float* bias; int N, col0, dstride; float* dst;
    if (item < 36) { W = ada_w; bias = ada_b; N = NMOD; col0 = 256 * item; dst = mod; dstride = NMOD; }
    else if (item < 72) { W = ada_w + (size_t)D * NMOD; bias = ada_b + NMOD; N = NMOD; col0 = 256 * (item - 36); dst = mod + 4 * NMOD; dstride = NMOD; }
    else { W = kvw; bias = kvb; N = 2 * D; col0 = 256 * (item - 72); dst = mod + 8 * NMOD; dstride = 2 * D; }
    const int wave = tid >> 6, lane = tid & 63;
    f32x4 a0 = {0.f, 0.f, 0.f, 0.f}, a1 = a0, a2 = a0, a3 = a0;
    const float* wp = W + (size_t)(128 * wave) * N + col0 + 4 * lane;
#pragma unroll 8
    for (int kk = 0; kk < 128; ++kk) { const f32x4 w = *(const f32x4*)(wp + (size_t)kk * N); const f32x4 cv = *(const LAS f32x4*)(cact + (128 * wave + kk) * 4);
        a0 += w * cv.x; a1 += w * cv.y; a2 += w * cv.z; a3 += w * cv.w; }
    LAS f32x4* rp = (LAS f32x4*)(red + (wave * 64 + lane) * 16);
    rp[0] = a0; rp[1] = a1; rp[2] = a2; rp[3] = a3;
    __syncthreads();
    for (int o = tid; o < 1024; o += 512) { const int b = o >> 8, j = o & 255; float s = 0.f;
#pragma unroll
        for (int w = 0; w < 8; ++w) s += red[(w * 64 + (j >> 2)) * 16 + 4 * b + (j & 3)];
        dst[(size_t)b * dstride + col0 + j] = s + bias[col0 + j]; }
    __syncthreads();
}
__device__ __forceinline__ void norm_rows(const float* src, const float* g, const float* shift, const float* scale, int mstride, bf16* dst, int gw, int NGW, int lane) {
    f32x4 nx[4];
    if (gw < M) {
#pragma unroll
        for (int j = 0; j < 4; ++j) nx[j] = ((const f32x4*)(src + (size_t)gw * D) + lane)[64 * j]; }
    for (int m = gw; m < M; m += NGW) {
        const int b = m >> 13;
        f32x4 v[4]; float s = 0.f;
#pragma unroll
        for (int j = 0; j < 4; ++j) v[j] = nx[j];
        if (m + NGW < M) { const f32x4* xn_ = (const f32x4*)(src + (size_t)(m + NGW) * D) + lane;
#pragma unroll
            for (int j = 0; j < 4; ++j) nx[j] = xn_[64 * j]; }
#pragma unroll
        for (int j = 0; j < 4; ++j) s += (v[j].x * v[j].x + v[j].y * v[j].y) + (v[j].z * v[j].z + v[j].w * v[j].w);
        const float rs = __builtin_amdgcn_rsqf(wave_sum(s) * (1.f / D) + EPS);
        const f32x4* g4 = (const f32x4*)g + lane; const f32x4* sh4 = (const f32x4*)(shift + (size_t)b * mstride) + lane; const f32x4* sc4 = (const f32x4*)(scale + (size_t)b * mstride) + lane;
        unsigned long long* o8 = (unsigned long long*)(dst + (size_t)m * D) + lane;
#pragma unroll
        for (int j = 0; j < 4; ++j) { const f32x4 y = v[j] * rs * g4[64 * j] * (sc4[64 * j] + 1.f) + sh4[64 * j];
            o8[64 * j] = (unsigned long long)pk2(y.x, y.y) | ((unsigned long long)pk2(y.z, y.w) << 32); }
    }
}
__device__ __forceinline__ void norm_rows_kv(const bf16* src, const float* gA, const float* shA, const float* scA, int strideA, bf16* dstA,
                                             const float* gB, const float* shB, const float* scB, int strideB, bf16* dstB,
                                             const LAS float* fgT, const float* fgb, float* logf_out, int gw, int NGW, int lane) {
    unsigned long long nw[4] = {0ull, 0ull, 0ull, 0ull};
    if (gw < M) { const unsigned long long* x0_ = (const unsigned long long*)(src + (size_t)gw * D) + lane;
#pragma unroll
        for (int j = 0; j < 4; ++j) nw[j] = x0_[64 * j]; }
    for (int m = gw; m < M; m += NGW) {
        const int b = m >> 13;
        unsigned long long cw[4];
#pragma unroll
        for (int j = 0; j < 4; ++j) cw[j] = nw[j];
        if (m + NGW < M) { const unsigned long long* xn_ = (const unsigned long long*)(src + (size_t)(m + NGW) * D) + lane;
#pragma unroll
            for (int j = 0; j < 4; ++j) nw[j] = xn_[64 * j]; }
        f32x4 v[4]; float s = 0.f;
#pragma unroll
        for (int j = 0; j < 4; ++j) { const unsigned long long w = cw[j]; const unsigned lo = (unsigned)w, hi = (unsigned)(w >> 32);
            { const pg8::f32x2s_t a = pg8::up_h2(lo), b = pg8::up_h2(hi); v[j] = (f32x4){a.x, a.y, b.x, b.y}; } s += (v[j].x * v[j].x + v[j].y * v[j].y) + (v[j].z * v[j].z + v[j].w * v[j].w); }
        const float rs = __builtin_amdgcn_rsqf(wave_sum(s) * (1.f / D) + EPS);
        {   const f32x4* g4 = (const f32x4*)gB + lane; const f32x4* sh4 = (const f32x4*)(shB + (size_t)b * strideB) + lane; const f32x4* sc4 = (const f32x4*)(scB + (size_t)b * strideB) + lane;
            unsigned long long* o8 = (unsigned long long*)(dstB + (size_t)m * D) + lane;
#pragma unroll
            for (int j = 0; j < 4; ++j) { const f32x4 y = v[j] * rs * g4[64 * j] * (sc4[64 * j] + 1.f) + sh4[64 * j];
                o8[64 * j] = (unsigned long long)pk2(y.x, y.y) | ((unsigned long long)pk2(y.z, y.w) << 32); } }
        {   const f32x4* g4 = (const f32x4*)gA + lane; const f32x4* sh4 = (const f32x4*)(shA + (size_t)b * strideA) + lane; const f32x4* sc4 = (const f32x4*)(scA + (size_t)b * strideA) + lane;
            unsigned long long* o8 = (unsigned long long*)(dstA + (size_t)m * D) + lane;
#pragma unroll
            for (int j = 0; j < 4; ++j) { v[j] = v[j] * rs * g4[64 * j] * (sc4[64 * j] + 1.f) + sh4[64 * j];
                o8[64 * j] = (unsigned long long)pk2(v[j].x, v[j].y) | ((unsigned long long)pk2(v[j].z, v[j].w) << 32); } }
        float zmine = 0.f;
#pragma unroll
        for (int hh = 0; hh < 16; ++hh) { float p = 0.f;
#pragma unroll
            for (int j = 0; j < 4; ++j) { const f32x4 w = *(const LAS f32x4*)(fgT + hh * 1024 + 256 * j + 4 * lane); p += (v[j].x * w.x + v[j].y * w.y) + (v[j].z * w.z + v[j].w * w.w); }
            p = wave_sum(p); if (lane == hh) zmine = p; }
        if (lane < 16) { const float z = zmine + fgb[lane]; const float lf = fminf(z, 0.f) - 0.6931471805599453f * __builtin_amdgcn_logf(1.f + __builtin_amdgcn_exp2f(-LOG2E * fabsf(z)));     logf_out[(size_t)m * 16 + lane] = lf; }
    }
}
__device__ __forceinline__ void combine_rows(const bf16* O0, const bf16* O1, const float* lamp, const float* subg, bf16* dst, int gw, int NGW, int lane) {
    const float pa = lamp[lane] * lamp[64 + lane], pb = lamp[128 + lane] * lamp[192 + lane];
    const float lam = __builtin_amdgcn_exp2f(LOG2E * wave_sum(pa)) - __builtin_amdgcn_exp2f(LOG2E * wave_sum(pb)) + 0.2f;
    float gg[16];
#pragma unroll
    for (int e = 0; e < 16; ++e) gg[e] = subg[16 * (lane & 7) + e] * 0.8f;
    v4u na0, na1, nb0, nb1;
    if (gw < M) { const v4u* p0 = (const v4u*)(O0 + (size_t)gw * D + 16 * lane); const v4u* p1 = (const v4u*)(O1 + (size_t)gw * D + 16 * lane); na0 = p0[0]; na1 = p0[1]; nb0 = p1[0]; nb1 = p1[1]; }
    for (int m = gw; m < M; m += NGW) {
        const v4u a0 = na0, a1 = na1, b0 = nb0, b1 = nb1;
        if (m + NGW < M) { const v4u* p0 = (const v4u*)(O0 + (size_t)(m + NGW) * D + 16 * lane); const v4u* p1 = (const v4u*)(O1 + (size_t)(m + NGW) * D + 16 * lane); na0 = p0[0]; na1 = p0[1]; nb0 = p1[0]; nb1 = p1[1]; }
        float v[16];
#pragma unroll
        for (int i = 0; i < 4; ++i) { v[2 * i] = bf_lo(a0[i]) - lam * bf_lo(b0[i]); v[2 * i + 1] = bf_hi(a0[i]) - lam * bf_hi(b0[i]);
            v[8 + 2 * i] = bf_lo(a1[i]) - lam * bf_lo(b1[i]); v[8 + 2 * i + 1] = bf_hi(a1[i]) - lam * bf_hi(b1[i]); }
        float ss = 0.f;
#pragma unroll
        for (int e = 0; e < 16; ++e) ss += v[e] * v[e];
        ss = xadd<1>(ss); ss = xadd<2>(ss); ss = xadd<4>(ss);
        const float rs = __builtin_amdgcn_rsqf(ss * (1.f / 128.f) + EPS);
        v4u o0, o1;
#pragma unroll
        for (int i = 0; i < 4; ++i) { o0[i] = pk2(v[2 * i] * rs * gg[2 * i], v[2 * i + 1] * rs * gg[2 * i + 1]); o1[i] = pk2(v[8 + 2 * i] * rs * gg[8 + 2 * i], v[8 + 2 * i + 1] * rs * gg[8 + 2 * i + 1]); }
        v4u* q = (v4u*)(dst + (size_t)m * D + 16 * lane); q[0] = o0; q[1] = o1;
    }
}
__device__ __forceinline__ void scan_seq(int seq, const float* logf_in, float* nf2, LAS unsigned char* lds, int tid) {
    const int b = seq >> 4, hh = seq & 15, s0 = 16 * tid, lane = tid & 63, wave = tid >> 6;
    float v[16]; float run = 0.f;
#pragma unroll
    for (int i = 0; i < 16; ++i) { run += logf_in[((size_t)(b * T + s0 + i)) * 16 + hh]; v[i] = run; }
    float incl = run;
#pragma unroll
    for (int o = 1; o < 64; o <<= 1) { const float t = __int_as_float(__builtin_amdgcn_ds_bpermute((lane - o) << 2, __float_as_int(incl))); if (lane >= o) incl += t; }
    LAS float* wt = (LAS float*)lds;
    if (lane == 63) wt[wave] = incl;
    __syncthreads();
    float off = incl - run;
    for (int w = 0; w < wave; ++w) off += wt[w];
#pragma unroll
    for (int i = 0; i < 16; ++i) nf2[(size_t)seq * T + s0 + i] = -(off + v[i]) * LOG2E;
    __syncthreads();
}

__device__ __forceinline__ void kmax_rows(const bf16* KB, float* kpart, LAS unsigned char* lds, int gw, int NGW, int tid, int lane, int bx) {
    LAS unsigned* lm = (LAS unsigned*)lds;
    if (tid < 64) lm[tid] = 0u;
    __syncthreads();
    float run = 0.f; int cb = -1;
    v4u ka0 = {0u, 0u, 0u, 0u}, ka1 = ka0;
    if (gw < M) { const v4u* p0_ = (const v4u*)(KB + (size_t)gw * D + 16 * lane); ka0 = p0_[0]; ka1 = p0_[1]; }
    for (int m = gw; m < M; m += NGW) {
        const int b = m >> 13;
        if (b != cb) { if (cb >= 0 && (lane & 3) == 0) atomicMax((unsigned*)(lm + cb * 16 + (lane >> 2)), __float_as_uint(run)); run = 0.f; cb = b; }
        const v4u a0 = ka0, a1 = ka1;
        if (m + NGW < M) { const v4u* pn_ = (const v4u*)(KB + (size_t)(m + NGW) * D + 16 * lane); ka0 = pn_[0]; ka1 = pn_[1]; }
        float ss = 0.f;
#pragma unroll
        for (int i = 0; i < 4; ++i) { const float x0 = bf_lo(a0[i]), x1 = bf_hi(a0[i]), x2 = bf_lo(a1[i]), x3 = bf_hi(a1[i]); ss += (x0 * x0 + x1 * x1) + (x2 * x2 + x3 * x3); }
        ss = xadd<1>(ss); ss = xadd<2>(ss);
        run = fmaxf(run, ss);
    }
    if (cb >= 0 && (lane & 3) == 0) atomicMax((unsigned*)(lm + cb * 16 + (lane >> 2)), __float_as_uint(run));
    __syncthreads();
    if (tid < 64) kpart[(size_t)bx * 64 + tid] = __uint_as_float(lm[tid]);
    __syncthreads();
}

struct Args { const float* in[21]; float* out; unsigned char* ws; int pad0, pad1; };
enum { K_PRO = 0, K_NORM, K_SWIGLU, K_RESID, K_SPLIT, K_ATTNA, K_COMB, K_NORMKV, K_ATTNB, K_RESIDN, K_NOP };
constexpr int NPH = 23;

__global__ void __launch_bounds__(NWAVES * 64, 2) skel_fwd(Args args) {
    extern __shared__ __attribute__((aligned(16))) unsigned char lds[];
    cg::grid_group grid = cg::this_grid();
    LAS unsigned char* ldsL = (LAS unsigned char*)lds;
    typedef __attribute__((address_space(4))) const Args CArgs;
    {   volatile LAS unsigned* bst0 = (volatile LAS unsigned*)(ldsL + RING_BYTES + 512);
        if (threadIdx.x < 2) bst0[threadIdx.x] = 0u;
        if (blockIdx.x == 0) { unsigned* bw = (unsigned*)(args.ws + WS_BAR); for (int i = threadIdx.x; i < XCD_BAR_WORDS; i += NWAVES * 64) bw[i] = 0u;
            unsigned* cw = (unsigned*)(args.ws + WS_CNT); for (int i = threadIdx.x; i < 5 * 128 * 64; i += NWAVES * 64) cw[i] = 0u; }
        __syncthreads(); }
    int prep = 0;
    const int wave_s = __builtin_amdgcn_readfirstlane(threadIdx.x >> 6);
#pragma nounroll
    for (int ph = 0; ph < NPH; ++ph) {
        CArgs* ap = (CArgs*)__builtin_amdgcn_kernarg_segment_ptr();
        asm volatile("" : "+s"(ap));
        const int wave = wave_s;
#define TID() opq_tid(wave_s)
        int G = gridDim.x, bx = blockIdx.x; asm volatile("" : "+s"(G), "+s"(bx));
        const int vcu = (G % 8 == 0) ? (bx % 8) * (G / 8) + bx / 8 : bx;
        const int gw = vcu * NWAVES + wave, NGW = G * NWAVES;
        unsigned char* ws = ap->ws;
        const float* x = ap->in[0];
        float* OUTF = ap->out; bf16* XB = (bf16*)ap->out;
        bf16* XB2 = (bf16*)(ws + WS_XN2);
        float* mod = (float*)(ws + WS_MOD);
        float* kvmod = mod + 8 * NMOD;
        float* logfb = (float*)(ws + WS_LOGF);
        float* nf2 = (float*)(ws + WS_NF2);
        bf16* XN = (bf16*)(ws + WS_XN); bf16* XN2 = (bf16*)(ws + WS_XN2);
        bf16* R1 = (bf16*)(ws + WS_R1); bf16* R2 = (bf16*)(ws + WS_R2);
        const float* norm_g = ap->in[4];
        int kind = K_NORM; bool sync_after = true;
        const bf16* gA = XN; const bf16* gB = nullptr; int gN = D, gK = D;
        const float* nsrc = x; const float* ng = norm_g; const float* nsh = mod; const float* nsc = mod;
        const void* rbase = XB; int rbase_bf = 1; bf16* rout = XB; const float* rgate = mod; float rcoef = 0.5f;
        bf16* sO = R1; float sscale = 1.f;
        int bank = 0, fin = 0;
        const int L = (ph >= 12) ? 1 : 0;
        unsigned char* wl = ws + (L ? WS_WB : WS_WA);
        const float* modl = mod + (size_t)L * 4 * NMOD;
        switch (ph) {
            case 0: kind = K_PRO; break;
            case 1: kind = K_NORM; nsrc = x; ng = norm_g; nsh = modl; nsc = modl + D; break;
            case 2: kind = K_SWIGLU; gB = (const bf16*)(wl + WO_IN0); gN = NIN; gK = D; break;
            case 3: kind = K_RESIDN; gA = R1; gB = (const bf16*)(wl + WO_OUT0); gN = D; gK = FF; rbase = x; rbase_bf = 0; rgate = modl + 2 * D; rcoef = 0.5f; bank = 0; ng = norm_g + D; nsh = modl + 3 * D; nsc = modl + 4 * D; break;
            case 4: kind = K_NOP; sync_after = false; break;
            case 5: kind = K_SPLIT; gB = (const bf16*)(wl + WO_X1); gN = 3 * D; gK = D; sO = R1; sscale = attn_body::C2; break;
            case 6: kind = K_ATTNA; break;
            case 7: kind = K_COMB; break;
            case 8: kind = K_RESIDN; gA = R1; gB = (const bf16*)(wl + WO_AWO); gN = D; gK = D; rgate = modl + 5 * D; rcoef = 1.f; bank = 1; ng = norm_g + 2 * D; nsh = modl + 6 * D; nsc = modl + 7 * D; break;
            case 9: kind = K_NOP; sync_after = false; break;
            case 10: kind = K_SWIGLU; gB = (const bf16*)(wl + WO_IN1); gN = NIN; gK = D; break;
            case 11: kind = K_RESID; gA = R1; gB = (const bf16*)(wl + WO_OUT1); gN = D; gK = FF; rgate = modl + 8 * D; rcoef = 0.5f; break;
            case 12: kind = K_NORMKV; break;
            case 13: kind = K_SPLIT; gB = (const bf16*)(wl + WO_X1); gN = 2 * D; gK = D; sO = R2; sscale = 1.f; sync_after = false; break;
            case 14: kind = K_SWIGLU; gA = XN2; gB = (const bf16*)(wl + WO_IN0); gN = NIN; gK = D; break;
            case 15: kind = K_RESIDN; gA = R1; gB = (const bf16*)(wl + WO_OUT0); gN = D; gK = FF; rgate = modl + 2 * D; rcoef = 0.5f; bank = 2; ng = norm_g + 4 * D; nsh = modl + 3 * D; nsc = modl + 4 * D; break;
            case 16: kind = K_NOP; sync_after = false; break;
            case 17: kind = K_SPLIT; gB = (const bf16*)(wl + WO_BWQ); gN = D; gK = D; sO = R1; sscale = attn_body::C2; break;
            case 18: kind = K_ATTNB; break;
            case 19: kind = K_RESIDN; gA = R1; gB = (const bf16*)(wl + WO_BWO); gN = D; gK = D; rgate = modl + 5 * D; rcoef = 1.f; bank = 3; rout = XB2; ng = norm_g + 5 * D; nsh = modl + 6 * D; nsc = modl + 7 * D; break;
            case 20: kind = K_NOP; sync_after = false; break;
            case 21: kind = K_SWIGLU; gB = (const bf16*)(wl + WO_IN1); gN = NIN; gK = D; break;
            case 22: kind = K_RESIDN; gA = R1; gB = (const bf16*)(wl + WO_OUT1); gN = D; gK = FF; rgate = modl + 8 * D; rcoef = 0.5f; bank = 4; fin = 1; rbase = XB2; ng = ap->in[20]; sync_after = false; break;
            default: kind = K_NOP; sync_after = false; break;
        }
#ifndef PROBE_REP
#define PROBE_REP 0
#endif
#ifndef PROBE_SYNC
#define PROBE_SYNC 1
#endif
        if (kind == K_PRO) {
            if (bx == 0 && TID() == 0) *(unsigned*)(ws + WS_QCTR) = 0u;
            if (PROBE_REP != 0 && bx == 1 && TID() == 0) ((unsigned*)(ws + WS_QCTR))[1] = 0u;
            for (int it = bx; it < 80; it += G) p0_mod_item(it, ap->in[1], ap->in[2], ap->in[3], ap->in[12], ap->in[13], mod, ldsL, TID());
            LAS float* scr = (LAS float*)(ldsL + wave * 16384);
            constexpr int I_IN = (D / 64) * (NIN / 32), I_OUT = (FF / 64) * (D / 32), I_QKV = (D / 64) * (3 * D / 32), I_SQ = (D / 64) * (D / 32), I_KV = (D / 64) * (2 * D / 32);
            constexpr int NITEMS = 4 * I_IN + 4 * I_OUT + I_QKV + I_SQ + I_KV + 2 * I_SQ;
            for (int it = gw; it < NITEMS; it += NGW) {
                int r = it; const float* W; int K, N, perm = 0; bf16* WT;
                if (r < 4 * I_IN) { const int w = r / I_IN; r -= w * I_IN; W = ap->in[5] + (size_t)w * D * NIN; K = D; N = NIN; perm = 1;
                    WT = (bf16*)(ws + ((w >> 1) ? WS_WB : WS_WA) + ((w & 1) ? WO_IN1 : WO_IN0)); }
                else if ((r -= 4 * I_IN) < 4 * I_OUT) { const int w = r / I_OUT; r -= w * I_OUT; W = ap->in[6] + (size_t)w * FF * D; K = FF; N = D;
                    WT = (bf16*)(ws + ((w >> 1) ? WS_WB : WS_WA) + ((w & 1) ? WO_OUT1 : WO_OUT0)); }
                else if ((r -= 4 * I_OUT) < I_QKV) { W = ap->in[7]; K = D; N = 3 * D; WT = (bf16*)(ws + WS_WA + WO_X1); }
                else if ((r -= I_QKV) < I_SQ) { W = ap->in[8]; K = D; N = D; WT = (bf16*)(ws + WS_WA + WO_AWO); }
                else if ((r -= I_SQ) < I_KV) { W = ap->in[15]; K = D; N = 2 * D; WT = (bf16*)(ws + WS_WB + WO_X1); }
                else if ((r -= I_KV) < I_SQ) { W = ap->in[18]; K = D; N = D; WT = (bf16*)(ws + WS_WB + WO_BWQ); }
                else { r -= I_SQ; W = ap->in[19]; K = D; N = D; WT = (bf16*)(ws + WS_WB + WO_BWO); }
                p0_transpose_item(W, K, N, WT, perm, scr, r, TID() & 63);
            }
        } else if (kind == K_NORM) {
            norm_rows(nsrc, ng, nsh, nsc, NMOD, XN, gw, NGW, TID() & 63);
        } else if (kind == K_NORMKV) {
            LAS float* fgT = (LAS float*)ldsL;
            for (int i = TID(); i < 16 * D; i += NWAVES * 64) { const int c = i >> 4, hh = i & 15; fgT[hh * 1024 + c] = ap->in[16][i]; }
            __syncthreads();
            norm_rows_kv(XB, ap->in[14], kvmod, kvmod + D, 2 * D, XN, norm_g + 3 * D, modl, modl + D, NMOD, XN2, fgT, ap->in[17], logfb, gw, NGW, TID() & 63);
            __syncthreads();
        } else if (kind == K_SWIGLU) {
            pg8::Gemm g{gA, gB, M, gN, gK}; pg8::StaticOrder S; S.init(M, gN, G, bx);
            pg8::EpiSwiglu E{R1, FF};
            pg8::gemm_phase<pg8::EpiSwiglu, pg8::StaticOrder, true, true>(ldsL, g, S, E, TID());
        } else if (kind == K_RESID) {
            pg8::Gemm g{gA, gB, M, gN, gK}; pg8::StaticOrder S; S.init(M, gN, G, bx);
            pg8::EpiResid E{(const bf16*)rbase, rout, rgate, NMOD, rcoef};
            pg8::gemm_phase<pg8::EpiResid, pg8::StaticOrder, true, true>(ldsL, g, S, E, TID());
        } else if (kind == K_RESIDN) {
            pg8::Gemm g{gA, gB, M, D, gK}; pg8::StaticOrder S; S.init(M, D, G, bx);
            pg8::RmsStats st{(unsigned*)(ws + WS_XBUF), (unsigned*)(ws + WS_CNT) + (size_t)bank * 128 * 64, EPS};
#define RUN_RESIDN(BH, FN) do { pg8::EpiResidNorm<BH, FN> E{rbase, rout, OUTF, rgate, NMOD, rcoef, ng, nsh, nsc, NMOD, XN, st, ldsL + RING_BYTES + 1024}; \
                pg8::gemm_phase<pg8::EpiResidNorm<BH, FN>, pg8::StaticOrder, true, true>(ldsL, g, S, E, TID()); } while (0)
            if (fin) RUN_RESIDN(true, true); else if (rbase_bf) RUN_RESIDN(true, false); else RUN_RESIDN(false, false);
#undef RUN_RESIDN
        } else if (kind == K_SPLIT) {
            if (ph == 17) { const int t_ = TID(); kmax_rows(R2, (float*)(ws + WS_KPART), ldsL, gw, NGW, t_, t_ & 63, bx); }
            pg8::Gemm g{gA, gB, M, gN, gK}; pg8::StaticOrder S; S.init(M, gN, G, bx);
            pg8::EpiBf16<0> E{sO, D, nullptr, D, BUF64 / 2, sscale};
            pg8::gemm_phase<pg8::EpiBf16<0>, pg8::StaticOrder, true, true>(ldsL, g, S, E, TID());
            if (ph == 13) { for (int seq = bx; seq < 64; seq += G) scan_seq(seq, logfb, nf2, ldsL, TID()); }
        } else if (kind == K_ATTNA) {
            const attn_body::bf16* Qp = (const attn_body::bf16*)R1; const attn_body::bf16* Kp = Qp + BUF64 / 2; const attn_body::bf16* Vp = Kp + BUF64 / 2;
            attn_body::bf16* O0 = (attn_body::bf16*)R2; attn_body::bf16* O1 = O0 + BUF64 / 2;
            for (int pi = vcu; pi < 1024; pi += G) { const int combo = pi >> 4, s = pi & 15, b = combo >> 4, h16 = combo & 15;
                const int vc = (h16 >> 1) * 128;
                for (int k = 0; k < 2; ++k) { const int qb = k ? s : 31 - s;
                    attn_body::attn_unit_w<8>(b, h16 * 64, h16 * 64, vc, vc, qb, Qp, Kp, Vp, (h16 & 1) ? O1 : O0, (char*)lds, ap->in[11], h16 >> 1, nullptr, 0, TID()); } }
        } else if (kind == K_ATTNB) {
            const attn_body::bf16* Qp = (const attn_body::bf16*)R1; const attn_body::bf16* Kp = (const attn_body::bf16*)R2; const attn_body::bf16* Vp = Kp + BUF64 / 2;
            LAS int* ordl = (LAS int*)(ldsL + RING_BYTES); LAS unsigned* slotl = (LAS unsigned*)(ldsL + RING_BYTES + 256);
            if (wave == 0) { const int lane = TID() & 63; const float v = nf2[(size_t)lane * T + T - 1]; int rank = 0;
                for (int j = 0; j < 64; ++j) { const float vj = __int_as_float(__builtin_amdgcn_readlane(__float_as_int(v), j)); rank += (vj < v || (vj == v && j < lane)) ? 1 : 0; }
                ordl[rank] = lane; }
            __syncthreads();
            unsigned* qctr = (unsigned*)(ws + WS_QCTR) + (PROBE_REP ? prep : 0);
            for (;;) {
                if (TID() == 0) slotl[0] = atomicAdd(qctr, 1u);
                __syncthreads();
                const unsigned u = slotl[0];
                __syncthreads();
                if (u >= 2048u) break;
                const int combo = ordl[u >> 5], qb = 31 - (int)(u & 31u), b = combo >> 4, h = combo & 15;
                attn_body::attn_unit<8, 1>(b, h * 64, h * 64, h * 64, h * 64, qb, Qp, Kp, Vp, (attn_body::bf16*)R1, (char*)lds, nf2 + (size_t)combo * T, 0, (const float*)(ws + WS_KPART) + combo, G, TID());
            }
        } else if (kind == K_COMB) {
            combine_rows(R2, R2 + BUF64 / 2, ap->in[9], ap->in[10], R1, gw, NGW, TID() & 63);
        }
        if (PROBE_REP != 0 && prep == 0 && ((PROBE_REP >> kind) & 1) && kind != K_RESID && kind != K_RESIDN && kind != K_NOP) { prep = 1; --ph; if (ph < 0) { grid.sync(); } else { XcdBarrier bar; bar.bar = (unsigned*)(ws + WS_BAR); bar.x = xb_xcc_id(); bar.st = (volatile LAS unsigned*)(ldsL + RING_BYTES + 512); xcd_barrier(bar, TID()); } continue; }
        prep = 0;
        if (sync_after) {
            XcdBarrier bar; bar.bar = (unsigned*)(ws + WS_BAR); bar.x = xb_xcc_id(); bar.st = (volatile LAS unsigned*)(ldsL + RING_BYTES + 512);
            if (ph == 0) { grid.sync(); if (TID() == 0) (void)xb_add(&bar.bar[XB_XCNT(bar.x)], 1u); }
            else { for (int sy = 0; sy < PROBE_SYNC; ++sy) xcd_barrier(bar, TID()); }
        }
    }
}

extern "C" void kernel_launch(void* const* d_in, const int* in_sizes, int n_in, void* d_out, int out_size, void* d_ws, size_t ws_size, hipStream_t stream) {
    static int grid = 0;
    if (grid == 0) {
        if (n_in != 21 || in_sizes[0] != M * D || out_size != M * D || ws_size < WS_END) { fprintf(stderr, "kernel_launch: unexpected shapes (n_in %d in0 %d out %d ws %zu); nothing launched\n", n_in, n_in > 0 ? in_sizes[0] : -1, out_size, ws_size); grid = -1; return; }
        int dev = 0, cus = 0, per_cu = 0;
        (void)hipGetDevice(&dev);
        (void)hipDeviceGetAttribute(&cus, hipDeviceAttributeMultiprocessorCount, dev);
        (void)hipFuncSetAttribute((const void*)skel_fwd, hipFuncAttributeMaxDynamicSharedMemorySize, LDS_BYTES);
        (void)hipOccupancyMaxActiveBlocksPerMultiprocessor(&per_cu, (const void*)skel_fwd, NWAVES * 64, LDS_BYTES);
        if (per_cu < 1) per_cu = 1;
        grid = cus * per_cu;
    }
    if (grid < 0) return;
    Args a{};
    for (int i = 0; i < 21; ++i) a.in[i] = (const float*)d_in[i];
    a.out = (float*)d_out; a.ws = (unsigned char*)d_ws;
    void* kargs[] = {&a};
    hipError_t e = hipLaunchCooperativeKernel((const void*)skel_fwd, dim3(grid), dim3(NWAVES * 64), kargs, LDS_BYTES, stream);
    if (e != hipSuccess) fprintf(stderr, "cooperative launch failed: %s (grid %d)\n", hipGetErrorString(e), grid);
}
```

```cpp
#include <hip/hip_cooperative_groups.h>
#include <hip/hip_runtime.h>
#include <cstdio>
#include <cstdint>
__device__ __forceinline__ int opq_tid(int wave_s) { int l; asm volatile("v_mbcnt_lo_u32_b32 %0, -1, 0\n\tv_mbcnt_hi_u32_b32 %0, -1, %0" : "=v"(l)); return (wave_s << 6) | l; }
template <int O> __device__ __forceinline__ float xlane_partner_lt32(float v) { return __int_as_float(__builtin_amdgcn_ds_swizzle(__float_as_int(v), (O << 10) | 0x1f)); }
template <int O> __device__ __forceinline__ float xadd(float v) {
    if constexpr (O == 32) { auto rr = __builtin_amdgcn_permlane32_swap(__float_as_uint(v), __float_as_uint(v), false, false); return __uint_as_float(rr[0]) + __uint_as_float(rr[1]); }
    else return v + xlane_partner_lt32<O>(v); }
template <int O> __device__ __forceinline__ float xmax(float v) {
    if constexpr (O == 32) { auto rr = __builtin_amdgcn_permlane32_swap(__float_as_uint(v), __float_as_uint(v), false, false); return fmaxf(__uint_as_float(rr[0]), __uint_as_float(rr[1])); }
    else return fmaxf(v, xlane_partner_lt32<O>(v)); }
__device__ __forceinline__ float wave_sum64(float v) { v = xadd<1>(v); v = xadd<2>(v); v = xadd<4>(v); v = xadd<8>(v); v = xadd<16>(v); return xadd<32>(v); }
__device__ __forceinline__ float wave_max32(float v) { v = xmax<1>(v); v = xmax<2>(v); v = xmax<4>(v); v = xmax<8>(v); return xmax<16>(v); }
__device__ __forceinline__ float wave_max64(float v) { return xmax<32>(wave_max32(v)); }
namespace pg8 {
#define PG8_LAS __attribute__((address_space(3)))
typedef unsigned short bf16_t;
typedef short bf16x8 __attribute__((ext_vector_type(8)));
typedef float f32x4 __attribute__((ext_vector_type(4)));
typedef unsigned u32x4 __attribute__((ext_vector_type(4)));
constexpr int BM = 256, BK = 64, HALF = 128, HTB = HALF * BK * 2  , STAGE_BYTES = 8 * HTB, NXCD = 8, WGM = 8;

__host__ __device__ __forceinline__ int lds_byte(int r, int c) { const int st = (r >> 4) * 2 + (c >> 5), rr = r & 15, cc = c & 31, ob = rr * 64 + cc * 2; return st * 1024 + (ob ^ (((ob >> 9) & 1) << 5)); }
__host__ __device__ __forceinline__ void stage_rc(int b, int& R, int& C) { const int st = b / 1024, sb = b % 1024, swz = sb ^ (((sb >> 9) & 1) << 5); R = (st >> 1) * 16 + swz / 64; C = (st & 1) * 32 + (swz % 64) / 2; }
__host__ __device__ __forceinline__ int perm32(int rho) { const int n = rho >> 4, i = rho & 15; return 8 * (i >> 2) + 4 * n + (i & 3); }

struct Unit { int pm, pn; };
struct Gemm { const bf16_t* A; const bf16_t* Bt; int M, N, K; };

struct StaticOrder {
    int nM, nN, nwg, G, c;
    __host__ __device__ void init(int M, int N, int G_, int c_) { nM = M / BM; nN = N / BM; nwg = nM * nN; G = G_; c = c_; }
    __host__ __device__ bool next(int i, Unit& u) const {
        const long L = (long)i * G + c; if (L >= nwg) return false;
        int wgid = (int)L; { const int q = nwg / NXCD, r = nwg % NXCD, xcd = wgid % NXCD, off = wgid / NXCD; wgid = (xcd < r ? xcd * (q + 1) : r * (q + 1) + (xcd - r) * q) + off; }
        const int nig = WGM * nN, gid = wgid / nig, fm = gid * WGM, gsz = (nM - fm) < WGM ? (nM - fm) : WGM;
        u.pm = fm + ((wgid % nig) % gsz); u.pn = (wgid % nig) / gsz; return true;
    }
    __device__ __forceinline__ void a_ready(const Unit&) const {}
    __device__ __forceinline__ void done(const Unit&) const {}
};

__device__ __forceinline__ unsigned cvt_pk_bf16(float lo, float hi) { unsigned r; asm volatile("v_cvt_pk_bf16_f32 %0, %1, %2" : "=v"(r) : "v"(lo), "v"(hi)); return r; }
typedef float f32x2 __attribute__((ext_vector_type(2)));
__device__ __forceinline__ f32x2 gelu_pk(f32x2 v) {
    const f32x2 av = __builtin_elementwise_abs(v), d = av * 0.2316418882f + 1.0f;
    f32x2 t; t.x = __builtin_amdgcn_rcpf(d.x); t.y = __builtin_amdgcn_rcpf(d.y);
    f32x2 q = t * 0.5307027145f + (-0.7265760135f); q = q * t + 0.7107068705f; q = q * t + (-0.142248368f); q = q * t + 0.127414796f; q = q * t;
    const f32x2 s = (v * v) * (-0.72134752044f);
    f32x2 e; e.x = __builtin_amdgcn_exp2f(s.x); e.y = __builtin_amdgcn_exp2f(s.y);
    const f32x2 m = v * (q * e), r = v - m;
    f32x2 o; o.x = v.x < 0.f ? m.x : r.x; o.y = v.y < 0.f ? m.y : r.y; return o;
}

template <int ACT  > struct EpiBf16 {
    static constexpr bool PERM = true, AFTER_DRAIN = false; static_assert(ACT == 0 || ACT == 1, "EpiBf16: ACT is 0 (none) or 1 (gelu_pk)");
    bf16_t* O; int ldc; const float* bias; int split_cols; size_t split_stride; float scale0;
    __device__ __forceinline__ void operator()(const f32x4 (&acc)[2][2][4][2], const Unit& u, int wr, int wc, int fr, int fq) const {
        const int row0 = u.pm * BM + wr * 64 + fr; int colt = u.pn * BM; bf16_t* base = O;
        float sc = 1.f; if (split_cols) { const int t = colt / split_cols; base += (size_t)t * split_stride; colt -= t * split_cols; if (t == 0) sc = scale0; }
        const int col0 = colt + wc * 32 + 8 * fq, bcol0 = u.pn * BM + wc * 32 + 8 * fq;
        f32x4 bv[2][2];
#pragma unroll
        for (int bj = 0; bj < 2; ++bj)
#pragma unroll
            for (int n = 0; n < 2; ++n) bv[bj][n] = bias ? *(const f32x4*)(bias + bcol0 + bj * HALF + 4 * n) : (f32x4){0.f, 0.f, 0.f, 0.f};
#pragma unroll
        for (int ai = 0; ai < 2; ++ai)
#pragma unroll
            for (int m = 0; m < 4; ++m) { bf16_t* rowp = base + (size_t)(row0 + ai * HALF + m * 16) * ldc + col0;
#pragma unroll
                for (int bj = 0; bj < 2; ++bj) { f32x4 v0 = acc[ai][bj][m][0] + bv[bj][0], v1 = acc[ai][bj][m][1] + bv[bj][1];
                    if (ACT == 1) { f32x2 a = gelu_pk((f32x2){v0[0], v0[1]}), b = gelu_pk((f32x2){v0[2], v0[3]}), c = gelu_pk((f32x2){v1[0], v1[1]}), d = gelu_pk((f32x2){v1[2], v1[3]});
                        v0 = (f32x4){a.x, a.y, b.x, b.y}; v1 = (f32x4){c.x, c.y, d.x, d.y}; }
                    v0 = v0 * sc; v1 = v1 * sc; u32x4 w; w.x = cvt_pk_bf16(v0[0], v0[1]); w.y = cvt_pk_bf16(v0[2], v0[3]); w.z = cvt_pk_bf16(v1[0], v1[1]); w.w = cvt_pk_bf16(v1[2], v1[3]);
                    *(u32x4*)(rowp + bj * HALF) = w; } }
    }
};

struct EpiSwiglu {
    static constexpr bool PERM = true, AFTER_DRAIN = false;
    bf16_t* H; int ldh;
    __device__ __forceinline__ void operator()(const f32x4 (&acc)[2][2][4][2], const Unit& u, int wr, int wc, int fr, int fq) const {
        const int row0 = u.pm * BM + wr * 64 + fr, col0 = u.pn * HALF + wc * 32 + 8 * fq;
#pragma unroll
        for (int ai = 0; ai < 2; ++ai)
#pragma unroll
            for (int m = 0; m < 4; ++m) { bf16_t* rowp = H + (size_t)(row0 + ai * HALF + m * 16) * ldh + col0;
                float hv[8];
#pragma unroll
                for (int n = 0; n < 2; ++n)
#pragma unroll
                    for (int i = 0; i < 4; ++i) { const float g = acc[ai][0][m][n][i], uu = acc[ai][1][m][n][i];
                        const float sg = g * __builtin_amdgcn_rcpf(1.0f + __builtin_amdgcn_exp2f(-1.4426950408889634f * g)); hv[4 * n + i] = sg * uu; }
                u32x4 w; w.x = cvt_pk_bf16(hv[0], hv[1]); w.y = cvt_pk_bf16(hv[2], hv[3]); w.z = cvt_pk_bf16(hv[4], hv[5]); w.w = cvt_pk_bf16(hv[6], hv[7]);
                *(u32x4*)rowp = w; }
    }
};
typedef _Float16 h16x2_t __attribute__((ext_vector_type(2)));
typedef float f32x2s_t __attribute__((ext_vector_type(2)));
__device__ __forceinline__ unsigned pk_h2(float a, float b) { f32x2s_t v = {__builtin_fminf(__builtin_fmaxf(a, -65504.f), 65504.f), __builtin_fminf(__builtin_fmaxf(b, -65504.f), 65504.f)}; h16x2_t h = __builtin_convertvector(v, h16x2_t); return __builtin_bit_cast(unsigned, h); }
__device__ __forceinline__ f32x2s_t up_h2(unsigned w) { h16x2_t h = __builtin_bit_cast(h16x2_t, w); return __builtin_convertvector(h, f32x2s_t); }
__device__ __forceinline__ f32x4 bfx4_lo(const u32x4& w) { const f32x2s_t a = up_h2(w.x), b = up_h2(w.y); return (f32x4){a.x, a.y, b.x, b.y}; }
__device__ __forceinline__ f32x4 bfx4_hi(const u32x4& w) { const f32x2s_t a = up_h2(w.z), b = up_h2(w.w); return (f32x4){a.x, a.y, b.x, b.y}; }
struct EpiResid {
    static constexpr bool PERM = true, AFTER_DRAIN = false;
    const bf16_t* base; bf16_t* out; const float* gate; int gstride; float coef;
    __device__ __forceinline__ void operator()(const f32x4 (&acc)[2][2][4][2], const Unit& u, int wr, int wc, int fr, int fq) const {
        const int row0 = u.pm * BM + wr * 64 + fr, col0 = u.pn * BM + wc * 32 + 8 * fq;
        const float* gp = gate + (size_t)((u.pm * BM) >> 13) * gstride + col0;
        f32x4 gv[2][2];
#pragma unroll
        for (int bj = 0; bj < 2; ++bj)
#pragma unroll
            for (int n = 0; n < 2; ++n) gv[bj][n] = *(const f32x4*)(gp + bj * HALF + 4 * n) * coef;
        u32x4 bwa[2][4][2];
#pragma unroll
        for (int ai = 0; ai < 2; ++ai)
#pragma unroll
            for (int m = 0; m < 4; ++m)
#pragma unroll
                for (int bj = 0; bj < 2; ++bj) bwa[ai][m][bj] = *(const u32x4*)(base + (size_t)(row0 + ai * HALF + m * 16) * 1024 + col0 + bj * HALF);
#pragma unroll
        for (int ai = 0; ai < 2; ++ai)
#pragma unroll
            for (int m = 0; m < 4; ++m) { const size_t off = (size_t)(row0 + ai * HALF + m * 16) * 1024 + col0;
#pragma unroll
                for (int bj = 0; bj < 2; ++bj) { const u32x4 bw = bwa[ai][m][bj];
                    const f32x4 v0 = bfx4_lo(bw) + gv[bj][0] * acc[ai][bj][m][0], v1 = bfx4_hi(bw) + gv[bj][1] * acc[ai][bj][m][1];
                    u32x4 w; w.x = pk_h2(v0[0], v0[1]); w.y = pk_h2(v0[2], v0[3]); w.z = pk_h2(v1[0], v1[1]); w.w = pk_h2(v1[2], v1[3]);
                    *(u32x4*)(out + off + bj * HALF) = w; } }
    }
};
struct OneUnit { int pm, pn;
    __device__ __forceinline__ bool next(int i, Unit& u) const { if (i) return false; u.pm = pm; u.pn = pn; return true; }
    __device__ __forceinline__ void a_ready(const Unit&) const {}
    __device__ __forceinline__ void done(const Unit&) const {} };
struct RmsStats {
    unsigned* xbuf;
    unsigned* cnt;
    float eps;
    __device__ __forceinline__ void run(const f32x4 (&v)[2][2][4][2], const Unit& u, int wr, int wc, int fr, int fq, PG8_LAS unsigned char* lds, int wid, int lane) const {
        PG8_LAS float* P = (PG8_LAS float*)lds;
        PG8_LAS float* S = (PG8_LAS float*)(lds + 8192);
#pragma unroll
        for (int ai = 0; ai < 2; ++ai)
#pragma unroll
            for (int m = 0; m < 4; ++m) { float q = 0.f;
#pragma unroll
                for (int bj = 0; bj < 2; ++bj)
#pragma unroll
                    for (int n = 0; n < 2; ++n) { const f32x4 x = v[ai][bj][m][n]; q += (x[0] * x[0] + x[1] * x[1]) + (x[2] * x[2] + x[3] * x[3]); }
                q = xadd<16>(q); q = xadd<32>(q);
                if (fq == 0) P[(ai * HALF + wr * 64 + m * 16 + fr) * 4 + wc] = q; }
        asm volatile("s_waitcnt lgkmcnt(0)" ::: "memory"); __builtin_amdgcn_s_barrier(); asm volatile("" ::: "memory");
        const int row = wid * 32 + (lane & 31);
        if (lane < 32) { const float s = (P[row * 4 + 0] + P[row * 4 + 1]) + (P[row * 4 + 2] + P[row * 4 + 3]);
            __hip_atomic_store(xbuf + ((size_t)(u.pm * BM + row) * 4 + u.pn), __float_as_uint(s), __ATOMIC_RELAXED, __HIP_MEMORY_SCOPE_AGENT); }
        asm volatile("s_waitcnt vmcnt(0)" ::: "memory");
        if (lane == 0) __hip_atomic_fetch_add(cnt + 64 * u.pm, 1u, __ATOMIC_RELAXED, __HIP_MEMORY_SCOPE_AGENT);
        if (wid == 0) { unsigned sp = 0;
            while ((unsigned)__builtin_amdgcn_readfirstlane(__hip_atomic_load(cnt + 64 * u.pm, __ATOMIC_RELAXED, __HIP_MEMORY_SCOPE_AGENT)) < 32u) { __builtin_amdgcn_s_sleep(2); if (++sp > (1u << 22)) break; }
            __builtin_amdgcn_fence(__ATOMIC_ACQUIRE, "agent"); }
        asm volatile("s_waitcnt vmcnt(0) lgkmcnt(0)" ::: "memory"); __builtin_amdgcn_s_barrier(); asm volatile("" ::: "memory");
        if (lane < 32) { const unsigned* slot = xbuf + (size_t)(u.pm * BM + row) * 4; float t = 0.f;
#pragma unroll
            for (int k = 0; k < 4; ++k) t += __uint_as_float(__hip_atomic_load(slot + k, __ATOMIC_RELAXED, __HIP_MEMORY_SCOPE_AGENT));
            S[row] = __builtin_amdgcn_rsqf(t * (1.0f / 1024.0f) + eps); }
        asm volatile("s_waitcnt lgkmcnt(0)" ::: "memory"); __builtin_amdgcn_s_barrier(); asm volatile("" ::: "memory");
    }
    __device__ __forceinline__ void publish(const f32x4 (&v)[2][2][4][2], const Unit& u, int wr, int wc, int fr, int fq, PG8_LAS unsigned char* lds, int wid, int lane) const {
        PG8_LAS float* P = (PG8_LAS float*)lds;
#pragma unroll
        for (int ai = 0; ai < 2; ++ai)
#pragma unroll
            for (int m = 0; m < 4; ++m) { float q = 0.f;
#pragma unroll
                for (int bj = 0; bj < 2; ++bj)
#pragma unroll
                    for (int n = 0; n < 2; ++n) { const f32x4 x = v[ai][bj][m][n]; q += (x[0] * x[0] + x[1] * x[1]) + (x[2] * x[2] + x[3] * x[3]); }
                q = xadd<16>(q); q = xadd<32>(q);
                if (fq == 0) P[(ai * HALF + wr * 64 + m * 16 + fr) * 4 + wc] = q; }
        asm volatile("s_waitcnt lgkmcnt(0)" ::: "memory"); __builtin_amdgcn_s_barrier(); asm volatile("" ::: "memory");
        const int row = wid * 32 + (lane & 31);
        if (lane < 32) { const float s = (P[row * 4 + 0] + P[row * 4 + 1]) + (P[row * 4 + 2] + P[row * 4 + 3]);
            __hip_atomic_store(xbuf + ((size_t)(u.pm * BM + row) * 4 + u.pn), __float_as_uint(s), __ATOMIC_RELAXED, __HIP_MEMORY_SCOPE_AGENT); }
        asm volatile("s_waitcnt vmcnt(0)" ::: "memory");
        if (lane == 0) __hip_atomic_fetch_add(cnt + 64 * u.pm, 1u, __ATOMIC_RELAXED, __HIP_MEMORY_SCOPE_AGENT);
    }
    __device__ __forceinline__ void collect(const Unit& u, PG8_LAS unsigned char* lds, int wid, int lane) const {
        PG8_LAS float* S = (PG8_LAS float*)(lds + 8192);
        const int row = wid * 32 + (lane & 31);
        if (wid == 0) { unsigned sp = 0;
            while ((unsigned)__builtin_amdgcn_readfirstlane(__hip_atomic_load(cnt + 64 * u.pm, __ATOMIC_RELAXED, __HIP_MEMORY_SCOPE_AGENT)) < 32u) { __builtin_amdgcn_s_sleep(2); if (++sp > (1u << 22)) break; }
            __builtin_amdgcn_fence(__ATOMIC_ACQUIRE, "agent"); }
        asm volatile("s_waitcnt lgkmcnt(0)" ::: "memory"); __builtin_amdgcn_s_barrier(); asm volatile("" ::: "memory");
        if (lane < 32) { const unsigned* slot = xbuf + (size_t)(u.pm * BM + row) * 4; float t = 0.f;
#pragma unroll
            for (int k = 0; k < 4; ++k) t += __uint_as_float(__hip_atomic_load(slot + k, __ATOMIC_RELAXED, __HIP_MEMORY_SCOPE_AGENT));
            S[row] = __builtin_amdgcn_rsqf(t * (1.0f / 1024.0f) + eps); }
        asm volatile("s_waitcnt lgkmcnt(0)" ::: "memory"); __builtin_amdgcn_s_barrier(); asm volatile("" ::: "memory");
    }
};
template <bool BASE_H, bool FIN> struct EpiResidNorm {
    static constexpr bool PERM = true, AFTER_DRAIN = false;
    const void* base; bf16_t* outb; float* outf; const float* gate; int gstride; float coef;
    const float* ng; const float* shift; const float* scale; int mstride; bf16_t* xn; RmsStats st; PG8_LAS unsigned char* tabs;
    __device__ __forceinline__ void operator()(const f32x4 (&acc_c)[2][2][4][2], const Unit& u, int wr, int wc, int fr, int fq) const {
        f32x4 (&acc)[2][2][4][2] = const_cast<f32x4 (&)[2][2][4][2]>(acc_c);
        asm volatile("" : "+v"(fr), "+v"(fq));
        PG8_LAS unsigned char* lds = tabs; const int wid = wr * 4 + wc, lane = fq * 16 + fr;
        const int row0 = u.pm * BM + wr * 64 + fr, col0 = u.pn * BM + wc * 32 + 8 * fq, b = (u.pm * BM) >> 13;
        {   const float* gp = gate + (size_t)b * gstride + col0;
            f32x4 gv[2][2];
#pragma unroll
            for (int bj = 0; bj < 2; ++bj)
#pragma unroll
                for (int n = 0; n < 2; ++n) gv[bj][n] = *(const f32x4*)(gp + bj * HALF + 4 * n) * coef;
            if constexpr (BASE_H) {
                u32x4 bw[2][4][2];
#pragma unroll
                for (int ai = 0; ai < 2; ++ai)
#pragma unroll
                    for (int m = 0; m < 4; ++m)
#pragma unroll
                        for (int bj = 0; bj < 2; ++bj) bw[ai][m][bj] = *(const u32x4*)((const bf16_t*)base + (size_t)(row0 + ai * HALF + m * 16) * 1024 + col0 + bj * HALF);
#pragma unroll
                for (int ai = 0; ai < 2; ++ai)
#pragma unroll
                    for (int m = 0; m < 4; ++m) { const size_t off = (size_t)(row0 + ai * HALF + m * 16) * 1024 + col0;
#pragma unroll
                        for (int bj = 0; bj < 2; ++bj) {
                            acc[ai][bj][m][0] = bfx4_lo(bw[ai][m][bj]) + gv[bj][0] * acc[ai][bj][m][0]; acc[ai][bj][m][1] = bfx4_hi(bw[ai][m][bj]) + gv[bj][1] * acc[ai][bj][m][1];
                        } }
            } else {
#pragma unroll
                for (int ai = 0; ai < 2; ++ai)
#pragma unroll
                    for (int mp = 0; mp < 2; ++mp) { f32x4 bf[2][2][2];
#pragma unroll
                        for (int mm = 0; mm < 2; ++mm)
#pragma unroll
                            for (int bj = 0; bj < 2; ++bj)
#pragma unroll
                                for (int n = 0; n < 2; ++n) bf[mm][bj][n] = *(const f32x4*)((const float*)base + (size_t)(row0 + ai * HALF + (2 * mp + mm) * 16) * 1024 + col0 + bj * HALF + 4 * n);
#pragma unroll
                        for (int mm = 0; mm < 2; ++mm) { const int m = 2 * mp + mm; const size_t off = (size_t)(row0 + ai * HALF + m * 16) * 1024 + col0;
#pragma unroll
                            for (int bj = 0; bj < 2; ++bj) {
                                acc[ai][bj][m][0] = bf[mm][bj][0] + gv[bj][0] * acc[ai][bj][m][0]; acc[ai][bj][m][1] = bf[mm][bj][1] + gv[bj][1] * acc[ai][bj][m][1];
                                if constexpr (!FIN) { const f32x4 v0 = acc[ai][bj][m][0], v1 = acc[ai][bj][m][1];
                                    u32x4 w; w.x = pk_h2(v0[0], v0[1]); w.y = pk_h2(v0[2], v0[3]); w.z = pk_h2(v1[0], v1[1]); w.w = pk_h2(v1[2], v1[3]);
                                    *(u32x4*)(outb + off + bj * HALF) = w; } } }
                        asm volatile("" ::: "memory"); }
            } }
        if constexpr (BASE_H) {
            st.publish(acc, u, wr, wc, fr, fq, lds, wid, lane);
            if constexpr (!FIN) {
#pragma unroll
                for (int ai = 0; ai < 2; ++ai)
#pragma unroll
                    for (int m = 0; m < 4; ++m) { const size_t off = (size_t)(row0 + ai * HALF + m * 16) * 1024 + col0;
#pragma unroll
                        for (int bj = 0; bj < 2; ++bj) { const f32x4 v0 = acc[ai][bj][m][0], v1 = acc[ai][bj][m][1];
                            u32x4 w; w.x = pk_h2(v0[0], v0[1]); w.y = pk_h2(v0[2], v0[3]); w.z = pk_h2(v1[0], v1[1]); w.w = pk_h2(v1[2], v1[3]);
                            *(u32x4*)(outb + off + bj * HALF) = w; } } }
            st.collect(u, lds, wid, lane);
        } else st.run(acc, u, wr, wc, fr, fq, lds, wid, lane);
        const PG8_LAS float* S = (const PG8_LAS float*)(lds + 8192);
        f32x4 gm[2][2], sh[2][2];
#pragma unroll
        for (int bj = 0; bj < 2; ++bj)
#pragma unroll
            for (int n = 0; n < 2; ++n) { const int c = col0 + bj * HALF + 4 * n; const f32x4 g = *(const f32x4*)(ng + c);
                if constexpr (FIN) { gm[bj][n] = g; sh[bj][n] = (f32x4){0.f, 0.f, 0.f, 0.f}; }
                else { gm[bj][n] = g * (*(const f32x4*)(scale + (size_t)b * mstride + c) + 1.0f); sh[bj][n] = *(const f32x4*)(shift + (size_t)b * mstride + c); } }
#pragma unroll
        for (int ai = 0; ai < 2; ++ai)
#pragma unroll
            for (int m = 0; m < 4; ++m) { const int r = ai * HALF + wr * 64 + m * 16 + fr; const float rs = S[r]; const size_t off = (size_t)(u.pm * BM + r) * 1024 + col0;
                if constexpr (FIN) {
#pragma unroll
                    for (int bj = 0; bj < 2; ++bj)
#pragma unroll
                        for (int n = 0; n < 2; ++n) *(f32x4*)(outf + off + bj * HALF + 4 * n) = acc[ai][bj][m][n] * rs * gm[bj][n];
                } else {
#pragma unroll
                    for (int bj = 0; bj < 2; ++bj) { const f32x4 v0 = acc[ai][bj][m][0] * rs * gm[bj][0] + sh[bj][0], v1 = acc[ai][bj][m][1] * rs * gm[bj][1] + sh[bj][1];
                        u32x4 w; w.x = cvt_pk_bf16(v0[0], v0[1]); w.y = cvt_pk_bf16(v0[2], v0[3]); w.z = cvt_pk_bf16(v1[0], v1[1]); w.w = cvt_pk_bf16(v1[2], v1[3]);
                        *(u32x4*)(xn + off + bj * HALF) = w; } } }
    }
};
template <class Epi, class Sched, bool ALIGN_EPI = false, bool SP2 = false>
__device__ __forceinline__ void gemm_phase(PG8_LAS unsigned char* lds, const Gemm g, const Sched& S, const Epi& E, const int tid_in) {
    int tid = tid_in; asm volatile("" : "+v"(tid));
    const int wid = __builtin_amdgcn_readfirstlane(tid >> 6), lane = tid & 63, wr = wid >> 2, wc = wid & 3, fr = lane & 15, fq = lane >> 4;
    const int K = g.K, nt = K / BK;
    unsigned voffA[2], voffB[2];
#pragma unroll
    for (int i = 0; i < 2; ++i) { int R, C; stage_rc(tid * 16 + i * 8192, R, C); const int Rb = Epi::PERM ? ((R & ~31) + perm32(R & 31)) : R;
        voffA[i] = (unsigned)(R * K + C) * 2u; voffB[i] = (unsigned)(Rb * K + C) * 2u; }
    const size_t kstep = (size_t)(BK * 2);
    const size_t hstep = (size_t)HALF * K * 2;
    const size_t tstep = 2 * hstep;
    const unsigned ldsw = (unsigned)wid * 1024u;
    const int aoff = lds_byte(wr * 64 + fr, fq * 8), boff = lds_byte(wc * 32 + fr, fq * 8);
#define PG8_SA(b, h) (((b) * 2 + (h)) * HTB)
#define PG8_SB(b, h) ((4 + (b) * 2 + (h)) * HTB)
#define PG8_STAGE(bufoff, gbase, voff) do { _Pragma("unroll") for (int _i = 0; _i < 2; ++_i) \
        __builtin_amdgcn_global_load_lds((const unsigned*)((const char*)(gbase) + (voff)[_i]), (PG8_LAS unsigned*)(lds + (bufoff) + ldsw + _i * 8192), 16, 0, 0); } while (0)
#define PG8_LDA(dst, b, h) do { _Pragma("unroll") for (int m = 0; m < 4; ++m) _Pragma("unroll") for (int k = 0; k < 2; ++k) dst[m][k] = *(const PG8_LAS bf16x8*)(lds + PG8_SA(b, h) + aoff + m * 2048 + k * 1024); } while (0)
#define PG8_LDB(dst, b, h) do { _Pragma("unroll") for (int n = 0; n < 2; ++n) _Pragma("unroll") for (int k = 0; k < 2; ++k) dst[n][k] = *(const PG8_LAS bf16x8*)(lds + PG8_SB(b, h) + boff + n * 2048 + k * 1024); } while (0)
#define PG8_MMA(ai, bj, At, Bt) do { __builtin_amdgcn_s_setprio(1); _Pragma("unroll") for (int m = 0; m < 4; ++m) _Pragma("unroll") for (int n = 0; n < 2; ++n) _Pragma("unroll") for (int k = 0; k < 2; ++k) \
        acc[ai][bj][m][n] = __builtin_amdgcn_mfma_f32_16x16x32_bf16(Bt[n][k], At[m][k], acc[ai][bj][m][n], 0, 0, 0); __builtin_amdgcn_s_setprio(0); } while (0)
#define PG8_WAIT_V(n) asm volatile("s_waitcnt vmcnt(" #n ")" ::: "memory")
#define PG8_WAIT_L(n) asm volatile("s_waitcnt lgkmcnt(" #n ")" ::: "memory")
#define PG8_BAR __builtin_amdgcn_s_barrier()
#define PG8_SCHED __builtin_amdgcn_sched_barrier(0)
    Unit cur, nxt; int ui = 0;
    if (!S.next(0, cur)) return;
    f32x4 acc[2][2][4][2];
#pragma unroll
    for (int a = 0; a < 2; ++a)
#pragma unroll
        for (int b = 0; b < 2; ++b)
#pragma unroll
            for (int m = 0; m < 4; ++m)
#pragma unroll
                for (int n = 0; n < 2; ++n) acc[a][b][m][n] = (f32x4){0.f, 0.f, 0.f, 0.f};
    bf16x8 At[4][2], B0[2][2], B1[2][2];
    const char* cA = (const char*)g.A + (size_t)cur.pm * tstep; const char* cB = (const char*)g.Bt + (size_t)cur.pn * tstep;
    S.a_ready(cur);
    if constexpr (SP2) {
        PG8_STAGE(PG8_SB(0, 0), cB, voffB); PG8_STAGE(PG8_SB(0, 1), cB + hstep, voffB); PG8_STAGE(PG8_SA(0, 0), cA, voffA); PG8_STAGE(PG8_SA(0, 1), cA + hstep, voffA);
        if (wr == 1) PG8_BAR;
        PG8_WAIT_V(2); PG8_BAR;
        PG8_STAGE(PG8_SB(1, 0), cB + kstep, voffB); PG8_STAGE(PG8_SA(1, 0), cA + kstep, voffA); PG8_STAGE(PG8_SB(1, 1), cB + hstep + kstep, voffB);
        PG8_WAIT_V(6); PG8_BAR;
    } else {
        PG8_STAGE(PG8_SB(0, 0), cB, voffB); PG8_STAGE(PG8_SA(0, 0), cA, voffA); PG8_STAGE(PG8_SB(0, 1), cB + hstep, voffB); PG8_STAGE(PG8_SA(0, 1), cA + hstep, voffA);
        if (wr == 1) PG8_BAR;
        PG8_WAIT_V(4); PG8_BAR;
        PG8_STAGE(PG8_SB(1, 0), cB + kstep, voffB); PG8_STAGE(PG8_SA(1, 0), cA + kstep, voffA); PG8_STAGE(PG8_SB(1, 1), cB + hstep + kstep, voffB);
        PG8_WAIT_V(6); PG8_BAR;
    }
    for (;;) {
        const bool has_next = S.next(ui + 1, nxt);
        const char* nA = has_next ? (const char*)g.A + (size_t)nxt.pm * tstep : cA; const char* nB = has_next ? (const char*)g.Bt + (size_t)nxt.pn * tstep : cB;
        for (int t = 0; t < nt; t += 2) {
            const bool last = (t == nt - 2);
            const char* a1 = cA + (size_t)(t + 1) * kstep;
            const char* a2 = last ? nA : cA + (size_t)(t + 2) * kstep; const char* b2 = last ? nB : cB + (size_t)(t + 2) * kstep;
            const char* a3 = a2 + kstep; const char* b3 = b2 + kstep;
            if (last && has_next) S.a_ready(nxt);
            if constexpr (SP2) {
            PG8_LDB(B0, 0, 0); PG8_LDB(B1, 0, 1); PG8_SCHED; PG8_LDA(At, 0, 0); PG8_STAGE(PG8_SA(1, 1), a1 + hstep, voffA);
            PG8_WAIT_V(8); PG8_WAIT_L(0); PG8_BAR; PG8_MMA(0, 0, At, B0); PG8_MMA(0, 1, At, B1); PG8_BAR; PG8_SCHED;
            PG8_LDA(At, 0, 1); PG8_STAGE(PG8_SB(0, 0), b2, voffB); PG8_STAGE(PG8_SB(0, 1), b2 + hstep, voffB); PG8_STAGE(PG8_SA(0, 0), a2, voffA);
            PG8_WAIT_V(8); PG8_WAIT_L(0); PG8_BAR; PG8_MMA(1, 0, At, B0); PG8_MMA(1, 1, At, B1); PG8_BAR; PG8_SCHED;
            PG8_LDB(B0, 1, 0); PG8_LDB(B1, 1, 1); PG8_SCHED; PG8_LDA(At, 1, 0); PG8_STAGE(PG8_SA(0, 1), a2 + hstep, voffA);
            PG8_WAIT_V(8); PG8_WAIT_L(0); PG8_BAR; PG8_MMA(0, 0, At, B0); PG8_MMA(0, 1, At, B1); PG8_BAR; PG8_SCHED;
            PG8_LDA(At, 1, 1); PG8_STAGE(PG8_SB(1, 0), b3, voffB); PG8_STAGE(PG8_SB(1, 1), b3 + hstep, voffB); PG8_STAGE(PG8_SA(1, 0), a3, voffA);
            PG8_WAIT_V(8); PG8_WAIT_L(0); PG8_BAR; PG8_MMA(1, 0, At, B0); PG8_MMA(1, 1, At, B1); PG8_BAR; PG8_SCHED;
            } else {
            PG8_LDB(B0, 0, 0); PG8_SCHED; PG8_LDA(At, 0, 0); PG8_STAGE(PG8_SA(1, 1), a1 + hstep, voffA);
            PG8_WAIT_L(8); PG8_BAR; PG8_WAIT_L(0); PG8_MMA(0, 0, At, B0); PG8_BAR; PG8_SCHED;
            PG8_LDB(B1, 0, 1); PG8_STAGE(PG8_SB(0, 0), b2, voffB);
            PG8_BAR; PG8_WAIT_L(0); PG8_MMA(0, 1, At, B1); PG8_BAR;
            PG8_LDA(At, 0, 1); PG8_STAGE(PG8_SA(0, 0), a2, voffA);
            PG8_BAR; PG8_WAIT_L(0); PG8_MMA(1, 0, At, B0); PG8_BAR; PG8_SCHED;
            PG8_STAGE(PG8_SB(0, 1), b2 + hstep, voffB);
            PG8_WAIT_V(6); PG8_BAR; PG8_MMA(1, 1, At, B1); PG8_BAR;
            PG8_LDB(B0, 1, 0); PG8_SCHED; PG8_LDA(At, 1, 0); PG8_STAGE(PG8_SA(0, 1), a2 + hstep, voffA);
            PG8_WAIT_L(8); PG8_BAR; PG8_WAIT_L(0); PG8_MMA(0, 0, At, B0); PG8_BAR; PG8_SCHED;
            PG8_LDB(B1, 1, 1); PG8_STAGE(PG8_SB(1, 0), b3, voffB);
            PG8_BAR; PG8_WAIT_L(0); PG8_MMA(0, 1, At, B1); PG8_BAR;
            PG8_LDA(At, 1, 1); PG8_STAGE(PG8_SA(1, 0), a3, voffA);
            PG8_BAR; PG8_WAIT_L(0); PG8_MMA(1, 0, At, B0); PG8_BAR; PG8_SCHED;
            PG8_STAGE(PG8_SB(1, 1), b3 + hstep, voffB);
            PG8_WAIT_V(6); PG8_BAR; PG8_MMA(1, 1, At, B1); PG8_BAR;
            }
        }
        if constexpr (ALIGN_EPI) { if (wr == 0) PG8_BAR; }
        if constexpr (!Epi::AFTER_DRAIN) { E(acc, cur, wr, wc, fr, fq); S.done(cur); }
        if (!has_next) break;
#pragma unroll
        for (int a = 0; a < 2; ++a)
#pragma unroll
            for (int b = 0; b < 2; ++b)
#pragma unroll
                for (int m = 0; m < 4; ++m)
#pragma unroll
                    for (int n = 0; n < 2; ++n) acc[a][b][m][n] = (f32x4){0.f, 0.f, 0.f, 0.f};
        cur = nxt; cA = nA; cB = nB; ++ui;
        if constexpr (ALIGN_EPI) { if (wr == 1) PG8_BAR; }
    }
    PG8_WAIT_V(0);
    if constexpr (!ALIGN_EPI) { if (wr == 0) PG8_BAR; }
    PG8_BAR;
    if constexpr (Epi::AFTER_DRAIN) { E.fused(acc, cur, wr, wc, fr, fq, lds, wid, lane); S.done(cur); }
#undef PG8_SA
#undef PG8_SB
#undef PG8_STAGE
#undef PG8_LDA
#undef PG8_LDB
#undef PG8_MMA
#undef PG8_WAIT_V
#undef PG8_WAIT_L
#undef PG8_BAR
#undef PG8_SCHED
}
}

#ifndef PG8_SP2
#define PG8_SP2 true
#endif
#ifndef PG8_ALIGN
#define PG8_ALIGN true
#endif
#include <hip/hip_bf16.h>
#include <cmath>
namespace attn_body {
using bf16=__hip_bfloat16;
using bf16x8=__attribute__((ext_vector_type(8)))short;
using s16x4=__attribute__((ext_vector_type(4)))short;
using f32x16=__attribute__((ext_vector_type(16)))float;
using u32x4=__attribute__((ext_vector_type(4)))unsigned;
constexpr int BATCH=4,NHEAD=16,SEQ=8192,D=64,DM=NHEAD*D;
constexpr int NW=8,QBLK=32,QB=QBLK*NW,KVBLK=64,NQB=SEQ/QB;
constexpr int ATTN_PITCH=DM, ATTN_UNIT_ROWS=QB;
__device__ __forceinline__ int crow(int r,int hi){return (r&3)+8*(r>>2)+4*hi;}
#define SBAR() __builtin_amdgcn_sched_barrier(0)
__device__ __forceinline__ void cmask(f32x16&p0,f32x16&p1,int jb,int qrel,int hi){
  const float NEG=-INFINITY; int kb=64*jb+4*hi;
  #pragma unroll
  for(int r=0;r<16;++r){int kv=kb+(r&3)+8*(r>>2); if(kv>qrel)p0[r]=NEG; if(kv+32>qrel)p1[r]=NEG;}
}


typedef float f32x4v __attribute__((ext_vector_type(4)));
#define ALAS __attribute__((address_space(3)))
__device__ __forceinline__ void biasmask(f32x16&p0,f32x16&p1,int jb,int qrel,int hi,const ALAS float*tab){
  const int nb=qrel-64*jb-4*hi;
  #pragma unroll
  for(int r=0;r<16;++r){ const int n0=nb-((r&3)+8*(r>>2)); int i0=n0<-1?-1:n0; i0=(i0>128?128:i0)+1; int i1=n0-32; i1=i1<-1?-1:i1; i1=(i1>128?128:i1)+1; p0[r]+=tab[i0]; p1[r]+=tab[i1]; }
}
constexpr int NSLOT=3, SLOTB=8192;
constexpr int LDS_K=0, LDS_V=NSLOT*SLOTB, LDS_WS=2*NSLOT*SLOTB, LDS_OST=LDS_WS+NW*64*4, LDS_BYTES=LDS_OST+NW*4096;
constexpr float C2=0.125f*1.4426950408889634f;
__device__ __forceinline__ void glds16(const void*gsrc,unsigned lds_dst){unsigned keep;
  asm volatile("s_mov_b32 %0, m0\n\ts_mov_b32 m0, %2\n\ts_nop 0\n\tglobal_load_lds_dwordx4 %1, off\n\ts_mov_b32 m0, %0":"=&s"(keep):"v"(gsrc),"s"(lds_dst):"memory");}
__device__ __forceinline__ float max3f(float a,float b,float c){float r;asm("v_max3_f32 %0, %1, %2, %3":"=v"(r):"v"(a),"v"(b),"v"(c));return r;}
__device__ __forceinline__ float max2f(float a,float b){float r;asm("v_max_f32_e32 %0, %1, %2":"=v"(r):"v"(a),"v"(b));return r;}
__device__ __forceinline__ float fadd_s(float a,float b){float r;asm("v_add_f32_e32 %0, %1, %2":"=v"(r):"v"(a),"v"(b));return r;}
__device__ __forceinline__ float fsub_s(float a,float b){float r;asm("v_sub_f32_e32 %0, %1, %2":"=v"(r):"v"(a),"v"(b));return r;}
typedef float f32x2_t __attribute__((ext_vector_type(2))); typedef __bf16 bf16x2_t __attribute__((ext_vector_type(2)));
__device__ __forceinline__ unsigned cvtpk_s(float lo,float hi){f32x2_t v={lo,hi};bf16x2_t b=__builtin_convertvector(v,bf16x2_t);return __builtin_bit_cast(unsigned,b);}
#define WAIT_BAR(N) asm volatile("s_waitcnt vmcnt(" #N ") lgkmcnt(0)\n\ts_barrier":::"memory")

__device__ __forceinline__ void qkt(f32x16&p0,f32x16&p1,const char*Kslot,const bf16x8*qr,const f32x16&negm,int r32,int hi){
  const char*kb=Kslot+hi*1024+r32*16;
  #pragma unroll
  for(int d0=0;d0<4;++d0){
    const bf16x8 b0=*reinterpret_cast<const bf16x8*>(kb+d0*2048);
    const bf16x8 b1=*reinterpret_cast<const bf16x8*>(kb+d0*2048+512);
    if(d0==0){p0=__builtin_amdgcn_mfma_f32_32x32x16_bf16(b0,qr[0],negm,0,0,0);p1=__builtin_amdgcn_mfma_f32_32x32x16_bf16(b1,qr[0],negm,0,0,0);}
    else{p0=__builtin_amdgcn_mfma_f32_32x32x16_bf16(b0,qr[d0],p0,0,0,0);p1=__builtin_amdgcn_mfma_f32_32x32x16_bf16(b1,qr[d0],p1,0,0,0);}}
}
typedef __attribute__((address_space(3))) const char* lds_cptr;
typedef short v4i16_t __attribute__((ext_vector_type(4)));
__device__ __forceinline__ void kload8(bf16x8*kf,lds_cptr kp){
  kf[0]=*(const __attribute__((address_space(3))) bf16x8*)(kp);      kf[1]=*(const __attribute__((address_space(3))) bf16x8*)(kp+512);
  kf[2]=*(const __attribute__((address_space(3))) bf16x8*)(kp+2048); kf[3]=*(const __attribute__((address_space(3))) bf16x8*)(kp+2560);
  kf[4]=*(const __attribute__((address_space(3))) bf16x8*)(kp+4096); kf[5]=*(const __attribute__((address_space(3))) bf16x8*)(kp+4608);
  kf[6]=*(const __attribute__((address_space(3))) bf16x8*)(kp+6144); kf[7]=*(const __attribute__((address_space(3))) bf16x8*)(kp+6656);
}
__device__ __forceinline__ void kload2(bf16x8*kf,lds_cptr kp,int j){ kf[2*j]=*(const __attribute__((address_space(3))) bf16x8*)(kp+j*2048); kf[2*j+1]=*(const __attribute__((address_space(3))) bf16x8*)(kp+j*2048+512); }
__device__ __forceinline__ s16x4 vtr(lds_cptr p){ return __builtin_bit_cast(s16x4,__builtin_amdgcn_ds_read_tr16_b64_v4i16((__attribute__((address_space(3))) v4i16_t*)p)); }
__device__ __forceinline__ float rowmax(const f32x16&p0,const f32x16&p1){
  float a=max3f(p0[0],p0[1],p1[0]),b=max3f(p0[2],p0[3],p1[1]);a=max3f(a,p1[2],p1[3]);
  #pragma unroll
  for(int r=4;r<16;r+=4){a=max3f(a,p0[r],p0[r+1]);b=max3f(b,p0[r+2],p0[r+3]);a=max3f(a,p1[r],p1[r+1]);b=max3f(b,p1[r+2],p1[r+3]);}
  const float m=max2f(a,b);
  auto rr=__builtin_amdgcn_permlane32_swap(__float_as_uint(m),__float_as_uint(m),false,false);
  return max2f(__uint_as_float(rr[0]),__uint_as_float(rr[1]));
}
__device__ __forceinline__ void pv(f32x16*o,int vb,bf16x8 pa0,bf16x8 pa1,bf16x8 pa2,bf16x8 pa3){
  #pragma unroll
  for(int d0=0;d0<2;++d0){s16x4 lo[4],hi[4];
    #pragma unroll
    for(int ks=0;ks<4;++ks){
      asm volatile("ds_read_b64_tr_b16 %0,%1 offset:%c2":"=&v"(lo[ks]):"v"(vb),"i"(d0*4096+ks*1024):"memory");
      asm volatile("ds_read_b64_tr_b16 %0,%1 offset:%c2":"=&v"(hi[ks]):"v"(vb),"i"(d0*4096+ks*1024+512):"memory");}
    asm volatile("s_waitcnt lgkmcnt(0)":::"memory");SBAR();
    #define PK(k) (bf16x8){lo[k][0],lo[k][1],lo[k][2],lo[k][3],hi[k][0],hi[k][1],hi[k][2],hi[k][3]}
    o[d0]=__builtin_amdgcn_mfma_f32_32x32x16_bf16(pa0,PK(0),o[d0],0,0,0);
    o[d0]=__builtin_amdgcn_mfma_f32_32x32x16_bf16(pa1,PK(1),o[d0],0,0,0);
    o[d0]=__builtin_amdgcn_mfma_f32_32x32x16_bf16(pa2,PK(2),o[d0],0,0,0);
    o[d0]=__builtin_amdgcn_mfma_f32_32x32x16_bf16(pa3,PK(3),o[d0],0,0,0);
    #undef PK
  }
}

#ifndef ATTN_STORE16
#define ATTN_STORE16(p,v) (*(u32x4*)(p)=(v))
#endif
template<int THRL,int MODE> __device__ __forceinline__ void attn_unit(int b,int qc,int kc,int vc,int oc,int qb,const bf16*Q,const bf16*__restrict__ K,const bf16*__restrict__ V,bf16*O,char*shm,const float*aux,int hidx,const float*kpart,int npart,const int tid_in){
  int tid=tid_in; asm volatile("":"+v"(tid));
  const int lane=tid&63,r32=lane&31,hi=lane>>5; const int wid=__builtin_amdgcn_readfirstlane(tid>>6);
  const long rowbase=(long)b*SEQ; const int q0=qb*QB;
  const bf16*Qw=Q+(rowbase+q0+wid*QBLK)*DM+qc;
  const bf16*Kh=K+rowbase*DM+kc; const bf16*Vh=V+rowbase*DM+vc;
  const unsigned lds0=(unsigned)(uintptr_t)shm;
  float*wsf=(float*)(shm+LDS_WS)+wid*64;
  int tskip=0; float mfix=0.f;
  if(MODE==1){
    bf16x8 qv[4];
    #pragma unroll
    for(int d0=0;d0<4;++d0) qv[d0]=*reinterpret_cast<const bf16x8*>(&Qw[(long)r32*DM+d0*16+hi*8]);
    bf16x8 kvd[4];
    #pragma unroll
    for(int d0=0;d0<4;++d0) kvd[d0]=*reinterpret_cast<const bf16x8*>(&Kh[(long)(q0+wid*QBLK+r32)*DM+d0*16+hi*8]);
    float kmv[4];
    #pragma unroll
    for(int j=0;j<4;++j){ const int i=lane+64*j; kmv[j]=(i<npart)?kpart[(long)i*64]:0.f; }
    const int NT0=(q0+QB)/KVBLK;
    const float a_row=aux[q0+wid*QBLK+r32], a_t0=aux[64*lane+63], a_t1=aux[64*(lane+64)+63];
    const int n4=(q0+QB)>>2; f32x4v tv[4];
    #pragma unroll
    for(int j=0;j<4;++j){ const int i=tid+512*j; if(i<n4) tv[j]=((const f32x4v*)aux)[i]; }
    float km=fmaxf(fmaxf(kmv[0],kmv[1]),fmaxf(kmv[2],kmv[3]));
    for(int i=lane+256;i<npart;i+=64) km=fmaxf(km,kpart[(long)i*64]);
    float ss=0.f,sd=0.f;
    #pragma unroll
    for(int d0=0;d0<4;++d0){
      #pragma unroll
      for(int e=0;e<8;++e){ const float f=__uint_as_float(((unsigned)(unsigned short)qv[d0][e])<<16), g=__uint_as_float(((unsigned)(unsigned short)kvd[d0][e])<<16); ss+=f*f; sd+=f*g; } }
    { auto rr=__builtin_amdgcn_permlane32_swap(__float_as_uint(ss),__float_as_uint(ss),false,false); ss=__uint_as_float(rr[0])+__uint_as_float(rr[1]); }
    { auto rr=__builtin_amdgcn_permlane32_swap(__float_as_uint(sd),__float_as_uint(sd),false,false); sd=__uint_as_float(rr[0])+__uint_as_float(rr[1]); }
    const float dneg=wave_max32(-(sd+a_row));
    const float ssrow=ss;
    ss=wave_max32(ss);
    km=wave_max64(km);
    ALAS float*wsl=(ALAS float*)((__attribute__((address_space(3))) char*)shm+LDS_WS);
    if(lane==0){wsl[wid*64]=ss; wsl[wid*64+1]=dneg;}
    { ALAS f32x4v*tabw=(ALAS f32x4v*)((__attribute__((address_space(3))) char*)shm+LDS_BYTES);
      #pragma unroll
      for(int j=0;j<4;++j){ const int i=tid+512*j; if(i<n4) tabw[i]=tv[j]; } }
    asm volatile("s_waitcnt lgkmcnt(0)\n\ts_barrier":::"memory");
    float qm=wsl[0],dn=wsl[1];
    #pragma unroll
    for(int w=1;w<NW;++w){qm=fmaxf(qm,wsl[w*64]);dn=fmaxf(dn,wsl[w*64+1]);}
    const float smax1=__builtin_amdgcn_sqrtf(qm*km)*1.01f+1.f;
    constexpr float SKIP_T=64.f;
    const float thr=-dn-SKIP_T-smax1;
    mfix=a_row+(__builtin_amdgcn_sqrtf(ssrow*km)*1.01f+1.f);
    const bool sk0=(lane<NT0-6)&&(a_t0<thr);
    const bool sk1=(lane+64<NT0-6)&&(a_t1<thr);
    const unsigned long long m0=~__ballot(sk0), m1=~__ballot(sk1);
    const int nlead=m0?__builtin_ctzll(m0):64+(m1?__builtin_ctzll(m1):64);
    tskip=__builtin_amdgcn_readfirstlane(nlead&~1);
    Kh+=(long)tskip*KVBLK*DM; Vh+=(long)tskip*KVBLK*DM;
  }
  const bf16*ksrc=Kh+(long)lane*DM+wid*8;
  const bf16*vsrc=Vh+(long)(16*(wid&3)+(lane>>2))*DM+(wid>>2)*32+(lane&3)*8;
  const unsigned kdst=lds0+LDS_K+wid*1024, vdst=lds0+LDS_V+wid*1024;
  #define DMA_K(t,slot) glds16(ksrc+(long)(t)*KVBLK*DM,(unsigned)__builtin_amdgcn_readfirstlane(kdst+(slot)))
  #define DMA_V(t,slot) glds16(vsrc+(long)(t)*KVBLK*DM,(unsigned)__builtin_amdgcn_readfirstlane(vdst+(slot)))
  const int vb0=(int)(lds0+LDS_V)+((lane>>4)&1)*32+(lane&3)*8+(4*hi+((lane&15)>>2))*64;
  const char*Kbase=shm+LDS_K; bf16x8 kf[8];
  const lds_cptr shm3=(lds_cptr)shm; const lds_cptr kp0=shm3+LDS_K+hi*1024+r32*16; const lds_cptr vp0=shm3+LDS_V+((lane>>4)&1)*32+(lane&3)*8+(4*hi+((lane&15)>>2))*64;
  const int NT=(q0+QB)/KVBLK-tskip;
  const ALAS float*tab3=(const ALAS float*)(shm3+LDS_BYTES);
  { ALAS float*tabf=(ALAS float*)(shm3+LDS_BYTES);
    if(MODE==0){ if(tid<130){ float v; if(tid==0)v=-INFINITY; else if(tid==129)v=0.f; else{ const int n=tid-1; int bk; if(n<16)bk=n; else{ const int lg=16+(int)(__builtin_amdgcn_logf((float)n*0.0625f)*(16.0f/3.0f));     bk=lg<31?lg:31; } v=(aux[bk*8+hidx]-aux[31*8+hidx])*1.4426950408889634f; } tabf[tid]=v; } }
    asm volatile("s_waitcnt vmcnt(0) lgkmcnt(0)":::"memory"); }
  DMA_K(0,0);DMA_V(0,0);DMA_K(1,SLOTB);
  bf16x8 qr[4];
  #pragma unroll
  for(int d0=0;d0<4;++d0)qr[d0]=*reinterpret_cast<const bf16x8*>(&Qw[(long)r32*DM+d0*16+hi*8]);
  float mhat=(MODE==1)?mfix:0.f,l_reg=0.f;f32x16 o[2];o[0]=f32x16{};o[1]=f32x16{};f32x16 negm=f32x16{};asm volatile("":"+v"(negm));
  const f32x16 zero16=f32x16{};
  #define CIN ((MODE==1)?zero16:negm)
  const int qrel=wid*QBLK+r32;
  #define CMASK(P0,P1,t) do{int jb_=(t)-(NT-4); if(MODE==1){ if(jb_>=0)cmask(P0,P1,jb_,qrel,hi); } else { if(jb_>=-2)biasmask(P0,P1,jb_,qrel,hi,tab3); } }while(0)
  #define FADD(P0,P1,t) do{ if(MODE==1){ const ALAS f32x4v*fp_=(const ALAS f32x4v*)(shm3+LDS_BYTES)+(16*((t)+tskip)+hi); \
    _Pragma("unroll") for(int g_=0;g_<4;++g_){ const f32x4v a_=fp_[2*g_]-mhat, b_=fp_[8+2*g_]-mhat; \
      P0[4*g_]+=a_[0];P0[4*g_+1]+=a_[1];P0[4*g_+2]+=a_[2];P0[4*g_+3]+=a_[3]; P1[4*g_]+=b_[0];P1[4*g_+1]+=b_[1];P1[4*g_+2]+=b_[2];P1[4*g_+3]+=b_[3]; } } }while(0)
  bool resc=false;
  #define START(P0,P1) do{ resc=false; if(MODE==1){ \
      _Pragma("unroll") for(int r=0;r<16;++r)P0[r]=__builtin_amdgcn_exp2f(P0[r]); } else { const float rm=rowmax(P0,P1); \
    { const float dl=rm; mhat=fadd_s(mhat,dl); \
      _Pragma("unroll") for(int r=0;r<16;++r){P0[r]=fsub_s(P0[r],dl);P1[r]=fsub_s(P1[r],dl);} \
      _Pragma("unroll") for(int r=0;r<16;++r)negm[r]=-mhat; asm volatile("":"+v"(negm)); } \
    _Pragma("unroll") for(int r=0;r<16;++r)P0[r]=__builtin_amdgcn_exp2f(P0[r]); } }while(0)
  #define RESC() do{ if(resc){ asm volatile("s_waitcnt lgkmcnt(0)":::"memory"); \
      _Pragma("unroll") for(int d_=0;d_<2;++d_) _Pragma("unroll") for(int r=0;r<16;++r)o[d_][r]*=wsf[crow(r,hi)]; } }while(0)
  f32x16 pA0,pA1,pB0,pB1;
  int sl_prev=0,sl_cur=0,sl_next=SLOTB;
  #define ROT() do{sl_prev=sl_cur;sl_cur=sl_next;sl_next=(sl_next==(NSLOT-1)*SLOTB)?0:sl_next+SLOTB;}while(0)
  DMA_K(2,2*SLOTB);
  WAIT_BAR(3);
  qkt(pA0,pA1,Kbase,qr,CIN,r32,hi);asm volatile("s_nop 15\n\ts_nop 7":"+v"(pA0),"+v"(pA1));FADD(pA0,pA1,0);CMASK(pA0,pA1,0);
  START(pA0,pA1);
  _Pragma("unroll") for(int r=0;r<16;++r)pA1[r]=__builtin_amdgcn_exp2f(pA1[r]);
  WAIT_BAR(0);
  DMA_K(3,0);DMA_V(1,SLOTB);
  ROT();
  kload8(kf,kp0+sl_cur);
  WAIT_BAR(2);
  s16x4 vlo[8],vhi[8]; u32x4 pw0,pw1,pw2,pw3;
  #define PKW(P,B) cvtpk_s(P[B],P[B+1])
  #define PAF(k) __builtin_bit_cast(bf16x8,pw##k)
  #define VFR(i) (bf16x8){vlo[i][0],vlo[i][1],vlo[i][2],vlo[i][3],vhi[i][0],vhi[i][1],vhi[i][2],vhi[i][3]}
  #define PIN(x) asm volatile("":"+v"(x))
  #define MX3(a,b,c) __builtin_fmaxf(__builtin_fmaxf((a),(b)),(c))
  #define GAPA(MF,A0,A1,A2,A3,W0,W1,PW) do{ MF; sacc+=A0; sacc+=A1; sacc+=A2; sacc+=A3; PIN(sacc); W0; W1; PIN(PW); SBAR(); }while(0)
  #define EX(v) __builtin_amdgcn_exp2f(v)
  #define GAPB(MF,X,B) do{ MF; X[B]=EX(X[B]); X[B+1]=EX(X[B+1]); X[B+2]=EX(X[B+2]); X[B+3]=EX(X[B+3]); PIN(X); SBAR(); }while(0)
  #define VRD(i) do{ vlo[i]=vtr(vp_+(((i)>>2)*4096+((i)&3)*1024)); vhi[i]=vtr(vp_+(((i)>>2)*4096+((i)&3)*1024+512)); }while(0)
  #define KRD(G,j) do{ if(G){ kload2(kf,kp0+sl_next,j); SBAR(); } }while(0)
  #define STEP(C0,C1,P0,P1,t,GK,GV,GL) do{ SBAR(); \
    const lds_cptr vp_=vp0+sl_prev; \
    VRD(0); SBAR(); float sacc=(P0[0]+P0[1]); \
    GAPA(C0=__builtin_amdgcn_mfma_f32_32x32x16_bf16(kf[0],qr[0],CIN,0,0,0), P0[2],P0[3],P0[4],P0[5],     pw0[0]=PKW(P0,0), pw0[1]=PKW(P0,2), pw0); \
    VRD(4); SBAR(); GAPA(C1=__builtin_amdgcn_mfma_f32_32x32x16_bf16(kf[1],qr[0],CIN,0,0,0), P0[6],P0[7],P0[8],P0[9],     pw0[2]=PKW(P0,4), pw0[3]=PKW(P0,6), pw0); \
    VRD(1); SBAR(); GAPA(C0=__builtin_amdgcn_mfma_f32_32x32x16_bf16(kf[2],qr[1],C0,0,0,0),   P0[10],P0[11],P0[12],P0[13], pw1[0]=PKW(P0,8), pw1[1]=PKW(P0,10), pw1); \
    VRD(5); SBAR(); GAPA(C1=__builtin_amdgcn_mfma_f32_32x32x16_bf16(kf[3],qr[1],C1,0,0,0),   P0[14],P0[15],P1[0],P1[1],   pw1[2]=PKW(P0,12),pw1[3]=PKW(P0,14), pw1); \
    VRD(2); SBAR(); GAPA(C0=__builtin_amdgcn_mfma_f32_32x32x16_bf16(kf[4],qr[2],C0,0,0,0),   P1[2],P1[3],P1[4],P1[5],     pw2[0]=PKW(P1,0), pw2[1]=PKW(P1,2), pw2); \
    VRD(6); SBAR(); GAPA(C1=__builtin_amdgcn_mfma_f32_32x32x16_bf16(kf[5],qr[2],C1,0,0,0),   P1[6],P1[7],P1[8],P1[9],     pw2[2]=PKW(P1,4), pw2[3]=PKW(P1,6), pw2); \
    VRD(3); SBAR(); GAPA(C0=__builtin_amdgcn_mfma_f32_32x32x16_bf16(kf[6],qr[3],C0,0,0,0),   P1[10],P1[11],P1[12],P1[13], pw3[0]=PKW(P1,8), pw3[1]=PKW(P1,10), pw3); \
    VRD(7); SBAR(); GAPA(C1=__builtin_amdgcn_mfma_f32_32x32x16_bf16(kf[7],qr[3],C1,0,0,0),   P1[14],P1[15],0.f,0.f,       pw3[2]=PKW(P1,12),pw3[3]=PKW(P1,14), pw3); \
    l_reg+=sacc; \
    if(GK){DMA_K((t)+3,sl_cur);} if(GV){DMA_V((t)+1,sl_next);} \
    FADD(C0,C1,t); CMASK(C0,C1,t); \
    resc=false; if(MODE!=1) { float a=MX3(C0[0],C0[1],C1[0]),b=MX3(C0[2],C0[3],C1[1]); a=MX3(a,C1[2],C1[3]); \
      _Pragma("unroll") for(int r=4;r<16;r+=4){a=MX3(a,C0[r],C0[r+1]);b=MX3(b,C0[r+2],C0[r+3]);a=MX3(a,C1[r],C1[r+1]);b=MX3(b,C1[r+2],C1[r+3]);} \
      float rm=__builtin_fmaxf(a,b); { auto rr=__builtin_amdgcn_permlane32_swap(__float_as_uint(rm),__float_as_uint(rm),false,false); rm=__builtin_fmaxf(__uint_as_float(rr[0]),__uint_as_float(rr[1])); } \
      resc=false; \
      if(__builtin_expect(__any(rm>(float)THRL),0)){ const float dl=__builtin_fmaxf(rm,0.f); mhat+=dl; \
        _Pragma("unroll") for(int r=0;r<16;++r){C0[r]-=dl;C1[r]-=dl;} \
        if(MODE==0){ _Pragma("unroll") for(int r=0;r<16;++r)negm[r]=-mhat; asm volatile("":"+v"(negm)); } \
        const float f=__builtin_amdgcn_exp2f(-dl); l_reg*=f; if(hi==0)wsf[r32]=f; resc=true; } } \
    SBAR(); \
    GAPB(o[0]=__builtin_amdgcn_mfma_f32_32x32x16_bf16(PAF(0),VFR(0),o[0],0,0,0), C0,0); \
    GAPB(o[1]=__builtin_amdgcn_mfma_f32_32x32x16_bf16(PAF(0),VFR(4),o[1],0,0,0), C0,4); \
    KRD(GL,0); GAPB(o[0]=__builtin_amdgcn_mfma_f32_32x32x16_bf16(PAF(1),VFR(1),o[0],0,0,0), C0,8); \
    KRD(GL,1); GAPB(o[1]=__builtin_amdgcn_mfma_f32_32x32x16_bf16(PAF(1),VFR(5),o[1],0,0,0), C0,12); \
    KRD(GL,2); GAPB(o[0]=__builtin_amdgcn_mfma_f32_32x32x16_bf16(PAF(2),VFR(2),o[0],0,0,0), C1,0); \
    KRD(GL,3); GAPB(o[1]=__builtin_amdgcn_mfma_f32_32x32x16_bf16(PAF(2),VFR(6),o[1],0,0,0), C1,4); \
    GAPB(o[0]=__builtin_amdgcn_mfma_f32_32x32x16_bf16(PAF(3),VFR(3),o[0],0,0,0), C1,8); \
    GAPB(o[1]=__builtin_amdgcn_mfma_f32_32x32x16_bf16(PAF(3),VFR(7),o[1],0,0,0), C1,12); \
    }while(0)
  int t=1;
  #undef CMASK
  #define CMASK(P0,P1,t) do{}while(0)
  for(;t+(MODE==0?7:5)<NT;t+=2){
    STEP(pB0,pB1,pA0,pA1,t,true,true,true);     WAIT_BAR(2); RESC(); ROT();
    STEP(pA0,pA1,pB0,pB1,t+1,true,true,true);   WAIT_BAR(2); RESC(); ROT();
  }
  #undef CMASK
  #define CMASK(P0,P1,t) do{int jb_=(t)-(NT-4); if(MODE==1){ if(jb_>=0)cmask(P0,P1,jb_,qrel,hi); } else { if(jb_>=-2)biasmask(P0,P1,jb_,qrel,hi,tab3); } }while(0)
  #define ENDW(tt) do{ if((tt)+3<NT){WAIT_BAR(2);} else if((tt)+2<NT){WAIT_BAR(1);} else {WAIT_BAR(0);} }while(0)
  for(;t+1<NT;t+=2){
    STEP(pB0,pB1,pA0,pA1,t,(t+3<NT),(t+1<NT),(t+1<NT));       ENDW(t);   RESC(); ROT();
    STEP(pA0,pA1,pB0,pB1,t+1,(t+4<NT),(t+2<NT),(t+2<NT));     ENDW(t+1); RESC(); ROT();
  }
  STEP(pB0,pB1,pA0,pA1,NT-1,false,false,false); RESC();
  { float sacc=pB0[0]+pB0[1]; _Pragma("unroll") for(int r=2;r<16;++r)sacc+=pB0[r]; _Pragma("unroll") for(int r=0;r<16;++r)sacc+=pB1[r]; l_reg+=sacc;
    pw0=(u32x4){PKW(pB0,0),PKW(pB0,2),PKW(pB0,4),PKW(pB0,6)};pw1=(u32x4){PKW(pB0,8),PKW(pB0,10),PKW(pB0,12),PKW(pB0,14)};pw2=(u32x4){PKW(pB1,0),PKW(pB1,2),PKW(pB1,4),PKW(pB1,6)};pw3=(u32x4){PKW(pB1,8),PKW(pB1,10),PKW(pB1,12),PKW(pB1,14)};
    SBAR(); pv(o,vb0+sl_cur,PAF(0),PAF(1),PAF(2),PAF(3)); }
  #undef PKW
  #undef PAF
  #undef VFR
  #undef PIN
  #undef MX3
  #undef GAPA
  #undef GAPB
  #undef EX
  #undef VRD
  #undef KRD
  #undef STEP
  #undef ENDW
  {auto rr=__builtin_amdgcn_permlane32_swap(__float_as_uint(l_reg),__float_as_uint(l_reg),false,false);l_reg=__uint_as_float(rr[0])+__uint_as_float(rr[1]);}
  if(hi==0)wsf[32+r32]=l_reg;asm volatile("s_waitcnt lgkmcnt(0)":::"memory");
  float rli[16];
  #pragma unroll
  for(int r=0;r<16;++r)rli[r]=__builtin_amdgcn_rcpf(wsf[32+crow(r,hi)]);
  bf16*Ow=O+(rowbase+q0+wid*QBLK)*DM+oc;
  { bf16*stg=(bf16*)(shm+LDS_OST)+wid*2048;
    #pragma unroll
    for(int r=0;r<16;++r){const int orow=crow(r,hi);
      #pragma unroll
      for(int d0=0;d0<2;++d0)stg[orow*64+d0*32+r32]=__float2bfloat16(o[d0][r]*rli[r]);}
    asm volatile("s_waitcnt lgkmcnt(0)":::"memory");
    #pragma unroll
    for(int i=0;i<4;++i){const int row=i*8+(lane>>3),ch=lane&7; const u32x4 v=*(const u32x4*)(stg+row*64+ch*8); ATTN_STORE16(Ow+(long)row*DM+ch*8,v);} }
  asm volatile("s_waitcnt lgkmcnt(0)\n\ts_barrier":::"memory");
  #undef FADD
  #undef CIN
  #undef DMA_K
  #undef DMA_V
  #undef CMASK
  #undef START
  #undef RESC
  #undef ROT
}
constexpr int WLDS_V=NSLOT*SLOTB, WLDS_WS=WLDS_V+NSLOT*2*SLOTB, WLDS_OST=WLDS_WS+NW*64*4, WLDS_BYTES=WLDS_OST+NW*4096;
__device__ __forceinline__ void pv_w(f32x16*o,int vb,bf16x8 pa0,bf16x8 pa1,bf16x8 pa2,bf16x8 pa3){
  #pragma unroll
  for(int d0=0;d0<4;++d0){s16x4 lo[4],hi[4];
    #pragma unroll
    for(int ks=0;ks<4;++ks){
      asm volatile("ds_read_b64_tr_b16 %0,%1 offset:%c2":"=&v"(lo[ks]):"v"(vb),"i"(d0*4096+ks*1024):"memory");
      asm volatile("ds_read_b64_tr_b16 %0,%1 offset:%c2":"=&v"(hi[ks]):"v"(vb),"i"(d0*4096+ks*1024+512):"memory");}
    asm volatile("s_waitcnt lgkmcnt(0)":::"memory");SBAR();
    #define PK(k) (bf16x8){lo[k][0],lo[k][1],lo[k][2],lo[k][3],hi[k][0],hi[k][1],hi[k][2],hi[k][3]}
    o[d0]=__builtin_amdgcn_mfma_f32_32x32x16_bf16(pa0,PK(0),o[d0],0,0,0);
    o[d0]=__builtin_amdgcn_mfma_f32_32x32x16_bf16(pa1,PK(1),o[d0],0,0,0);
    o[d0]=__builtin_amdgcn_mfma_f32_32x32x16_bf16(pa2,PK(2),o[d0],0,0,0);
    o[d0]=__builtin_amdgcn_mfma_f32_32x32x16_bf16(pa3,PK(3),o[d0],0,0,0);
    #undef PK
  }
}
template<int THRL> __device__ __forceinline__ void attn_unit_w(int b,int qc,int kc,int vc,int oc,int qb,const bf16*Q,const bf16*__restrict__ K,const bf16*__restrict__ V,bf16*O,char*shm,const float*aux,int hidx,const float*kpart,int npart,const int tid_in){
  int tid=tid_in; asm volatile("":"+v"(tid));
  constexpr int MODE=0;
  const int lane=tid&63,r32=lane&31,hi=lane>>5; const int wid=__builtin_amdgcn_readfirstlane(tid>>6);
  const long rowbase=(long)b*SEQ; const int q0=qb*QB;
  const bf16*Qw=Q+(rowbase+q0+wid*QBLK)*DM+qc;
  const bf16*Kh=K+rowbase*DM+kc; const bf16*Vh=V+rowbase*DM+vc;
  const unsigned lds0=(unsigned)(uintptr_t)shm;
  float*wsf=(float*)(shm+WLDS_WS)+wid*64;
  int tskip=0;
  if(MODE==1){
    float ss=0.f;
    #pragma unroll
    for(int d0=0;d0<4;++d0){ const bf16x8 qv=*reinterpret_cast<const bf16x8*>(&Qw[(long)r32*DM+d0*16+hi*8]);
      #pragma unroll
      for(int e=0;e<8;++e){ const float f=__uint_as_float(((unsigned)(unsigned short)qv[e])<<16); ss+=f*f; } }
    { auto rr=__builtin_amdgcn_permlane32_swap(__float_as_uint(ss),__float_as_uint(ss),false,false); ss=__uint_as_float(rr[0])+__uint_as_float(rr[1]); }
    ss=wave_max32(ss);
    float km=0.f; for(int i=lane;i<npart;i+=64) km=fmaxf(km,kpart[(long)i*64]);
    km=wave_max64(km);
    ALAS float*wsl=(ALAS float*)((__attribute__((address_space(3))) char*)shm+WLDS_WS);
    if(lane==0)wsl[wid*64]=ss;
    asm volatile("s_waitcnt lgkmcnt(0)\n\ts_barrier":::"memory");
    float qm=wsl[0];
    #pragma unroll
    for(int w=1;w<NW;++w)qm=fmaxf(qm,wsl[w*64]);
    const float smax2=2.f*(__builtin_amdgcn_sqrtf(qm*km)*1.01f+1.f);
    const int NT0=(q0+QB)/KVBLK;
    const float thr=aux[q0]-160.f-smax2;
    const bool sk0=(lane<NT0-6)&&(aux[64*lane+63]<thr);
    const bool sk1=(lane+64<NT0-6)&&(aux[64*(lane+64)+63]<thr);
    const unsigned long long m0=~__ballot(sk0), m1=~__ballot(sk1);
    const int nlead=m0?__builtin_ctzll(m0):64+(m1?__builtin_ctzll(m1):64);
    tskip=__builtin_amdgcn_readfirstlane(nlead&~1);
    Kh+=(long)tskip*KVBLK*DM; Vh+=(long)tskip*KVBLK*DM; aux+=64*tskip;
  }
  const bf16*ksrc=Kh+(long)lane*DM+wid*8;
  const bf16*vsrc=Vh+(long)(16*(wid&3)+(lane>>2))*DM+(wid>>2)*32+(lane&3)*8;
  const unsigned kdst=lds0+LDS_K+wid*1024, vdst=lds0+WLDS_V+wid*1024;
  #define DMA_K(t,slot) glds16(ksrc+(long)(t)*KVBLK*DM,(unsigned)__builtin_amdgcn_readfirstlane(kdst+(slot)))
  #define DMA_V(t,slot) do{ glds16(vsrc+(long)(t)*KVBLK*DM,(unsigned)__builtin_amdgcn_readfirstlane(vdst+2*(slot))); glds16(vsrc+64+(long)(t)*KVBLK*DM,(unsigned)__builtin_amdgcn_readfirstlane(vdst+2*(slot)+8192)); }while(0)
  const int vb0=(int)(lds0+WLDS_V)+((lane>>4)&1)*32+(lane&3)*8+(4*hi+((lane&15)>>2))*64;
  const char*Kbase=shm+LDS_K; bf16x8 kf[8];
  const lds_cptr shm3=(lds_cptr)shm; const lds_cptr kp0=shm3+LDS_K+hi*1024+r32*16; const lds_cptr vp0=shm3+WLDS_V+((lane>>4)&1)*32+(lane&3)*8+(4*hi+((lane&15)>>2))*64;
  const int NT=(q0+QB)/KVBLK-tskip;
  const ALAS float*tab3=(const ALAS float*)(shm3+WLDS_BYTES);
  { ALAS float*tabf=(ALAS float*)(shm3+WLDS_BYTES);
    if(MODE==0){ if(tid<130){ float v; if(tid==0)v=-INFINITY; else if(tid==129)v=0.f; else{ const int n=tid-1; int bk; if(n<16)bk=n; else{ const int lg=16+(int)(__builtin_amdgcn_logf((float)n*0.0625f)*(16.0f/3.0f));     bk=lg<31?lg:31; } v=(aux[bk*8+hidx]-aux[31*8+hidx])*1.4426950408889634f; } tabf[tid]=v; } }
    else{ const int n4=(q0+QB-64*tskip)>>2; for(int i=tid;i<n4;i+=512) ((ALAS f32x4v*)tabf)[i]=((const f32x4v*)aux)[i]; }
    asm volatile("s_waitcnt vmcnt(0) lgkmcnt(0)":::"memory"); }
  DMA_K(0,0);DMA_V(0,0);DMA_K(1,SLOTB);
  bf16x8 qr[4];
  #pragma unroll
  for(int d0=0;d0<4;++d0)qr[d0]=*reinterpret_cast<const bf16x8*>(&Qw[(long)r32*DM+d0*16+hi*8]);
  float mhat=0.f,l_reg=0.f;f32x16 o[4];o[0]=f32x16{};o[1]=f32x16{};o[2]=f32x16{};o[3]=f32x16{};
  const f32x16 zero16=f32x16{};
  #define CIN zero16
  const int qrel=wid*QBLK+r32;
  #define CMASK(P0,P1,t) do{int jb_=(t)-(NT-4); if(MODE==1){ if(jb_>=0)cmask(P0,P1,jb_,qrel,hi); } else { if(jb_>=-2)biasmask(P0,P1,jb_,qrel,hi,tab3); } }while(0)
  #define FADD(P0,P1,t) do{ if(MODE==1){ const ALAS f32x4v*fp_=(const ALAS f32x4v*)(shm3+WLDS_BYTES)+(16*(t)+hi); \
    _Pragma("unroll") for(int g_=0;g_<4;++g_){ const f32x4v a_=fp_[2*g_]-mhat, b_=fp_[8+2*g_]-mhat; \
      P0[4*g_]+=a_[0];P0[4*g_+1]+=a_[1];P0[4*g_+2]+=a_[2];P0[4*g_+3]+=a_[3]; P1[4*g_]+=b_[0];P1[4*g_+1]+=b_[1];P1[4*g_+2]+=b_[2];P1[4*g_+3]+=b_[3]; } } }while(0)
  bool resc=false;
  #define START(P0,P1) do{ const float rm=rowmax(P0,P1); resc=false; mhat=rm; \
    _Pragma("unroll") for(int r=0;r<16;++r)P0[r]=__builtin_amdgcn_exp2f(fsub_s(P0[r],mhat)); }while(0)
  #define RESC() do{ if(resc){ asm volatile("s_waitcnt lgkmcnt(0)":::"memory"); \
      _Pragma("unroll") for(int d_=0;d_<4;++d_) _Pragma("unroll") for(int r=0;r<16;++r)o[d_][r]*=wsf[crow(r,hi)]; } }while(0)
  f32x16 pA0,pA1,pB0,pB1;
  int sl_prev=0,sl_cur=0,sl_next=SLOTB;
  #define ROT() do{sl_prev=sl_cur;sl_cur=sl_next;sl_next=(sl_next==(NSLOT-1)*SLOTB)?0:sl_next+SLOTB;}while(0)
  DMA_K(2,2*SLOTB);
  WAIT_BAR(4);
  qkt(pA0,pA1,Kbase,qr,CIN,r32,hi);asm volatile("s_nop 15\n\ts_nop 7":"+v"(pA0),"+v"(pA1));FADD(pA0,pA1,0);CMASK(pA0,pA1,0);
  START(pA0,pA1);
  _Pragma("unroll") for(int r=0;r<16;++r)pA1[r]=__builtin_amdgcn_exp2f(pA1[r]-mhat);
  WAIT_BAR(0);
  DMA_K(3,0);DMA_V(1,SLOTB);
  ROT();
  kload8(kf,kp0+sl_cur);
  WAIT_BAR(3);
  s16x4 vlo[8],vhi[8]; u32x4 pw0,pw1,pw2,pw3;
  #define PKW(P,B) cvtpk_s(P[B],P[B+1])
  #define PAF(k) __builtin_bit_cast(bf16x8,pw##k)
  #define VFR(i) (bf16x8){vlo[i][0],vlo[i][1],vlo[i][2],vlo[i][3],vhi[i][0],vhi[i][1],vhi[i][2],vhi[i][3]}
  #define PIN(x) asm volatile("":"+v"(x))
  #define MX3(a,b,c) __builtin_fmaxf(__builtin_fmaxf((a),(b)),(c))
  #define GAPA(MF,A0,A1,A2,A3,W0,W1,PW) do{ MF; sacc+=A0; sacc+=A1; sacc+=A2; sacc+=A3; PIN(sacc); W0; W1; PIN(PW); SBAR(); }while(0)
  #define EX(v) __builtin_amdgcn_exp2f(v)
  #define GAPB(MF,X,B) do{ MF; X[B]=EX(X[B]-mhat); X[B+1]=EX(X[B+1]-mhat); X[B+2]=EX(X[B+2]-mhat); X[B+3]=EX(X[B+3]-mhat); PIN(X); SBAR(); }while(0)
  #define GAPC(MF) do{ MF; SBAR(); }while(0)
  #define GAPB2(MF,X,B) do{ MF; X[B]=EX(X[B]-mhat); X[B+1]=EX(X[B+1]-mhat); PIN(X); SBAR(); }while(0)
  #define VRD2(i) do{ vlo[i]=vtr(vp_+((((i)>>2)+2)*4096+((i)&3)*1024)); vhi[i]=vtr(vp_+((((i)>>2)+2)*4096+((i)&3)*1024+512)); SBAR(); }while(0)
  #define VRD(i) do{ vlo[i]=vtr(vp_+(((i)>>2)*4096+((i)&3)*1024)); vhi[i]=vtr(vp_+(((i)>>2)*4096+((i)&3)*1024+512)); }while(0)
  #define KRD(G,j) do{ if(G){ kload2(kf,kp0+sl_next,j); SBAR(); } }while(0)
  #define STEP(C0,C1,P0,P1,t,GK,GV,GL) do{ SBAR(); \
    const lds_cptr vp_=vp0+2*sl_prev; \
    VRD(0); SBAR(); float sacc=(P0[0]+P0[1]); \
    GAPA(C0=__builtin_amdgcn_mfma_f32_32x32x16_bf16(kf[0],qr[0],CIN,0,0,0), P0[2],P0[3],P0[4],P0[5],     pw0[0]=PKW(P0,0), pw0[1]=PKW(P0,2), pw0); \
    VRD(4); SBAR(); GAPA(C1=__builtin_amdgcn_mfma_f32_32x32x16_bf16(kf[1],qr[0],CIN,0,0,0), P0[6],P0[7],P0[8],P0[9],     pw0[2]=PKW(P0,4), pw0[3]=PKW(P0,6), pw0); \
    VRD(1); SBAR(); GAPA(C0=__builtin_amdgcn_mfma_f32_32x32x16_bf16(kf[2],qr[1],C0,0,0,0),   P0[10],P0[11],P0[12],P0[13], pw1[0]=PKW(P0,8), pw1[1]=PKW(P0,10), pw1); \
    VRD(5); SBAR(); GAPA(C1=__builtin_amdgcn_mfma_f32_32x32x16_bf16(kf[3],qr[1],C1,0,0,0),   P0[14],P0[15],P1[0],P1[1],   pw1[2]=PKW(P0,12),pw1[3]=PKW(P0,14), pw1); \
    VRD(2); SBAR(); GAPA(C0=__builtin_amdgcn_mfma_f32_32x32x16_bf16(kf[4],qr[2],C0,0,0,0),   P1[2],P1[3],P1[4],P1[5],     pw2[0]=PKW(P1,0), pw2[1]=PKW(P1,2), pw2); \
    VRD(6); SBAR(); GAPA(C1=__builtin_amdgcn_mfma_f32_32x32x16_bf16(kf[5],qr[2],C1,0,0,0),   P1[6],P1[7],P1[8],P1[9],     pw2[2]=PKW(P1,4), pw2[3]=PKW(P1,6), pw2); \
    VRD(3); SBAR(); GAPA(C0=__builtin_amdgcn_mfma_f32_32x32x16_bf16(kf[6],qr[3],C0,0,0,0),   P1[10],P1[11],P1[12],P1[13], pw3[0]=PKW(P1,8), pw3[1]=PKW(P1,10), pw3); \
    VRD(7); SBAR(); GAPA(C1=__builtin_amdgcn_mfma_f32_32x32x16_bf16(kf[7],qr[3],C1,0,0,0),   P1[14],P1[15],0.f,0.f,       pw3[2]=PKW(P1,12),pw3[3]=PKW(P1,14), pw3); \
    l_reg+=sacc; \
    if(GK){DMA_K((t)+3,sl_cur);} if(GV){DMA_V((t)+1,sl_next);} \
    FADD(C0,C1,t); CMASK(C0,C1,t); \
    { float a=MX3(C0[0],C0[1],C1[0]),b=MX3(C0[2],C0[3],C1[1]); a=MX3(a,C1[2],C1[3]); \
      _Pragma("unroll") for(int r=4;r<16;r+=4){a=MX3(a,C0[r],C0[r+1]);b=MX3(b,C0[r+2],C0[r+3]);a=MX3(a,C1[r],C1[r+1]);b=MX3(b,C1[r+2],C1[r+3]);} \
      float rm=__builtin_fmaxf(a,b); { auto rr=__builtin_amdgcn_permlane32_swap(__float_as_uint(rm),__float_as_uint(rm),false,false); rm=__builtin_fmaxf(__uint_as_float(rr[0]),__uint_as_float(rr[1])); } \
      resc=false; \
      const float rmr=rm-mhat; \
      if(__builtin_expect(__any(rmr>(float)THRL),0)){ const float dl=__builtin_fmaxf(rmr,0.f); mhat+=dl; \
        const float f=__builtin_amdgcn_exp2f(-dl); l_reg*=f; if(hi==0)wsf[r32]=f; resc=true; } } \
    SBAR(); \
    GAPB2(o[0]=__builtin_amdgcn_mfma_f32_32x32x16_bf16(PAF(0),VFR(0),o[0],0,0,0), C0,0); VRD2(0); \
    GAPB2(o[1]=__builtin_amdgcn_mfma_f32_32x32x16_bf16(PAF(0),VFR(4),o[1],0,0,0), C0,2); VRD2(4); \
    KRD(GL,0); GAPB2(o[0]=__builtin_amdgcn_mfma_f32_32x32x16_bf16(PAF(1),VFR(1),o[0],0,0,0), C0,4); VRD2(1); \
    KRD(GL,1); GAPB2(o[1]=__builtin_amdgcn_mfma_f32_32x32x16_bf16(PAF(1),VFR(5),o[1],0,0,0), C0,6); VRD2(5); \
    KRD(GL,2); GAPB2(o[0]=__builtin_amdgcn_mfma_f32_32x32x16_bf16(PAF(2),VFR(2),o[0],0,0,0), C0,8); VRD2(2); \
    KRD(GL,3); GAPB2(o[1]=__builtin_amdgcn_mfma_f32_32x32x16_bf16(PAF(2),VFR(6),o[1],0,0,0), C0,10); VRD2(6); \
    GAPB2(o[0]=__builtin_amdgcn_mfma_f32_32x32x16_bf16(PAF(3),VFR(3),o[0],0,0,0), C0,12); VRD2(3); \
    GAPB2(o[1]=__builtin_amdgcn_mfma_f32_32x32x16_bf16(PAF(3),VFR(7),o[1],0,0,0), C0,14); VRD2(7); \
    GAPB2(o[2]=__builtin_amdgcn_mfma_f32_32x32x16_bf16(PAF(0),VFR(0),o[2],0,0,0), C1,0); GAPB2(o[3]=__builtin_amdgcn_mfma_f32_32x32x16_bf16(PAF(0),VFR(4),o[3],0,0,0), C1,2); \
    GAPB2(o[2]=__builtin_amdgcn_mfma_f32_32x32x16_bf16(PAF(1),VFR(1),o[2],0,0,0), C1,4); GAPB2(o[3]=__builtin_amdgcn_mfma_f32_32x32x16_bf16(PAF(1),VFR(5),o[3],0,0,0), C1,6); \
    GAPB2(o[2]=__builtin_amdgcn_mfma_f32_32x32x16_bf16(PAF(2),VFR(2),o[2],0,0,0), C1,8); GAPB2(o[3]=__builtin_amdgcn_mfma_f32_32x32x16_bf16(PAF(2),VFR(6),o[3],0,0,0), C1,10); \
    GAPB2(o[2]=__builtin_amdgcn_mfma_f32_32x32x16_bf16(PAF(3),VFR(3),o[2],0,0,0), C1,12); GAPB2(o[3]=__builtin_amdgcn_mfma_f32_32x32x16_bf16(PAF(3),VFR(7),o[3],0,0,0), C1,14); \
    }while(0)
  int t=1;
  #undef CMASK
  #define CMASK(P0,P1,t) do{}while(0)
  for(;t+(MODE==0?7:5)<NT;t+=2){
    STEP(pB0,pB1,pA0,pA1,t,true,true,true);     WAIT_BAR(3); RESC(); ROT();
    STEP(pA0,pA1,pB0,pB1,t+1,true,true,true);   WAIT_BAR(3); RESC(); ROT();
  }
  #undef CMASK
  #define CMASK(P0,P1,t) do{int jb_=(t)-(NT-4); if(MODE==1){ if(jb_>=0)cmask(P0,P1,jb_,qrel,hi); } else { if(jb_>=-2)biasmask(P0,P1,jb_,qrel,hi,tab3); } }while(0)
  #define ENDW(tt) do{ if((tt)+3<NT){WAIT_BAR(3);} else if((tt)+2<NT){WAIT_BAR(2);} else {WAIT_BAR(0);} }while(0)
  for(;t+1<NT;t+=2){
    STEP(pB0,pB1,pA0,pA1,t,(t+3<NT),(t+1<NT),(t+1<NT));       ENDW(t);   RESC(); ROT();
    STEP(pA0,pA1,pB0,pB1,t+1,(t+4<NT),(t+2<NT),(t+2<NT));     ENDW(t+1); RESC(); ROT();
  }
  STEP(pB0,pB1,pA0,pA1,NT-1,false,false,false); RESC();
  { float sacc=pB0[0]+pB0[1]; _Pragma("unroll") for(int r=2;r<16;++r)sacc+=pB0[r]; _Pragma("unroll") for(int r=0;r<16;++r)sacc+=pB1[r]; l_reg+=sacc;
    pw0=(u32x4){PKW(pB0,0),PKW(pB0,2),PKW(pB0,4),PKW(pB0,6)};pw1=(u32x4){PKW(pB0,8),PKW(pB0,10),PKW(pB0,12),PKW(pB0,14)};pw2=(u32x4){PKW(pB1,0),PKW(pB1,2),PKW(pB1,4),PKW(pB1,6)};pw3=(u32x4){PKW(pB1,8),PKW(pB1,10),PKW(pB1,12),PKW(pB1,14)};
    SBAR(); pv_w(o,vb0+2*sl_cur,PAF(0),PAF(1),PAF(2),PAF(3)); }
  #undef PKW
  #undef PAF
  #undef VFR
  #undef PIN
  #undef MX3
  #undef GAPA
  #undef GAPB
  #undef GAPC
  #undef GAPB2
  #undef VRD2
  #undef EX
  #undef VRD
  #undef KRD
  #undef STEP
  #undef ENDW
  {auto rr=__builtin_amdgcn_permlane32_swap(__float_as_uint(l_reg),__float_as_uint(l_reg),false,false);l_reg=__uint_as_float(rr[0])+__uint_as_float(rr[1]);}
  if(hi==0)wsf[32+r32]=l_reg;asm volatile("s_waitcnt lgkmcnt(0)":::"memory");
  float rli[16];
  #pragma unroll
  for(int r=0;r<16;++r)rli[r]=__builtin_amdgcn_rcpf(wsf[32+crow(r,hi)]);
  bf16*Ow=O+(rowbase+q0+wid*QBLK)*DM+oc;
  int lane2=tid_in; asm volatile("":"+v"(lane2)); lane2&=63;
  { bf16*stg=(bf16*)(shm+WLDS_OST)+wid*2048;
    #pragma unroll
    for(int hh=0;hh<2;++hh){
      #pragma unroll
      for(int r=0;r<16;++r){const int orow=crow(r,hi);
        #pragma unroll
        for(int d0=0;d0<2;++d0)stg[orow*64+d0*32+r32]=__float2bfloat16(o[2*hh+d0][r]*rli[r]);}
      asm volatile("s_waitcnt lgkmcnt(0)":::"memory");
      #pragma unroll
      for(int i=0;i<4;++i){const int row=i*8+(lane2>>3),ch=lane2&7; const u32x4 v=*(const u32x4*)(stg+row*64+ch*8); ATTN_STORE16(Ow+(long)row*DM+hh*64+ch*8,v);}
      asm volatile("s_waitcnt lgkmcnt(0)":::"memory"); } }
  asm volatile("s_waitcnt lgkmcnt(0)\n\ts_barrier":::"memory");
  #undef FADD
  #undef CIN
  #undef DMA_K
  #undef DMA_V
  #undef CMASK
  #undef START
  #undef RESC
  #undef ROT
}
constexpr int ATTN_W_LDS_BYTES=WLDS_BYTES+1024;
constexpr int ATTN_LDS_BYTES=LDS_BYTES;
#undef SBAR
#undef WAIT_BAR
}
namespace cg = cooperative_groups;
constexpr int NWAVES = 8;
constexpr int BATCH = 4, T = 8192, D = 1024, FF = 2816, NIN = 2 * FF, M = BATCH * T, NMOD = 9 * D;
constexpr float EPS = 1e-6f, LOG2E = 1.4426950408889634f;
constexpr size_t MiB = 1u << 20;
constexpr size_t WS_CNT = 6 * MiB, WS_XBUF = 7 * MiB, WS_BAR = 1 * MiB + 832 * 1024, WS_QCTR = 1 * MiB + 768 * 1024, WS_KPART = 1 * MiB + 512 * 1024, WS_MOD = 1 * MiB, WS_LOGF = 2 * MiB, WS_NF2 = 4 * MiB, WS_WB = 8 * MiB, WS_XN = 52 * MiB, WS_R1 = 116 * MiB, WS_R2 = 308 * MiB, WS_XN2 = 436 * MiB, WS_WA = 436 * MiB, WS_END = 500 * MiB;
constexpr size_t WO_IN0 = 0, WO_IN1 = 11 * MiB, WO_OUT0 = 22 * MiB, WO_OUT1 = 22 * MiB + 5767168, WO_X1 = 33 * MiB, WO_AWO = 39 * MiB, WO_BWQ = 37 * MiB, WO_BWO = 39 * MiB;
constexpr size_t BUF64 = 64 * MiB;
constexpr int RING_BYTES = 131072, LDS_BYTES = 147456;
static_assert(attn_body::ATTN_LDS_BYTES + 32768 <= RING_BYTES && attn_body::ATTN_W_LDS_BYTES <= RING_BYTES, "attention LDS");

#define LAS __attribute__((address_space(3)))
typedef unsigned short bf16;
typedef unsigned v4u __attribute__((ext_vector_type(4)));
typedef float f32x4 __attribute__((ext_vector_type(4)));
#define LDS_WAIT() asm volatile("s_waitcnt lgkmcnt(0)" ::: "memory")

#define XB_TMO      128
#define XB_XCNT(j)  (256  + 64 * (j))
#define XB_XSUB(j)  (1280 + 64 * (j))
#define XB_XGEN(j)  (2304 + 64 * (j))
#define XB_TOP      3328
#define XB_TOPGEN   3392
#define XCD_BAR_WORDS 3456
#define XB_SPIN_CAP (1u << 18)

__device__ __forceinline__ unsigned xb_ld(unsigned* p)              { return __hip_atomic_load(p, __ATOMIC_RELAXED, __HIP_MEMORY_SCOPE_AGENT); }
__device__ __forceinline__ unsigned xb_add(unsigned* p, unsigned v) { return __hip_atomic_fetch_add(p, v, __ATOMIC_RELAXED, __HIP_MEMORY_SCOPE_AGENT); }
__device__ __forceinline__ unsigned xb_xcc_id() { return (unsigned)__builtin_amdgcn_s_getreg((3 << 11) | 20) & 0xFu; }
#define XB_SPIN(cond, bar) do { unsigned _sp = 0; while (cond) { __builtin_amdgcn_s_sleep(1); \
    if ((++_sp & 255u) == 0u) { if (xb_ld(&(bar)[XB_TMO])) break; if (_sp > XB_SPIN_CAP) { atomicAdd(&(bar)[XB_TMO], 1u); break; } } } } while (0)

struct XcdBarrier {
    unsigned* bar; unsigned x;
    volatile LAS unsigned* st;
};

__device__ __forceinline__ XcdBarrier xcd_barrier_post(unsigned* bar, volatile LAS unsigned* st, int tid) {
    XcdBarrier b; b.bar = bar; b.x = xb_xcc_id(); b.st = st;
    if (tid == 0) (void)xb_add(&bar[XB_XCNT(b.x)], 1u);
    return b;
}
__device__ __forceinline__ void xcd_barrier_complete(unsigned* bar, unsigned x, unsigned& nloc, unsigned& nx) {
    const unsigned G = gridDim.x * gridDim.y * gridDim.z;
    unsigned sum, cnt, mine, sp = 0u;
    for (;;) {
        sum = 0u; cnt = 0u; mine = 0u;
#pragma unroll
        for (unsigned j = 0; j < 16; ++j) { const unsigned c = xb_ld(&bar[XB_XCNT(j)]); sum += c; cnt += (c > 0u) ? 1u : 0u; mine = (j == x) ? c : mine; }
        if (sum == G) break;
        __builtin_amdgcn_s_sleep(1);
        if ((++sp & 255u) == 0u) { if (xb_ld(&bar[XB_TMO])) break; if (sp > XB_SPIN_CAP) { atomicAdd(&bar[XB_TMO], 1u); break; } }
    }
    nloc = mine > 0u ? mine : 1u; nx = cnt > 0u ? cnt : 1u;
}

__device__ __forceinline__ void xcd_barrier(const XcdBarrier& b, int tid) {
    asm volatile("s_waitcnt vmcnt(0)" ::: "memory");
    __syncthreads();
    if (tid == 0) {
        unsigned* bar = b.bar;
        __builtin_amdgcn_s_waitcnt(0);
        unsigned nloc = b.st[0], nx = b.st[1];
        if (nloc == 0u) { xcd_barrier_complete(bar, b.x, nloc, nx); b.st[0] = nloc; b.st[1] = nx; }
        const unsigned old = xb_add(&bar[XB_XSUB(b.x)], 1u);
        const unsigned gen = old / nloc;
        if (old + 1u == (gen + 1u) * nloc) {
            __builtin_amdgcn_fence(__ATOMIC_RELEASE, "agent");
            asm volatile("s_waitcnt vmcnt(0)" ::: "memory");
            const unsigned og = xb_add(&bar[XB_TOP], 1u);
            const unsigned tg = og / nx;
            if (og + 1u == (tg + 1u) * nx) xb_add(&bar[XB_TOPGEN], 1u);
            else XB_SPIN(xb_ld(&bar[XB_TOPGEN]) == tg, bar);
            __builtin_amdgcn_fence(__ATOMIC_ACQUIRE, "agent");
            xb_add(&bar[XB_XGEN(b.x)], 1u);
            asm volatile("s_waitcnt vmcnt(0)" ::: "memory");
        } else {
            XB_SPIN(xb_ld(&bar[XB_XGEN(b.x)]) == gen, bar);
            __builtin_amdgcn_fence(__ATOMIC_ACQUIRE, "agent");
            asm volatile("s_waitcnt vmcnt(0)" ::: "memory");
        }
    }
    __syncthreads();
}


__device__ __forceinline__ float wave_sum(float v) {
    return wave_sum64(v);
}
__device__ __forceinline__ unsigned pk2(float lo, float hi) { return pg8::cvt_pk_bf16(lo, hi); }
__device__ __forceinline__ float bf_lo(unsigned u) { return __uint_as_float(u << 16); }
__device__ __forceinline__ float bf_hi(unsigned u) { return __uint_as_float(u & 0xffff0000u); }

__device__ __forceinline__ void p0_transpose_item(const float* W, int K, int N, bf16* WT, int perm, LAS float* scr, int item, int lane) {
    const int nblk = N / 32, kb = item / nblk, nb = item % nblk, k0 = 64 * kb, n0 = 32 * nb;
    int nd = n0;
    if (perm) nd = (n0 < FF) ? 256 * (n0 >> 7) + (n0 & 127) : 256 * ((n0 - FF) >> 7) + 128 + ((n0 - FF) & 127);
    float wv[32];
#pragma unroll
    for (int i = 0; i < 32; ++i) wv[i] = W[(size_t)(k0 + 2 * i + (lane >> 5)) * N + n0 + (lane & 31)];
#pragma unroll
    for (int i = 0; i < 32; ++i) scr[(2 * i + (lane >> 5)) * 33 + (lane & 31)] = wv[i];
    LDS_WAIT(); asm volatile("" ::: "memory");
    const int c = lane & 7;
#pragma unroll
    for (int j = 0; j < 4; ++j) { const int n = (lane >> 3) + 8 * j; const LAS float* s = scr + (8 * c) * 33 + n;
        v4u o; o.x = pk2(s[0 * 33], s[1 * 33]); o.y = pk2(s[2 * 33], s[3 * 33]); o.z = pk2(s[4 * 33], s[5 * 33]); o.w = pk2(s[6 * 33], s[7 * 33]);
        *(v4u*)(WT + (size_t)(nd + n) * K + k0 + 8 * c) = o; }
    LDS_WAIT(); asm volatile("" ::: "memory");
}
__device__ __forceinline__ void p0_mod_item(int item, const float* c, const float* ada_w, const float* ada_b, const float* kvw, const float* kvb, float* mod, LAS unsigned char* lds, int tid) {
    LAS float* cact = (LAS float*)lds; LAS float* red = (LAS float*)(lds + 16384);
    for (int i = tid; i < 4096; i += 512) { const int b = i >> 10, k = i & 1023; const float v = c[i]; cact[k * 4 + b] = v * __builtin_amdgcn_rcpf(1.f + __builtin_amdgcn_exp2f(-LOG2E * v)); }
    __syncthreads();
    const float* W; const float* bias; int N, col0, dstride; float* dst;
    if (item < 36) { W = ada_w; bias = ada_b; N = NMOD; col0 = 256 * item; dst = mod; dstride = NMOD; }
    else if (item < 72) { W = ada_w + (size_t)D * NMOD; bias = ada_b + NMOD; N = NMOD; col0 = 256 * (item - 36); dst = mod + 4 * NMOD; dstride = NMOD; }
    else { W = kvw; bias = kvb; N = 2 * D; col0 = 256 * (item - 72); dst = mod + 8 * NMOD; dstride = 2 * D; }
    const int wave = tid >> 6, lane = tid & 63;
    f32x4 a0 = {0.f, 0.f, 0.f, 0.f}, a1 = a0, a2 = a0, a3 = a0;
    const float* wp = W + (size_t)(128 * wave) * N + col0 + 4 * lane;
#pragma unroll 8
    for (int kk = 0; kk < 128; ++kk) { const f32x4 w = *(const f32x4*)(wp + (size_t)kk * N); const f32x4 cv = *(const LAS f32x4*)(cact + (128 * wave + kk) * 4);
        a0 += w * cv.x; a1 += w * cv.y; a2 += w * cv.z; a3 += w * cv.w; }
    LAS f32x4* rp = (LAS f32x4*)(red + (wave * 64 + lane) * 16);
    rp[0] = a0; rp[1] = a1; rp[2] = a2; rp[3] = a3;
    __syncthreads();
    for (int o = tid; o < 1024; o += 512) { const int b = o >> 8, j = o & 255; float s = 0.f;
#pragma unroll
        for (int w = 0; w < 8; ++w) s += red[(w * 64 + (j >> 2)) * 16 + 4 * b + (j & 3)];
        dst[(size_t)b * dstride + col0 + j] = s + bias[col0 + j]; }
    __syncthreads();
}
__device__ __forceinline__ void norm_rows(const float* src, const float* g, const float* shift, const float* scale, int mstride, bf16* dst, int gw, int NGW, int lane) {
    f32x4 nx[4];
    if (gw < M) {
#pragma unroll
        for (int j = 0; j < 4; ++j) nx[j] = ((const f32x4*)(src + (size_t)gw * D) + lane)[64 * j]; }
    for (int m = gw; m < M; m += NGW) {
        const int b = m >> 13;
        f32x4 v[4]; float s = 0.f;
#pragma unroll
        for (int j = 0; j < 4; ++j) v[j] = nx[j];
        if (m + NGW < M) { const f32x4* xn_ = (const f32x4*)(src + (size_t)(m + NGW) * D) + lane;
#pragma unroll
            for (int j = 0; j < 4; ++j) nx[j] = xn_[64 * j]; }
#pragma unroll
        for (int j = 0; j < 4; ++j) s += (v[j].x * v[j].x + v[j].y * v[j].y) + (v[j].z * v[j].z + v[j].w * v[j].w);
        const float rs = __builtin_amdgcn_rsqf(wave_sum(s) * (1.f / D) + EPS);
        const f32x4* g4 = (const f32x4*)g + lane; const f32x4* sh4 = (const f32x4*)(shift + (size_t)b * mstride) + lane; const f32x4* sc4 = (const f32x4*)(scale + (size_t)b * mstride) + lane;
        unsigned long long* o8 = (unsigned long long*)(dst + (size_t)m * D) + lane;
#pragma unroll
        for (int j = 0; j < 4; ++j) { const f32x4 y = v[j] * rs * g4[64 * j] * (sc4[64 * j] + 1.f) + sh4[64 * j];
            o8[64 * j] = (unsigned long long)pk2(y.x, y.y) | ((unsigned long long)pk2(y.z, y.w) << 32); }
    }
}
__device__ __forceinline__ void norm_rows_kv(const bf16* src, const float* gA, const float* shA, const float* scA, int strideA, bf16* dstA,
                                             const float* gB, const float* shB, const float* scB, int strideB, bf16* dstB,
                                             const LAS float* fgT, const float* fgb, float* logf_out, int gw, int NGW, int lane) {
    unsigned long long nw[4] = {0ull, 0ull, 0ull, 0ull};
    if (gw < M) { const unsigned long long* x0_ = (const unsigned long long*)(src + (size_t)gw * D) + lane;
#pragma unroll
        for (int j = 0; j < 4; ++j) nw[j] = x0_[64 * j]; }
    for (int m = gw; m < M; m += NGW) {
        const int b = m >> 13;
        unsigned long long cw[4];
#pragma unroll
        for (int j = 0; j < 4; ++j) cw[j] = nw[j];
        if (m + NGW < M) { const unsigned long long* xn_ = (const unsigned long long*)(src + (size_t)(m + NGW) * D) + lane;
#pragma unroll
            for (int j = 0; j < 4; ++j) nw[j] = xn_[64 * j]; }
        f32x4 v[4]; float s = 0.f;
#pragma unroll
        for (int j = 0; j < 4; ++j) { const unsigned long long w = cw[j]; const unsigned lo = (unsigned)w, hi = (unsigned)(w >> 32);
            { const pg8::f32x2s_t a = pg8::up_h2(lo), b = pg8::up_h2(hi); v[j] = (f32x4){a.x, a.y, b.x, b.y}; } s += (v[j].x * v[j].x + v[j].y * v[j].y) + (v[j].z * v[j].z + v[j].w * v[j].w); }
        const float rs = __builtin_amdgcn_rsqf(wave_sum(s) * (1.f / D) + EPS);
        {   const f32x4* g4 = (const f32x4*)gB + lane; const f32x4* sh4 = (const f32x4*)(shB + (size_t)b * strideB) + lane; const f32x4* sc4 = (const f32x4*)(scB + (size_t)b * strideB) + lane;
            unsigned long long* o8 = (unsigned long long*)(dstB + (size_t)m * D) + lane;
#pragma unroll
            for (int j = 0; j < 4; ++j) { const f32x4 y = v[j] * rs * g4[64 * j] * (sc4[64 * j] + 1.f) + sh4[64 * j];
                o8[64 * j] = (unsigned long long)pk2(y.x, y.y) | ((unsigned long long)pk2(y.z, y.w) << 32); } }
        {   const f32x4* g4 = (const f32x4*)gA + lane; const f32x4* sh4 = (const f32x4*)(shA + (size_t)b * strideA) + lane; const f32x4* sc4 = (const f32x4*)(scA + (size_t)b * strideA) + lane;
            unsigned long long* o8 = (unsigned long long*)(dstA + (size_t)m * D) + lane;
#pragma unroll
            for (int j = 0; j < 4; ++j) { v[j] = v[j] * rs * g4[64 * j] * (sc4[64 * j] + 1.f) + sh4[64 * j];
                o8[64 * j] = (unsigned long long)pk2(v[j].x, v[j].y) | ((unsigned long long)pk2(v[j].z, v[j].w) << 32); } }
        float zmine = 0.f;
#pragma unroll
        for (int hh = 0; hh < 16; ++hh) { float p = 0.f;
#pragma unroll
            for (int j = 0; j < 4; ++j) { const f32x4 w = *(const LAS f32x4*)(fgT + hh * 1024 + 256 * j + 4 * lane); p += (v[j].x * w.x + v[j].y * w.y) + (v[j].z * w.z + v[j].w * w.w); }
            p = wave_sum(p); if (lane == hh) zmine = p; }
        if (lane < 16) { const float z = zmine + fgb[lane]; const float lf = fminf(z, 0.f) - 0.6931471805599453f * __builtin_amdgcn_logf(1.f + __builtin_amdgcn_exp2f(-LOG2E * fabsf(z)));     logf_out[(size_t)m * 16 + lane] = lf; }
    }
}
__device__ __forceinline__ void combine_rows(const bf16* O0, const bf16* O1, const float* lamp, const float* subg, bf16* dst, int gw, int NGW, int lane) {
    const float pa = lamp[lane] * lamp[64 + lane], pb = lamp[128 + lane] * lamp[192 + lane];
    const float lam = __builtin_amdgcn_exp2f(LOG2E * wave_sum(pa)) - __builtin_amdgcn_exp2f(LOG2E * wave_sum(pb)) + 0.2f;
    float gg[16];
#pragma unroll
    for (int e = 0; e < 16; ++e) gg[e] = subg[16 * (lane & 7) + e] * 0.8f;
    v4u na0, na1, nb0, nb1;
    if (gw < M) { const v4u* p0 = (const v4u*)(O0 + (size_t)gw * D + 16 * lane); const v4u* p1 = (const v4u*)(O1 + (size_t)gw * D + 16 * lane); na0 = p0[0]; na1 = p0[1]; nb0 = p1[0]; nb1 = p1[1]; }
    for (int m = gw; m < M; m += NGW) {
        const v4u a0 = na0, a1 = na1, b0 = nb0, b1 = nb1;
        if (m + NGW < M) { const v4u* p0 = (const v4u*)(O0 + (size_t)(m + NGW) * D + 16 * lane); const v4u* p1 = (const v4u*)(O1 + (size_t)(m + NGW) * D + 16 * lane); na0 = p0[0]; na1 = p0[1]; nb0 = p1[0]; nb1 = p1[1]; }
        float v[16];
#pragma unroll
        for (int i = 0; i < 4; ++i) { v[2 * i] = bf_lo(a0[i]) - lam * bf_lo(b0[i]); v[2 * i + 1] = bf_hi(a0[i]) - lam * bf_hi(b0[i]);
            v[8 + 2 * i] = bf_lo(a1[i]) - lam * bf_lo(b1[i]); v[8 + 2 * i + 1] = bf_hi(a1[i]) - lam * bf_hi(b1[i]); }
        float ss = 0.f;
#pragma unroll
        for (int e = 0; e < 16; ++e) ss += v[e] * v[e];
        ss = xadd<1>(ss); ss = xadd<2>(ss); ss = xadd<4>(ss);
        const float rs = __builtin_amdgcn_rsqf(ss * (1.f / 128.f) + EPS);
        v4u o0, o1;
#pragma unroll
        for (int i = 0; i < 4; ++i) { o0[i] = pk2(v[2 * i] * rs * gg[2 * i], v[2 * i + 1] * rs * gg[2 * i + 1]); o1[i] = pk2(v[8 + 2 * i] * rs * gg[8 + 2 * i], v[8 + 2 * i + 1] * rs * gg[8 + 2 * i + 1]); }
        v4u* q = (v4u*)(dst + (size_t)m * D + 16 * lane); q[0] = o0; q[1] = o1;
    }
}
__device__ __forceinline__ void scan_seq(int seq, const float* logf_in, float* nf2, LAS unsigned char* lds, int tid) {
    const int b = seq >> 4, hh = seq & 15, s0 = 16 * tid, lane = tid & 63, wave = tid >> 6;
    float v[16]; float run = 0.f;
#pragma unroll
    for (int i = 0; i < 16; ++i) { run += logf_in[((size_t)(b * T + s0 + i)) * 16 + hh]; v[i] = run; }
    float incl = run;
#pragma unroll
    for (int o = 1; o < 64; o <<= 1) { const float t = __int_as_float(__builtin_amdgcn_ds_bpermute((lane - o) << 2, __float_as_int(incl))); if (lane >= o) incl += t; }
    LAS float* wt = (LAS float*)lds;
    if (lane == 63) wt[wave] = incl;
    __syncthreads();
    float off = incl - run;
    for (int w = 0; w < wave; ++w) off += wt[w];
#pragma unroll
    for (int i = 0; i < 16; ++i) nf2[(size_t)seq * T + s0 + i] = -(off + v[i]) * LOG2E;
    __syncthreads();
}

__device__ __forceinline__ void kmax_rows(const bf16* KB, float* kpart, LAS unsigned char* lds, int gw, int NGW, int tid, int lane, int bx) {
    LAS unsigned* lm = (LAS unsigned*)lds;
    if (tid < 64) lm[tid] = 0u;
    __syncthreads();
    float run = 0.f; int cb = -1;
    v4u ka0 = {0u, 0u, 0u, 0u}, ka1 = ka0;
    if (gw < M) { const v4u* p0_ = (const v4u*)(KB + (size_t)gw * D + 16 * lane); ka0 = p0_[0]; ka1 = p0_[1]; }
    for (int m = gw; m < M; m += NGW) {
        const int b = m >> 13;
        if (b != cb) { if (cb >= 0 && (lane & 3) == 0) atomicMax((unsigned*)(lm + cb * 16 + (lane >> 2)), __float_as_uint(run)); run = 0.f; cb = b; }
        const v4u a0 = ka0, a1 = ka1;
        if (m + NGW < M) { const v4u* pn_ = (const v4u*)(KB + (size_t)(m + NGW) * D + 16 * lane); ka0 = pn_[0]; ka1 = pn_[1]; }
        float ss = 0.f;
#pragma unroll
        for (int i = 0; i < 4; ++i) { const float x0 = bf_lo(a0[i]), x1 = bf_hi(a0[i]), x2 = bf_lo(a1[i]), x3 = bf_hi(a1[i]); ss += (x0 * x0 + x1 * x1) + (x2 * x2 + x3 * x3); }
        ss = xadd<1>(ss); ss = xadd<2>(ss);
        run = fmaxf(run, ss);
    }
    if (cb >= 0 && (lane & 3) == 0) atomicMax((unsigned*)(lm + cb * 16 + (lane >> 2)), __float_as_uint(run));
    __syncthreads();
    if (tid < 64) kpart[(size_t)bx * 64 + tid] = __uint_as_float(lm[tid]);
    __syncthreads();
}

struct Args { const float* in[21]; float* out; unsigned char* ws; int pad0, pad1; };
enum { K_PRO = 0, K_NORM, K_SWIGLU, K_RESID, K_SPLIT, K_ATTNA, K_COMB, K_NORMKV, K_ATTNB, K_RESIDN, K_NOP };
constexpr int NPH = 23;

__global__ void __launch_bounds__(NWAVES * 64, 2) skel_fwd(Args args) {
    extern __shared__ __attribute__((aligned(16))) unsigned char lds[];
    cg::grid_group grid = cg::this_grid();
    LAS unsigned char* ldsL = (LAS unsigned char*)lds;
    typedef __attribute__((address_space(4))) const Args CArgs;
    {   volatile LAS unsigned* bst0 = (volatile LAS unsigned*)(ldsL + RING_BYTES + 512);
        if (threadIdx.x < 2) bst0[threadIdx.x] = 0u;
        if (blockIdx.x == 0) { unsigned* bw = (unsigned*)(args.ws + WS_BAR); for (int i = threadIdx.x; i < XCD_BAR_WORDS; i += NWAVES * 64) bw[i] = 0u;
            unsigned* cw = (unsigned*)(args.ws + WS_CNT); for (int i = threadIdx.x; i < 5 * 128 * 64; i += NWAVES * 64) cw[i] = 0u; }
        __syncthreads(); }
    int prep = 0;
    const int wave_s = __builtin_amdgcn_readfirstlane(threadIdx.x >> 6);
#pragma nounroll
    for (int ph = 0; ph < NPH; ++ph) {
        CArgs* ap = (CArgs*)__builtin_amdgcn_kernarg_segment_ptr();
        asm volatile("" : "+s"(ap));
        const int wave = wave_s;
#define TID() opq_tid(wave_s)
        int G = gridDim.x, bx = blockIdx.x; asm volatile("" : "+s"(G), "+s"(bx));
        const int vcu = (G % 8 == 0) ? (bx % 8) * (G / 8) + bx / 8 : bx;
        const int gw = vcu * NWAVES + wave, NGW = G * NWAVES;
        unsigned char* ws = ap->ws;
        const float* x = ap->in[0];
        float* OUTF = ap->out; bf16* XB = (bf16*)ap->out;
        bf16* XB2 = (bf16*)(ws + WS_XN2);
        float* mod = (float*)(ws + WS_MOD);
        float* kvmod = mod + 8 * NMOD;
        float* logfb = (float*)(ws + WS_LOGF);
        float* nf2 = (float*)(ws + WS_NF2);
        bf16* XN = (bf16*)(ws + WS_XN); bf16* XN2 = (bf16*)(ws + WS_XN2);
        bf16* R1 = (bf16*)(ws + WS_R1); bf16* R2 = (bf16*)(ws + WS_R2);
        const float* norm_g = ap->in[4];
        int kind = K_NORM; bool sync_after = true;
        const bf16* gA = XN; const bf16* gB = nullptr; int gN = D, gK = D;
        const float* nsrc = x; const float* ng = norm_g; const float* nsh = mod; const float* nsc = mod;
        const void* rbase = XB; int rbase_bf = 1; bf16* rout = XB; const float* rgate = mod; float rcoef = 0.5f;
        bf16* sO = R1; float sscale = 1.f;
        int bank = 0, fin = 0;
        const int L = (ph >= 12) ? 1 : 0;
        unsigned char* wl = ws + (L ? WS_WB : WS_WA);
        const float* modl = mod + (size_t)L * 4 * NMOD;
        switch (ph) {
            case 0: kind = K_PRO; break;
            case 1: kind = K_NORM; nsrc = x; ng = norm_g; nsh = modl; nsc = modl + D; break;
            case 2: kind = K_SWIGLU; gB = (const bf16*)(wl + WO_IN0); gN = NIN; gK = D; break;
            case 3: kind = K_RESIDN; gA = R1; gB = (const bf16*)(wl + WO_OUT0); gN = D; gK = FF; rbase = x; rbase_bf = 0; rgate = modl + 2 * D; rcoef = 0.5f; bank = 0; ng = norm_g + D; nsh = modl + 3 * D; nsc = modl + 4 * D; break;
            case 4: kind = K_NOP; sync_after = false; break;
            case 5: kind = K_SPLIT; gB = (const bf16*)(wl + WO_X1); gN = 3 * D; gK = D; sO = R1; sscale = attn_body::C2; break;
            case 6: kind = K_ATTNA; break;
            case 7: kind = K_COMB; break;
            case 8: kind = K_RESIDN; gA = R1; gB = (const bf16*)(wl + WO_AWO); gN = D; gK = D; rgate = modl + 5 * D; rcoef = 1.f; bank = 1; ng = norm_g + 2 * D; nsh = modl + 6 * D; nsc = modl + 7 * D; break;
            case 9: kind = K_NOP; sync_after = false; break;
            case 10: kind = K_SWIGLU; gB = (const bf16*)(wl + WO_IN1); gN = NIN; gK = D; break;
            case 11: kind = K_RESID; gA = R1; gB = (const bf16*)(wl + WO_OUT1); gN = D; gK = FF; rgate = modl + 8 * D; rcoef = 0.5f; break;
            case 12: kind = K_NORMKV; break;
            case 13: kind = K_SPLIT; gB = (const bf16*)(wl + WO_X1); gN = 2 * D; gK = D; sO = R2; sscale = 1.f; sync_after = false; break;
            case 14: kind = K_SWIGLU; gA = XN2; gB = (const bf16*)(wl + WO_IN0); gN = NIN; gK = D; break;
            case 15: kind = K_RESIDN; gA = R1; gB = (const bf16*)(wl + WO_OUT0); gN = D; gK = FF; rgate = modl + 2 * D; rcoef = 0.5f; bank = 2; ng = norm_g + 4 * D; nsh = modl + 3 * D; nsc = modl + 4 * D; break;
            case 16: kind = K_NOP; sync_after = false; break;
            case 17: kind = K_SPLIT; gB = (const bf16*)(wl + WO_BWQ); gN = D; gK = D; sO = R1; sscale = attn_body::C2; break;
            case 18: kind = K_ATTNB; break;
            case 19: kind = K_RESIDN; gA = R1; gB = (const bf16*)(wl + WO_BWO); gN = D; gK = D; rgate = modl + 5 * D; rcoef = 1.f; bank = 3; rout = XB2; ng = norm_g + 5 * D; nsh = modl + 6 * D; nsc = modl + 7 * D; break;
            case 20: kind = K_NOP; sync_after = false; break;
            case 21: kind = K_SWIGLU; gB = (const bf16*)(wl + WO_IN1); gN = NIN; gK = D; break;
            case 22: kind = K_RESIDN; gA = R1; gB = (const bf16*)(wl + WO_OUT1); gN = D; gK = FF; rgate = modl + 8 * D; rcoef = 0.5f; bank = 4; fin = 1; rbase = XB2; ng = ap->in[20]; sync_after = false; break;
            default: kind = K_NOP; sync_after = false; break;
        }
#ifndef PROBE_REP
#define PROBE_REP 0
#endif
#ifndef PROBE_SYNC
#define PROBE_SYNC 1
#endif
        if (kind == K_PRO) {
            if (bx == 0 && TID() == 0) *(unsigned*)(ws + WS_QCTR) = 0u;
            if (PROBE_REP != 0 && bx == 1 && TID() == 0) ((unsigned*)(ws + WS_QCTR))[1] = 0u;
            for (int it = bx; it < 80; it += G) p0_mod_item(it, ap->in[1], ap->in[2], ap->in[3], ap->in[12], ap->in[13], mod, ldsL, TID());
            LAS float* scr = (LAS float*)(ldsL + wave * 16384);
            constexpr int I_IN = (D / 64) * (NIN / 32), I_OUT = (FF / 64) * (D / 32), I_QKV = (D / 64) * (3 * D / 32), I_SQ = (D / 64) * (D / 32), I_KV = (D / 64) * (2 * D / 32);
            constexpr int NITEMS = 4 * I_IN + 4 * I_OUT + I_QKV + I_SQ + I_KV + 2 * I_SQ;
            for (int it = gw; it < NITEMS; it += NGW) {
                int r = it; const float* W; int K, N, perm = 0; bf16* WT;
                if (r < 4 * I_IN) { const int w = r / I_IN; r -= w * I_IN; W = ap->in[5] + (size_t)w * D * NIN; K = D; N = NIN; perm = 1;
                    WT = (bf16*)(ws + ((w >> 1) ? WS_WB : WS_WA) + ((w & 1) ? WO_IN1 : WO_IN0)); }
                else if ((r -= 4 * I_IN) < 4 * I_OUT) { const int w = r / I_OUT; r -= w * I_OUT; W = ap->in[6] + (size_t)w * FF * D; K = FF; N = D;
                    WT = (bf16*)(ws + ((w >> 1) ? WS_WB : WS_WA) + ((w & 1) ? WO_OUT1 : WO_OUT0)); }
                else if ((r -= 4 * I_OUT) < I_QKV) { W = ap->in[7]; K = D; N = 3 * D; WT = (bf16*)(ws + WS_WA + WO_X1); }
                else if ((r -= I_QKV) < I_SQ) { W = ap->in[8]; K = D; N = D; WT = (bf16*)(ws + WS_WA + WO_AWO); }
                else if ((r -= I_SQ) < I_KV) { W = ap->in[15]; K = D; N = 2 * D; WT = (bf16*)(ws + WS_WB + WO_X1); }
                else if ((r -= I_KV) < I_SQ) { W = ap->in[18]; K = D; N = D; WT = (bf16*)(ws + WS_WB + WO_BWQ); }
                else { r -= I_SQ; W = ap->in[19]; K = D; N = D; WT = (bf16*)(ws + WS_WB + WO_BWO); }
                p0_transpose_item(W, K, N, WT, perm, scr, r, TID() & 63);
            }
        } else if (kind == K_NORM) {
            norm_rows(nsrc, ng, nsh, nsc, NMOD, XN, gw, NGW, TID() & 63);
        } else if (kind == K_NORMKV) {
            LAS float* fgT = (LAS float*)ldsL;
            for (int i = TID(); i < 16 * D; i += NWAVES * 64) { const int c = i >> 4, hh = i & 15; fgT[hh * 1024 + c] = ap->in[16][i]; }
            __syncthreads();
            norm_rows_kv(XB, ap->in[14], kvmod, kvmod + D, 2 * D, XN, norm_g + 3 * D, modl, modl + D, NMOD, XN2, fgT, ap->in[17], logfb, gw, NGW, TID() & 63);
            __syncthreads();
        } else if (kind == K_SWIGLU) {
            pg8::Gemm g{gA, gB, M, gN, gK}; pg8::StaticOrder S; S.init(M, gN, G, bx);
            pg8::EpiSwiglu E{R1, FF};
            pg8::gemm_phase<pg8::EpiSwiglu, pg8::StaticOrder, true, true>(ldsL, g, S, E, TID());
        } else if (kind == K_RESID) {
            pg8::Gemm g{gA, gB, M, gN, gK}; pg8::StaticOrder S; S.init(M, gN, G, bx);
            pg8::EpiResid E{(const bf16*)rbase, rout, rgate, NMOD, rcoef};
            pg8::gemm_phase<pg8::EpiResid, pg8::StaticOrder, true, true>(ldsL, g, S, E, TID());
        } else if (kind == K_RESIDN) {
            pg8::Gemm g{gA, gB, M, D, gK}; pg8::StaticOrder S; S.init(M, D, G, bx);
            pg8::RmsStats st{(unsigned*)(ws + WS_XBUF), (unsigned*)(ws + WS_CNT) + (size_t)bank * 128 * 64, EPS};
#define RUN_RESIDN(BH, FN) do { pg8::EpiResidNorm<BH, FN> E{rbase, rout, OUTF, rgate, NMOD, rcoef, ng, nsh, nsc, NMOD, XN, st, ldsL + RING_BYTES + 1024}; \
                pg8::gemm_phase<pg8::EpiResidNorm<BH, FN>, pg8::StaticOrder, true, true>(ldsL, g, S, E, TID()); } while (0)
            if (fin) RUN_RESIDN(true, true); else if (rbase_bf) RUN_RESIDN(true, false); else RUN_RESIDN(false, false);
#undef RUN_RESIDN
        } else if (kind == K_SPLIT) {
            if (ph == 17) { const int t_ = TID(); kmax_rows(R2, (float*)(ws + WS_KPART), ldsL, gw, NGW, t_, t_ & 63, bx); }
            pg8::Gemm g{gA, gB, M, gN, gK}; pg8::StaticOrder S; S.init(M, gN, G, bx);
            pg8::EpiBf16<0> E{sO, D, nullptr, D, BUF64 / 2, sscale};
            pg8::gemm_phase<pg8::EpiBf16<0>, pg8::StaticOrder, true, true>(ldsL, g, S, E, TID());
            if (ph == 13) { for (int seq = bx; seq < 64; seq += G) scan_seq(seq, logfb, nf2, ldsL, TID()); }
        } else if (kind == K_ATTNA) {
            const attn_body::bf16* Qp = (const attn_body::bf16*)R1; const attn_body::bf16* Kp = Qp + BUF64 / 2; const attn_body::bf16* Vp = Kp + BUF64 / 2;
            attn_body::bf16* O0 = (attn_body::bf16*)R2; attn_body::bf16* O1 = O0 + BUF64 / 2;
            for (int pi = vcu; pi < 1024; pi += G) { const int combo = pi >> 4, s = pi & 15, b = combo >> 4, h16 = combo & 15;
                const int vc = (h16 >> 1) * 128;
                for (int k = 0; k < 2; ++k) { const int qb = k ? s : 31 - s;
                    attn_body::attn_unit_w<8>(b, h16 * 64, h16 * 64, vc, vc, qb, Qp, Kp, Vp, (h16 & 1) ? O1 : O0, (char*)lds, ap->in[11], h16 >> 1, nullptr, 0, TID()); } }
        } else if (kind == K_ATTNB) {
            const attn_body::bf16* Qp = (const attn_body::bf16*)R1; const attn_body::bf16* Kp = (const attn_body::bf16*)R2; const attn_body::bf16* Vp = Kp + BUF64 / 2;
            LAS int* ordl = (LAS int*)(ldsL + RING_BYTES); LAS unsigned* slotl = (LAS unsigned*)(ldsL + RING_BYTES + 256);
            if (wave == 0) { const int lane = TID() & 63; const float v = nf2[(size_t)lane * T + T - 1]; int rank = 0;
                for (int j = 0; j < 64; ++j) { const float vj = __int_as_float(__builtin_amdgcn_readlane(__float_as_int(v), j)); rank += (vj < v || (vj == v && j < lane)) ? 1 : 0; }
                ordl[rank] = lane; }
            __syncthreads();
            unsigned* qctr = (unsigned*)(ws + WS_QCTR) + (PROBE_REP ? prep : 0);
            for (;;) {
                if (TID() == 0) slotl[0] = atomicAdd(qctr, 1u);
                __syncthreads();
                const unsigned u = slotl[0];
                __syncthreads();
                if (u >= 2048u) break;
                const int combo = ordl[u >> 5], qb = 31 - (int)(u & 31u), b = combo >> 4, h = combo & 15;
                attn_body::attn_unit<8, 1>(b, h * 64, h * 64, h * 64, h * 64, qb, Qp, Kp, Vp, (attn_body::bf16*)R1, (char*)lds, nf2 + (size_t)combo * T, 0, (const float*)(ws + WS_KPART) + combo, G, TID());
            }
        } else if (kind == K_COMB) {
            combine_rows(R2, R2 + BUF64 / 2, ap->in[9], ap->in[10], R1, gw, NGW, TID() & 63);
        }
        if (PROBE_REP != 0 && prep == 0 && ((PROBE_REP >> kind) & 1) && kind != K_RESID && kind != K_RESIDN && kind != K_NOP) { prep = 1; --ph; if (ph < 0) { grid.sync(); } else { XcdBarrier bar; bar.bar = (unsigned*)(ws + WS_BAR); bar.x = xb_xcc_id(); bar.st = (volatile LAS unsigned*)(ldsL + RING_BYTES + 512); xcd_barrier(bar, TID()); } continue; }
        prep = 0;
        if (sync_after) {
            XcdBarrier bar; bar.bar = (unsigned*)(ws + WS_BAR); bar.x = xb_xcc_id(); bar.st = (volatile LAS unsigned*)(ldsL + RING_BYTES + 512);
            if (ph == 0) { grid.sync(); if (TID() == 0) (void)xb_add(&bar.bar[XB_XCNT(bar.x)], 1u); }
            else { for (int sy = 0; sy < PROBE_SYNC; ++sy) xcd_barrier(bar, TID()); }
        }
    }
}

extern "C" void kernel_launch(void* const* d_in, const int* in_sizes, int n_in, void* d_out, int out_size, void* d_ws, size_t ws_size, hipStream_t stream) {
    static int grid = 0;
    if (grid == 0) {
        if (n_in != 21 || in_sizes[0] != M * D || out_size != M * D || ws_size < WS_END) { fprintf(stderr, "kernel_launch: unexpected shapes (n_in %d in0 %d out %d ws %zu); nothing launched\n", n_in, n_in > 0 ? in_sizes[0] : -1, out_size, ws_size); grid = -1; return; }
        int dev = 0, cus = 0, per_cu = 0;
        (void)hipGetDevice(&dev);
        (void)hipDeviceGetAttribute(&cus, hipDeviceAttributeMultiprocessorCount, dev);
        (void)hipFuncSetAttribute((const void*)skel_fwd, hipFuncAttributeMaxDynamicSharedMemorySize, LDS_BYTES);
        (void)hipOccupancyMaxActiveBlocksPerMultiprocessor(&per_cu, (const void*)skel_fwd, NWAVES * 64, LDS_BYTES);
        if (per_cu < 1) per_cu = 1;
        grid = cus * per_cu;
    }
    if (grid < 0) return;
    Args a{};
    for (int i = 0; i < 21; ++i) a.in[i] = (const float*)d_in[i];
    a.out = (float*)d_out; a.ws = (unsigned char*)d_ws;
    void* kargs[] = {&a};
    hipError_t e = hipLaunchCooperativeKernel((const void*)skel_fwd, dim3(grid), dim3(NWAVES * 64), kargs, LDS_BYTES, stream);
    if (e != hipSuccess) fprintf(stderr, "cooperative launch failed: %s (grid %d)\n", hipGetErrorString(e), grid);
}
```

```cpp
#include <hip/hip_cooperative_groups.h>
#include <hip/hip_runtime.h>
#include <cstdio>
#include <cstdint>
__device__ __forceinline__ int opq_tid(int wave_s) { int l; asm volatile("v_mbcnt_lo_u32_b32 %0, -1, 0\n\tv_mbcnt_hi_u32_b32 %0, -1, %0" : "=v"(l)); return (wave_s << 6) | l; }
template <int O> __device__ __forceinline__ float xlane_partner_lt32(float v) { return __int_as_float(__builtin_amdgcn_ds_swizzle(__float_as_int(v), (O << 10) | 0x1f)); }
template <int O> __device__ __forceinline__ float xadd(float v) {
    if constexpr (O == 32) { auto rr = __builtin_amdgcn_permlane32_swap(__float_as_uint(v), __float_as_uint(v), false, false); return __uint_as_float(rr[0]) + __uint_as_float(rr[1]); }
    else return v + xlane_partner_lt32<O>(v); }
template <int O> __device__ __forceinline__ float xmax(float v) {
    if constexpr (O == 32) { auto rr = __builtin_amdgcn_permlane32_swap(__float_as_uint(v), __float_as_uint(v), false, false); return fmaxf(__uint_as_float(rr[0]), __uint_as_float(rr[1])); }
    else return fmaxf(v, xlane_partner_lt32<O>(v)); }
__device__ __forceinline__ float wave_sum64(float v) { v = xadd<1>(v); v = xadd<2>(v); v = xadd<4>(v); v = xadd<8>(v); v = xadd<16>(v); return xadd<32>(v); }
__device__ __forceinline__ float wave_max32(float v) { v = xmax<1>(v); v = xmax<2>(v); v = xmax<4>(v); v = xmax<8>(v); return xmax<16>(v); }
__device__ __forceinline__ float wave_max64(float v) { return xmax<32>(wave_max32(v)); }
namespace pg8 {
#define PG8_LAS __attribute__((address_space(3)))
typedef unsigned short bf16_t;
typedef short bf16x8 __attribute__((ext_vector_type(8)));
typedef float f32x4 __attribute__((ext_vector_type(4)));
typedef unsigned u32x4 __attribute__((ext_vector_type(4)));
constexpr int BM = 256, BK = 64, HALF = 128, HTB = HALF * BK * 2  , STAGE_BYTES = 8 * HTB, NXCD = 8, WGM = 8;

__host__ __device__ __forceinline__ int lds_byte(int r, int c) { const int st = (r >> 4) * 2 + (c >> 5), rr = r & 15, cc = c & 31, ob = rr * 64 + cc * 2; return st * 1024 + (ob ^ (((ob >> 9) & 1) << 5)); }
__host__ __device__ __forceinline__ void stage_rc(int b, int& R, int& C) { const int st = b / 1024, sb = b % 1024, swz = sb ^ (((sb >> 9) & 1) << 5); R = (st >> 1) * 16 + swz / 64; C = (st & 1) * 32 + (swz % 64) / 2; }
__host__ __device__ __forceinline__ int perm32(int rho) { const int n = rho >> 4, i = rho & 15; return 8 * (i >> 2) + 4 * n + (i & 3); }

struct Unit { int pm, pn; };
struct Gemm { const bf16_t* A; const bf16_t* Bt; int M, N, K; };

struct StaticOrder {
    int nM, nN, nwg, G, c;
    __host__ __device__ void init(int M, int N, int G_, int c_) { nM = M / BM; nN = N / BM; nwg = nM * nN; G = G_; c = c_; }
    __host__ __device__ bool next(int i, Unit& u) const {
        const long L = (long)i * G + c; if (L >= nwg) return false;
        int wgid = (int)L; { const int q = nwg / NXCD, r = nwg % NXCD, xcd = wgid % NXCD, off = wgid / NXCD; wgid = (xcd < r ? xcd * (q + 1) : r * (q + 1) + (xcd - r) * q) + off; }
        const int nig = WGM * nN, gid = wgid / nig, fm = gid * WGM, gsz = (nM - fm) < WGM ? (nM - fm) : WGM;
        u.pm = fm + ((wgid % nig) % gsz); u.pn = (wgid % nig) / gsz; return true;
    }
    __device__ __forceinline__ void a_ready(const Unit&) const {}
    __device__ __forceinline__ void done(const Unit&) const {}
};

__device__ __forceinline__ unsigned cvt_pk_bf16(float lo, float hi) { unsigned r; asm volatile("v_cvt_pk_bf16_f32 %0, %1, %2" : "=v"(r) : "v"(lo), "v"(hi)); return r; }
typedef float f32x2 __attribute__((ext_vector_type(2)));
__device__ __forceinline__ f32x2 gelu_pk(f32x2 v) {
    const f32x2 av = __builtin_elementwise_abs(v), d = av * 0.2316418882f + 1.0f;
    f32x2 t; t.x = __builtin_amdgcn_rcpf(d.x); t.y = __builtin_amdgcn_rcpf(d.y);
    f32x2 q = t * 0.5307027145f + (-0.7265760135f); q = q * t + 0.7107068705f; q = q * t + (-0.142248368f); q = q * t + 0.127414796f; q = q * t;
    const f32x2 s = (v * v) * (-0.72134752044f);
    f32x2 e; e.x = __builtin_amdgcn_exp2f(s.x); e.y = __builtin_amdgcn_exp2f(s.y);
    const f32x2 m = v * (q * e), r = v - m;
    f32x2 o; o.x = v.x < 0.f ? m.x : r.x; o.y = v.y < 0.f ? m.y : r.y; return o;
}

template <int ACT  > struct EpiBf16 {
    static constexpr bool PERM = true, AFTER_DRAIN = false; static_assert(ACT == 0 || ACT == 1, "EpiBf16: ACT is 0 (none) or 1 (gelu_pk)");
    bf16_t* O; int ldc; const float* bias; int split_cols; size_t split_stride; float scale0;
    __device__ __forceinline__ void operator()(const f32x4 (&acc)[2][2][4][2], const Unit& u, int wr, int wc, int fr, int fq) const {
        const int row0 = u.pm * BM + wr * 64 + fr; int colt = u.pn * BM; bf16_t* base = O;
        float sc = 1.f; if (split_cols) { const int t = colt / split_cols; base += (size_t)t * split_stride; colt -= t * split_cols; if (t == 0) sc = scale0; }
        const int col0 = colt + wc * 32 + 8 * fq, bcol0 = u.pn * BM + wc * 32 + 8 * fq;
        f32x4 bv[2][2];
#pragma unroll
        for (int bj = 0; bj < 2; ++bj)
#pragma unroll
            for (int n = 0; n < 2; ++n) bv[bj][n] = bias ? *(const f32x4*)(bias + bcol0 + bj * HALF + 4 * n) : (f32x4){0.f, 0.f, 0.f, 0.f};
#pragma unroll
        for (int ai = 0; ai < 2; ++ai)
#pragma unroll
            for (int m = 0; m < 4; ++m) { bf16_t* rowp = base + (size_t)(row0 + ai * HALF + m * 16) * ldc + col0;
#pragma unroll
                for (int bj = 0; bj < 2; ++bj) { f32x4 v0 = acc[ai][bj][m][0] + bv[bj][0], v1 = acc[ai][bj][m][1] + bv[bj][1];
                    if (ACT == 1) { f32x2 a = gelu_pk((f32x2){v0[0], v0[1]}), b = gelu_pk((f32x2){v0[2], v0[3]}), c = gelu_pk((f32x2){v1[0], v1[1]}), d = gelu_pk((f32x2){v1[2], v1[3]});
                        v0 = (f32x4){a.x, a.y, b.x, b.y}; v1 = (f32x4){c.x, c.y, d.x, d.y}; }
                    v0 = v0 * sc; v1 = v1 * sc; u32x4 w; w.x = cvt_pk_bf16(v0[0], v0[1]); w.y = cvt_pk_bf16(v0[2], v0[3]); w.z = cvt_pk_bf16(v1[0], v1[1]); w.w = cvt_pk_bf16(v1[2], v1[3]);
                    *(u32x4*)(rowp + bj * HALF) = w; } }
    }
};

struct EpiSwiglu {
    static constexpr bool PERM = true, AFTER_DRAIN = false;
    bf16_t* H; int ldh;
    __device__ __forceinline__ void operator()(const f32x4 (&acc)[2][2][4][2], const Unit& u, int wr, int wc, int fr, int fq) const {
        const int row0 = u.pm * BM + wr * 64 + fr, col0 = u.pn * HALF + wc * 32 + 8 * fq;
#pragma unroll
        for (int ai = 0; ai < 2; ++ai)
#pragma unroll
            for (int m = 0; m < 4; ++m) { bf16_t* rowp = H + (size_t)(row0 + ai * HALF + m * 16) * ldh + col0;
                float hv[8];
#pragma unroll
                for (int n = 0; n < 2; ++n)
#pragma unroll
                    for (int i = 0; i < 4; ++i) { const float g = acc[ai][0][m][n][i], uu = acc[ai][1][m][n][i];
                        const float sg = g * __builtin_amdgcn_rcpf(1.0f + __builtin_amdgcn_exp2f(-1.4426950408889634f * g)); hv[4 * n + i] = sg * uu; }
                u32x4 w; w.x = cvt_pk_bf16(hv[0], hv[1]); w.y = cvt_pk_bf16(hv[2], hv[3]); w.z = cvt_pk_bf16(hv[4], hv[5]); w.w = cvt_pk_bf16(hv[6], hv[7]);
                *(u32x4*)rowp = w; }
    }
};
typedef _Float16 h16x2_t __attribute__((ext_vector_type(2)));
typedef float f32x2s_t __attribute__((ext_vector_type(2)));
__device__ __forceinline__ unsigned pk_h2(float a, float b) { f32x2s_t v = {__builtin_fminf(__builtin_fmaxf(a, -65504.f), 65504.f), __builtin_fminf(__builtin_fmaxf(b, -65504.f), 65504.f)}; h16x2_t h = __builtin_convertvector(v, h16x2_t); return __builtin_bit_cast(unsigned, h); }
__device__ __forceinline__ f32x2s_t up_h2(unsigned w) { h16x2_t h = __builtin_bit_cast(h16x2_t, w); return __builtin_convertvector(h, f32x2s_t); }
__device__ __forceinline__ f32x4 bfx4_lo(const u32x4& w) { const f32x2s_t a = up_h2(w.x), b = up_h2(w.y); return (f32x4){a.x, a.y, b.x, b.y}; }
__device__ __forceinline__ f32x4 bfx4_hi(const u32x4& w) { const f32x2s_t a = up_h2(w.z), b = up_h2(w.w); return (f32x4){a.x, a.y, b.x, b.y}; }
struct EpiResid {
    static constexpr bool PERM = true, AFTER_DRAIN = false;
    const bf16_t* base; bf16_t* out; const float* gate; int gstride; float coef;
    __device__ __forceinline__ void operator()(const f32x4 (&acc)[2][2][4][2], const Unit& u, int wr, int wc, int fr, int fq) const {
        const int row0 = u.pm * BM + wr * 64 + fr, col0 = u.pn * BM + wc * 32 + 8 * fq;
        const float* gp = gate + (size_t)((u.pm * BM) >> 13) * gstride + col0;
        f32x4 gv[2][2];
#pragma unroll
        for (int bj = 0; bj < 2; ++bj)
#pragma unroll
            for (int n = 0; n < 2; ++n) gv[bj][n] = *(const f32x4*)(gp + bj * HALF + 4 * n) * coef;
        u32x4 bwa[2][4][2];
#pragma unroll
        for (int ai = 0; ai < 2; ++ai)
#pragma unroll
            for (int m = 0; m < 4; ++m)
#pragma unroll
                for (int bj = 0; bj < 2; ++bj) bwa[ai][m][bj] = *(const u32x4*)(base + (size_t)(row0 + ai * HALF + m * 16) * 1024 + col0 + bj * HALF);
#pragma unroll
        for (int ai = 0; ai < 2; ++ai)
#pragma unroll
            for (int m = 0; m < 4; ++m) { const size_t off = (size_t)(row0 + ai * HALF + m * 16) * 1024 + col0;
#pragma unroll
                for (int bj = 0; bj < 2; ++bj) { const u32x4 bw = bwa[ai][m][bj];
                    const f32x4 v0 = bfx4_lo(bw) + gv[bj][0] * acc[ai][bj][m][0], v1 = bfx4_hi(bw) + gv[bj][1] * acc[ai][bj][m][1];
                    u32x4 w; w.x = pk_h2(v0[0], v0[1]); w.y = pk_h2(v0[2], v0[3]); w.z = pk_h2(v1[0], v1[1]); w.w = pk_h2(v1[2], v1[3]);
                    *(u32x4*)(out + off + bj * HALF) = w; } }
    }
};
struct OneUnit { int pm, pn;
    __device__ __forceinline__ bool next(int i, Unit& u) const { if (i) return false; u.pm = pm; u.pn = pn; return true; }
    __device__ __forceinline__ void a_ready(const Unit&) const {}
    __device__ __forceinline__ void done(const Unit&) const {} };
struct RmsStats {
    unsigned* xbuf;
    unsigned* cnt;
    float eps;
    __device__ __forceinline__ void run(const f32x4 (&v)[2][2][4][2], const Unit& u, int wr, int wc, int fr, int fq, PG8_LAS unsigned char* lds, int wid, int lane) const {
        PG8_LAS float* P = (PG8_LAS float*)lds;
        PG8_LAS float* S = (PG8_LAS float*)(lds + 8192);
#pragma unroll
        for (int ai = 0; ai < 2; ++ai)
#pragma unroll
            for (int m = 0; m < 4; ++m) { float q = 0.f;
#pragma unroll
                for (int bj = 0; bj < 2; ++bj)
#pragma unroll
                    for (int n = 0; n < 2; ++n) { const f32x4 x = v[ai][bj][m][n]; q += (x[0] * x[0] + x[1] * x[1]) + (x[2] * x[2] + x[3] * x[3]); }
                q = xadd<16>(q); q = xadd<32>(q);
                if (fq == 0) P[(ai * HALF + wr * 64 + m * 16 + fr) * 4 + wc] = q; }
        asm volatile("s_waitcnt lgkmcnt(0)" ::: "memory"); __builtin_amdgcn_s_barrier(); asm volatile("" ::: "memory");
        const int row = wid * 32 + (lane & 31);
        if (lane < 32) { const float s = (P[row * 4 + 0] + P[row * 4 + 1]) + (P[row * 4 + 2] + P[row * 4 + 3]);
            __hip_atomic_store(xbuf + ((size_t)(u.pm * BM + row) * 4 + u.pn), __float_as_uint(s), __ATOMIC_RELAXED, __HIP_MEMORY_SCOPE_AGENT); }
        asm volatile("s_waitcnt vmcnt(0)" ::: "memory");
        if (lane == 0) __hip_atomic_fetch_add(cnt + 64 * u.pm, 1u, __ATOMIC_RELAXED, __HIP_MEMORY_SCOPE_AGENT);
        if (wid == 0) { unsigned sp = 0;
            while ((unsigned)__builtin_amdgcn_readfirstlane(__hip_atomic_load(cnt + 64 * u.pm, __ATOMIC_RELAXED, __HIP_MEMORY_SCOPE_AGENT)) < 32u) { __builtin_amdgcn_s_sleep(2); if (++sp > (1u << 22)) break; }
            __builtin_amdgcn_fence(__ATOMIC_ACQUIRE, "agent"); }
        asm volatile("s_waitcnt vmcnt(0) lgkmcnt(0)" ::: "memory"); __builtin_amdgcn_s_barrier(); asm volatile("" ::: "memory");
        if (lane < 32) { const unsigned* slot = xbuf + (size_t)(u.pm * BM + row) * 4; float t = 0.f;
#pragma unroll
            for (int k = 0; k < 4; ++k) t += __uint_as_float(__hip_atomic_load(slot + k, __ATOMIC_RELAXED, __HIP_MEMORY_SCOPE_AGENT));
            S[row] = __builtin_amdgcn_rsqf(t * (1.0f / 1024.0f) + eps); }
        asm volatile("s_waitcnt lgkmcnt(0)" ::: "memory"); __builtin_amdgcn_s_barrier(); asm volatile("" ::: "memory");
    }
    __device__ __forceinline__ void publish(const f32x4 (&v)[2][2][4][2], const Unit& u, int wr, int wc, int fr, int fq, PG8_LAS unsigned char* lds, int wid, int lane) const {
        PG8_LAS float* P = (PG8_LAS float*)lds;
#pragma unroll
        for (int ai = 0; ai < 2; ++ai)
#pragma unroll
            for (int m = 0; m < 4; ++m) { float q = 0.f;
#pragma unroll
                for (int bj = 0; bj < 2; ++bj)
#pragma unroll
                    for (int n = 0; n < 2; ++n) { const f32x4 x = v[ai][bj][m][n]; q += (x[0] * x[0] + x[1] * x[1]) + (x[2] * x[2] + x[3] * x[3]); }
                q = xadd<16>(q); q = xadd<32>(q);
                if (fq == 0) P[(ai * HALF + wr * 64 + m * 16 + fr) * 4 + wc] = q; }
        asm volatile("s_waitcnt lgkmcnt(0)" ::: "memory"); __builtin_amdgcn_s_barrier(); asm volatile("" ::: "memory");
        const int row = wid * 32 + (lane & 31);
        if (lane < 32) { const float s = (P[row * 4 + 0] + P[row * 4 + 1]) + (P[row * 4 + 2] + P[row * 4 + 3]);
            __hip_atomic_store(xbuf + ((size_t)(u.pm * BM + row) * 4 + u.pn), __float_as_uint(s), __ATOMIC_RELAXED, __HIP_MEMORY_SCOPE_AGENT); }
        asm volatile("s_waitcnt vmcnt(0)" ::: "memory");
        if (lane == 0) __hip_atomic_fetch_add(cnt + 64 * u.pm, 1u, __ATOMIC_RELAXED, __HIP_MEMORY_SCOPE_AGENT);
    }
    __device__ __forceinline__ void collect(const Unit& u, PG8_LAS unsigned char* lds, int wid, int lane) const {
        PG8_LAS float* S = (PG8_LAS float*)(lds + 8192);
        const int row = wid * 32 + (lane & 31);
        if (wid == 0) { unsigned sp = 0;
            while ((unsigned)__builtin_amdgcn_readfirstlane(__hip_atomic_load(cnt + 64 * u.pm, __ATOMIC_RELAXED, __HIP_MEMORY_SCOPE_AGENT)) < 32u) { __builtin_amdgcn_s_sleep(2); if (++sp > (1u << 22)) break; }
            __builtin_amdgcn_fence(__ATOMIC_ACQUIRE, "agent"); }
        asm volatile("s_waitcnt lgkmcnt(0)" ::: "memory"); __builtin_amdgcn_s_barrier(); asm volatile("" ::: "memory");
        if (lane < 32) { const unsigned* slot = xbuf + (size_t)(u.pm * BM + row) * 4; float t = 0.f;
#pragma unroll
            for (int k = 0; k < 4; ++k) t += __uint_as_float(__hip_atomic_load(slot + k, __ATOMIC_RELAXED, __HIP_MEMORY_SCOPE_AGENT));
            S[row] = __builtin_amdgcn_rsqf(t * (1.0f / 1024.0f) + eps); }
        asm volatile("s_waitcnt lgkmcnt(0)" ::: "memory"); __builtin_amdgcn_s_barrier(); asm volatile("" ::: "memory");
    }
};
template <bool BASE_H, bool FIN> struct EpiResidNorm {
    static constexpr bool PERM = true, AFTER_DRAIN = false;
    const void* base; bf16_t* outb; float* outf; const float* gate; int gstride; float coef;
    const float* ng; const float* shift; const float* scale; int mstride; bf16_t* xn; RmsStats st; PG8_LAS unsigned char* tabs;
    __device__ __forceinline__ void operator()(const f32x4 (&acc_c)[2][2][4][2], const Unit& u, int wr, int wc, int fr, int fq) const {
        f32x4 (&acc)[2][2][4][2] = const_cast<f32x4 (&)[2][2][4][2]>(acc_c);
        asm volatile("" : "+v"(fr), "+v"(fq));
        PG8_LAS unsigned char* lds = tabs; const int wid = wr * 4 + wc, lane = fq * 16 + fr;
        const int row0 = u.pm * BM + wr * 64 + fr, col0 = u.pn * BM + wc * 32 + 8 * fq, b = (u.pm * BM) >> 13;
        {   const float* gp = gate + (size_t)b * gstride + col0;
            f32x4 gv[2][2];
#pragma unroll
            for (int bj = 0; bj < 2; ++bj)
#pragma unroll
                for (int n = 0; n < 2; ++n) gv[bj][n] = *(const f32x4*)(gp + bj * HALF + 4 * n) * coef;
            if constexpr (BASE_H) {
                u32x4 bw[2][4][2];
#pragma unroll
                for (int ai = 0; ai < 2; ++ai)
#pragma unroll
                    for (int m = 0; m < 4; ++m)
#pragma unroll
                        for (int bj = 0; bj < 2; ++bj) bw[ai][m][bj] = *(const u32x4*)((const bf16_t*)base + (size_t)(row0 + ai * HALF + m * 16) * 1024 + col0 + bj * HALF);
#pragma unroll
                for (int ai = 0; ai < 2; ++ai)
#pragma unroll
                    for (int m = 0; m < 4; ++m) { const size_t off = (size_t)(row0 + ai * HALF + m * 16) * 1024 + col0;
#pragma unroll
                        for (int bj = 0; bj < 2; ++bj) {
                            acc[ai][bj][m][0] = bfx4_lo(bw[ai][m][bj]) + gv[bj][0] * acc[ai][bj][m][0]; acc[ai][bj][m][1] = bfx4_hi(bw[ai][m][bj]) + gv[bj][1] * acc[ai][bj][m][1];
                        } }
            } else {
#pragma unroll
                for (int ai = 0; ai < 2; ++ai)
#pragma unroll
                    for (int mp = 0; mp < 2; ++mp) { f32x4 bf[2][2][2];
#pragma unroll
                        for (int mm = 0; mm < 2; ++mm)
#pragma unroll
                            for (int bj = 0; bj < 2; ++bj)
#pragma unroll
                                for (int n = 0; n < 2; ++n) bf[mm][bj][n] = *(const f32x4*)((const float*)base + (size_t)(row0 + ai * HALF + (2 * mp + mm) * 16) * 1024 + col0 + bj * HALF + 4 * n);
#pragma unroll
                        for (int mm = 0; mm < 2; ++mm) { const int m = 2 * mp + mm; const size_t off = (size_t)(row0 + ai * HALF + m * 16) * 1024 + col0;
#pragma unroll
                            for (int bj = 0; bj < 2; ++bj) {
                                acc[ai][bj][m][0] = bf[mm][bj][0] + gv[bj][0] * acc[ai][bj][m][0]; acc[ai][bj][m][1] = bf[mm][bj][1] + gv[bj][1] * acc[ai][bj][m][1];
                                if constexpr (!FIN) { const f32x4 v0 = acc[ai][bj][m][0], v1 = acc[ai][bj][m][1];
                                    u32x4 w; w.x = pk_h2(v0[0], v0[1]); w.y = pk_h2(v0[2], v0[3]); w.z = pk_h2(v1[0], v1[1]); w.w = pk_h2(v1[2], v1[3]);
                                    *(u32x4*)(outb + off + bj * HALF) = w; } } }
                        asm volatile("" ::: "memory"); }
            } }
        if constexpr (BASE_H) {
            st.publish(acc, u, wr, wc, fr, fq, lds, wid, lane);
            if constexpr (!FIN) {
#pragma unroll
                for (int ai = 0; ai < 2; ++ai)
#pragma unroll
                    for (int m = 0; m < 4; ++m) { const size_t off = (size_t)(row0 + ai * HALF + m * 16) * 1024 + col0;
#pragma unroll
                        for (int bj = 0; bj < 2; ++bj) { const f32x4 v0 = acc[ai][bj][m][0], v1 = acc[ai][bj][m][1];
                            u32x4 w; w.x = pk_h2(v0[0], v0[1]); w.y = pk_h2(v0[2], v0[3]); w.z = pk_h2(v1[0], v1[1]); w.w = pk_h2(v1[2], v1[3]);
                            *(u32x4*)(outb + off + bj * HALF) = w; } } }
            st.collect(u, lds, wid, lane);
        } else st.run(acc, u, wr, wc, fr, fq, lds, wid, lane);
        const PG8_LAS float* S = (const PG8_LAS float*)(lds + 8192);
        f32x4 gm[2][2], sh[2][2];
#pragma unroll
        for (int bj = 0; bj < 2; ++bj)
#pragma unroll
            for (int n = 0; n < 2; ++n) { const int c = col0 + bj * HALF + 4 * n; const f32x4 g = *(const f32x4*)(ng + c);
                if constexpr (FIN) { gm[bj][n] = g; sh[bj][n] = (f32x4){0.f, 0.f, 0.f, 0.f}; }
                else { gm[bj][n] = g * (*(const f32x4*)(scale + (size_t)b * mstride + c) + 1.0f); sh[bj][n] = *(const f32x4*)(shift + (size_t)b * mstride + c); } }
#pragma unroll
        for (int ai = 0; ai < 2; ++ai)
#pragma unroll
            for (int m = 0; m < 4; ++m) { const int r = ai * HALF + wr * 64 + m * 16 + fr; const float rs = S[r]; const size_t off = (size_t)(u.pm * BM + r) * 1024 + col0;
                if constexpr (FIN) {
#pragma unroll
                    for (int bj = 0; bj < 2; ++bj)
#pragma unroll
                        for (int n = 0; n < 2; ++n) *(f32x4*)(outf + off + bj * HALF + 4 * n) = acc[ai][bj][m][n] * rs * gm[bj][n];
                } else {
#pragma unroll
                    for (int bj = 0; bj < 2; ++bj) { const f32x4 v0 = acc[ai][bj][m][0] * rs * gm[bj][0] + sh[bj][0], v1 = acc[ai][bj][m][1] * rs * gm[bj][1] + sh[bj][1];
                        u32x4 w; w.x = cvt_pk_bf16(v0[0], v0[1]); w.y = cvt_pk_bf16(v0[2], v0[3]); w.z = cvt_pk_bf16(v1[0], v1[1]); w.w = cvt_pk_bf16(v1[2], v1[3]);
                        *(u32x4*)(xn + off + bj * HALF) = w; } } }
    }
};
template <class Epi, class Sched, bool ALIGN_EPI = false, bool SP2 = false>
__device__ __forceinline__ void gemm_phase(PG8_LAS unsigned char* lds, const Gemm g, const Sched& S, const Epi& E, const int tid_in) {
    int tid = tid_in; asm volatile("" : "+v"(tid));
    const int wid = __builtin_amdgcn_readfirstlane(tid >> 6), lane = tid & 63, wr = wid >> 2, wc = wid & 3, fr = lane & 15, fq = lane >> 4;
    const int K = g.K, nt = K / BK;
    unsigned voffA[2], voffB[2];
#pragma unroll
    for (int i = 0; i < 2; ++i) { int R, C; stage_rc(tid * 16 + i * 8192, R, C); const int Rb = Epi::PERM ? ((R & ~31) + perm32(R & 31)) : R;
        voffA[i] = (unsigned)(R * K + C) * 2u; voffB[i] = (unsigned)(Rb * K + C) * 2u; }
    const size_t kstep = (size_t)(BK * 2);
    const size_t hstep = (size_t)HALF * K * 2;
    const size_t tstep = 2 * hstep;
    const unsigned ldsw = (unsigned)wid * 1024u;
    const int aoff = lds_byte(wr * 64 + fr, fq * 8), boff = lds_byte(wc * 32 + fr, fq * 8);
#define PG8_SA(b, h) (((b) * 2 + (h)) * HTB)
#define PG8_SB(b, h) ((4 + (b) * 2 + (h)) * HTB)
#define PG8_STAGE(bufoff, gbase, voff) do { _Pragma("unroll") for (int _i = 0; _i < 2; ++_i) \
        __builtin_amdgcn_global_load_lds((const unsigned*)((const char*)(gbase) + (voff)[_i]), (PG8_LAS unsigned*)(lds + (bufoff) + ldsw + _i * 8192), 16, 0, 0); } while (0)
#define PG8_LDA(dst, b, h) do { _Pragma("unroll") for (int m = 0; m < 4; ++m) _Pragma("unroll") for (int k = 0; k < 2; ++k) dst[m][k] = *(const PG8_LAS bf16x8*)(lds + PG8_SA(b, h) + aoff + m * 2048 + k * 1024); } while (0)
#define PG8_LDB(dst, b, h) do { _Pragma("unroll") for (int n = 0; n < 2; ++n) _Pragma("unroll") for (int k = 0; k < 2; ++k) dst[n][k] = *(const PG8_LAS bf16x8*)(lds + PG8_SB(b, h) + boff + n * 2048 + k * 1024); } while (0)
#define PG8_MMA(ai, bj, At, Bt) do { __builtin_amdgcn_s_setprio(1); _Pragma("unroll") for (int m = 0; m < 4; ++m) _Pragma("unroll") for (int n = 0; n < 2; ++n) _Pragma("unroll") for (int k = 0; k < 2; ++k) \
        acc[ai][bj][m][n] = __builtin_amdgcn_mfma_f32_16x16x32_bf16(Bt[n][k], At[m][k], acc[ai][bj][m][n], 0, 0, 0); __builtin_amdgcn_s_setprio(0); } while (0)
#define PG8_WAIT_V(n) asm volatile("s_waitcnt vmcnt(" #n ")" ::: "memory")
#define PG8_WAIT_L(n) asm volatile("s_waitcnt lgkmcnt(" #n ")" ::: "memory")
#define PG8_BAR __builtin_amdgcn_s_barrier()
#define PG8_SCHED __builtin_amdgcn_sched_barrier(0)
    Unit cur, nxt; int ui = 0;
    if (!S.next(0, cur)) return;
    f32x4 acc[2][2][4][2];
#pragma unroll
    for (int a = 0; a < 2; ++a)
#pragma unroll
        for (int b = 0; b < 2; ++b)
#pragma unroll
            for (int m = 0; m < 4; ++m)
#pragma unroll
                for (int n = 0; n < 2; ++n) acc[a][b][m][n] = (f32x4){0.f, 0.f, 0.f, 0.f};
    bf16x8 At[4][2], B0[2][2], B1[2][2];
    const char* cA = (const char*)g.A + (size_t)cur.pm * tstep; const char* cB = (const char*)g.Bt + (size_t)cur.pn * tstep;
    S.a_ready(cur);
    if constexpr (SP2) {
        PG8_STAGE(PG8_SB(0, 0), cB, voffB); PG8_STAGE(PG8_SB(0, 1), cB + hstep, voffB); PG8_STAGE(PG8_SA(0, 0), cA, voffA); PG8_STAGE(PG8_SA(0, 1), cA + hstep, voffA);
        if (wr == 1) PG8_BAR;
        PG8_WAIT_V(2); PG8_BAR;
        PG8_STAGE(PG8_SB(1, 0), cB + kstep, voffB); PG8_STAGE(PG8_SA(1, 0), cA + kstep, voffA); PG8_STAGE(PG8_SB(1, 1), cB + hstep + kstep, voffB);
        PG8_WAIT_V(6); PG8_BAR;
    } else {
        PG8_STAGE(PG8_SB(0, 0), cB, voffB); PG8_STAGE(PG8_SA(0, 0), cA, voffA); PG8_STAGE(PG8_SB(0, 1), cB + hstep, voffB); PG8_STAGE(PG8_SA(0, 1), cA + hstep, voffA);
        if (wr == 1) PG8_BAR;
        PG8_WAIT_V(4); PG8_BAR;
        PG8_STAGE(PG8_SB(1, 0), cB + kstep, voffB); PG8_STAGE(PG8_SA(1, 0), cA + kstep, voffA); PG8_STAGE(PG8_SB(1, 1), cB + hstep + kstep, voffB);
        PG8_WAIT_V(6); PG8_BAR;
    }
    for (;;) {
        const bool has_next = S.next(ui + 1, nxt);
        const char* nA = has_next ? (const char*)g.A + (size_t)nxt.pm * tstep : cA; const char* nB = has_next ? (const char*)g.Bt + (size_t)nxt.pn * tstep : cB;
        for (int t = 0; t < nt; t += 2) {
            const bool last = (t == nt - 2);
            const char* a1 = cA + (size_t)(t + 1) * kstep;
            const char* a2 = last ? nA : cA + (size_t)(t + 2) * kstep; const char* b2 = last ? nB : cB + (size_t)(t + 2) * kstep;
            const char* a3 = a2 + kstep; const char* b3 = b2 + kstep;
            if (last && has_next) S.a_ready(nxt);
            if constexpr (SP2) {
            PG8_LDB(B0, 0, 0); PG8_LDB(B1, 0, 1); PG8_SCHED; PG8_LDA(At, 0, 0); PG8_STAGE(PG8_SA(1, 1), a1 + hstep, voffA);
            PG8_WAIT_V(8); PG8_WAIT_L(0); PG8_BAR; PG8_MMA(0, 0, At, B0); PG8_MMA(0, 1, At, B1); PG8_BAR; PG8_SCHED;
            PG8_LDA(At, 0, 1); PG8_STAGE(PG8_SB(0, 0), b2, voffB); PG8_STAGE(PG8_SB(0, 1), b2 + hstep, voffB); PG8_STAGE(PG8_SA(0, 0), a2, voffA);
            PG8_WAIT_V(8); PG8_WAIT_L(0); PG8_BAR; PG8_MMA(1, 0, At, B0); PG8_MMA(1, 1, At, B1); PG8_BAR; PG8_SCHED;
            PG8_LDB(B0, 1, 0); PG8_LDB(B1, 1, 1); PG8_SCHED; PG8_LDA(At, 1, 0); PG8_STAGE(PG8_SA(0, 1), a2 + hstep, voffA);
            PG8_WAIT_V(8); PG8_WAIT_L(0); PG8_BAR; PG8_MMA(0, 0, At, B0); PG8_MMA(0, 1, At, B1); PG8_BAR; PG8_SCHED;
            PG8_LDA(At, 1, 1); PG8_STAGE(PG8_SB(1, 0), b3, voffB); PG8_STAGE(PG8_SB(1, 1), b3 + hstep, voffB); PG8_STAGE(PG8_SA(1, 0), a3, voffA);
            PG8_WAIT_V(8); PG8_WAIT_L(0); PG8_BAR; PG8_MMA(1, 0, At, B0); PG8_MMA(1, 1, At, B1); PG8_BAR; PG8_SCHED;
            } else {
            PG8_LDB(B0, 0, 0); PG8_SCHED; PG8_LDA(At, 0, 0); PG8_STAGE(PG8_SA(1, 1), a1 + hstep, voffA);
            PG8_WAIT_L(8); PG8_BAR; PG8_WAIT_L(0); PG8_MMA(0, 0, At, B0); PG8_BAR; PG8_SCHED;
            PG8_LDB(B1, 0, 1); PG8_STAGE(PG8_SB(0, 0), b2, voffB);
            PG8_BAR; PG8_WAIT_L(0); PG8_MMA(0, 1, At, B1); PG8_BAR;
            PG8_LDA(At, 0, 1); PG8_STAGE(PG8_SA(0, 0), a2, voffA);
            PG8_BAR; PG8_WAIT_L(0); PG8_MMA(1, 0, At, B0); PG8_BAR; PG8_SCHED;
            PG8_STAGE(PG8_SB(0, 1), b2 + hstep, voffB);
            PG8_WAIT_V(6); PG8_BAR; PG8_MMA(1, 1, At, B1); PG8_BAR;
            PG8_LDB(B0, 1, 0); PG8_SCHED; PG8_LDA(At, 1, 0); PG8_STAGE(PG8_SA(0, 1), a2 + hstep, voffA);
            PG8_WAIT_L(8); PG8_BAR; PG8_WAIT_L(0); PG8_MMA(0, 0, At, B0); PG8_BAR; PG8_SCHED;
            PG8_LDB(B1, 1, 1); PG8_STAGE(PG8_SB(1, 0), b3, voffB);
            PG8_BAR; PG8_WAIT_L(0); PG8_MMA(0, 1, At, B1); PG8_BAR;
            PG8_LDA(At, 1, 1); PG8_STAGE(PG8_SA(1, 0), a3, voffA);
            PG8_BAR; PG8_WAIT_L(0); PG8_MMA(1, 0, At, B0); PG8_BAR; PG8_SCHED;
            PG8_STAGE(PG8_SB(1, 1), b3 + hstep, voffB);
            PG8_WAIT_V(6); PG8_BAR; PG8_MMA(1, 1, At, B1); PG8_BAR;
            }
        }
        if constexpr (ALIGN_EPI) { if (wr == 0) PG8_BAR; }
        if constexpr (!Epi::AFTER_DRAIN) { E(acc, cur, wr, wc, fr, fq); S.done(cur); }
        if (!has_next) break;
#pragma unroll
        for (int a = 0; a < 2; ++a)
#pragma unroll
            for (int b = 0; b < 2; ++b)
#pragma unroll
                for (int m = 0; m < 4; ++m)
#pragma unroll
                    for (int n = 0; n < 2; ++n) acc[a][b][m][n] = (f32x4){0.f, 0.f, 0.f, 0.f};
        cur = nxt; cA = nA; cB = nB; ++ui;
        if constexpr (ALIGN_EPI) { if (wr == 1) PG8_BAR; }
    }
    PG8_WAIT_V(0);
    if constexpr (!ALIGN_EPI) { if (wr == 0) PG8_BAR; }
    PG8_BAR;
    if constexpr (Epi::AFTER_DRAIN) { E.fused(acc, cur, wr, wc, fr, fq, lds, wid, lane); S.done(cur); }
#undef PG8_SA
#undef PG8_SB
#undef PG8_STAGE
#undef PG8_LDA
#undef PG8_LDB
#undef PG8_MMA
#undef PG8_WAIT_V
#undef PG8_WAIT_L
#undef PG8_BAR
#undef PG8_SCHED
}
}

#ifndef PG8_SP2
#define PG8_SP2 true
#endif
#ifndef PG8_ALIGN
#define PG8_ALIGN true
#endif
#include <hip/hip_bf16.h>
#include <cmath>
namespace attn_body {
using bf16=__hip_bfloat16;
using bf16x8=__attribute__((ext_vector_type(8)))short;
using s16x4=__attribute__((ext_vector_type(4)))short;
using f32x16=__attribute__((ext_vector_type(16)))float;
using u32x4=__attribute__((ext_vector_type(4)))unsigned;
constexpr int BATCH=4,NHEAD=16,SEQ=8192,D=64,DM=NHEAD*D;
constexpr int NW=8,QBLK=32,QB=QBLK*NW,KVBLK=64,NQB=SEQ/QB;
constexpr int ATTN_PITCH=DM, ATTN_UNIT_ROWS=QB;
__device__ __forceinline__ int crow(int r,int hi){return (r&3)+8*(r>>2)+4*hi;}
#define SBAR() __builtin_amdgcn_sched_barrier(0)
__device__ __forceinline__ void cmask(f32x16&p0,f32x16&p1,int jb,int qrel,int hi){
  const float NEG=-INFINITY; int kb=64*jb+4*hi;
  #pragma unroll
  for(int r=0;r<16;++r){int kv=kb+(r&3)+8*(r>>2); if(kv>qrel)p0[r]=NEG; if(kv+32>qrel)p1[r]=NEG;}
}


typedef float f32x4v __attribute__((ext_vector_type(4)));
#define ALAS __attribute__((address_space(3)))
__device__ __forceinline__ void biasmask(f32x16&p0,f32x16&p1,int jb,int qrel,int hi,const ALAS float*tab){
  const int nb=qrel-64*jb-4*hi;
  #pragma unroll
  for(int r=0;r<16;++r){ const int n0=nb-((r&3)+8*(r>>2)); int i0=n0<-1?-1:n0; i0=(i0>128?128:i0)+1; int i1=n0-32; i1=i1<-1?-1:i1; i1=(i1>128?128:i1)+1; p0[r]+=tab[i0]; p1[r]+=tab[i1]; }
}
constexpr int NSLOT=3, SLOTB=8192;
constexpr int LDS_K=0, LDS_V=NSLOT*SLOTB, LDS_WS=2*NSLOT*SLOTB, LDS_OST=LDS_WS+NW*64*4, LDS_BYTES=LDS_OST+NW*4096;
constexpr float C2=0.125f*1.4426950408889634f;
__device__ __forceinline__ void glds16(const void*gsrc,unsigned lds_dst){unsigned keep;
  asm volatile("s_mov_b32 %0, m0\n\ts_mov_b32 m0, %2\n\ts_nop 0\n\tglobal_load_lds_dwordx4 %1, off\n\ts_mov_b32 m0, %0":"=&s"(keep):"v"(gsrc),"s"(lds_dst):"memory");}
__device__ __forceinline__ float max3f(float a,float b,float c){float r;asm("v_max3_f32 %0, %1, %2, %3":"=v"(r):"v"(a),"v"(b),"v"(c));return r;}
__device__ __forceinline__ float max2f(float a,float b){float r;asm("v_max_f32_e32 %0, %1, %2":"=v"(r):"v"(a),"v"(b));return r;}
__device__ __forceinline__ float fadd_s(float a,float b){float r;asm("v_add_f32_e32 %0, %1, %2":"=v"(r):"v"(a),"v"(b));return r;}
__device__ __forceinline__ float fsub_s(float a,float b){float r;asm("v_sub_f32_e32 %0, %1, %2":"=v"(r):"v"(a),"v"(b));return r;}
typedef float f32x2_t __attribute__((ext_vector_type(2))); typedef __bf16 bf16x2_t __attribute__((ext_vector_type(2)));
__device__ __forceinline__ unsigned cvtpk_s(float lo,float hi){f32x2_t v={lo,hi};bf16x2_t b=__builtin_convertvector(v,bf16x2_t);return __builtin_bit_cast(unsigned,b);}
#define WAIT_BAR(N) asm volatile("s_waitcnt vmcnt(" #N ") lgkmcnt(0)\n\ts_barrier":::"memory")

__device__ __forceinline__ void qkt(f32x16&p0,f32x16&p1,const char*Kslot,const bf16x8*qr,const f32x16&negm,int r32,int hi){
  const char*kb=Kslot+hi*1024+r32*16;
  #pragma unroll
  for(int d0=0;d0<4;++d0){
    const bf16x8 b0=*reinterpret_cast<const bf16x8*>(kb+d0*2048);
    const bf16x8 b1=*reinterpret_cast<const bf16x8*>(kb+d0*2048+512);
    if(d0==0){p0=__builtin_amdgcn_mfma_f32_32x32x16_bf16(b0,qr[0],negm,0,0,0);p1=__builtin_amdgcn_mfma_f32_32x32x16_bf16(b1,qr[0],negm,0,0,0);}
    else{p0=__builtin_amdgcn_mfma_f32_32x32x16_bf16(b0,qr[d0],p0,0,0,0);p1=__builtin_amdgcn_mfma_f32_32x32x16_bf16(b1,qr[d0],p1,0,0,0);}}
}
typedef __attribute__((address_space(3))) const char* lds_cptr;
typedef short v4i16_t __attribute__((ext_vector_type(4)));
__device__ __forceinline__ void kload8(bf16x8*kf,lds_cptr kp){
  kf[0]=*(const __attribute__((address_space(3))) bf16x8*)(kp);      kf[1]=*(const __attribute__((address_space(3))) bf16x8*)(kp+512);
  kf[2]=*(const __attribute__((address_space(3))) bf16x8*)(kp+2048); kf[3]=*(const __attribute__((address_space(3))) bf16x8*)(kp+2560);
  kf[4]=*(const __attribute__((address_space(3))) bf16x8*)(kp+4096); kf[5]=*(const __attribute__((address_space(3))) bf16x8*)(kp+4608);
  kf[6]=*(const __attribute__((address_space(3))) bf16x8*)(kp+6144); kf[7]=*(const __attribute__((address_space(3))) bf16x8*)(kp+6656);
}
__device__ __forceinline__ void kload2(bf16x8*kf,lds_cptr kp,int j){ kf[2*j]=*(const __attribute__((address_space(3))) bf16x8*)(kp+j*2048); kf[2*j+1]=*(const __attribute__((address_space(3))) bf16x8*)(kp+j*2048+512); }
__device__ __forceinline__ s16x4 vtr(lds_cptr p){ return __builtin_bit_cast(s16x4,__builtin_amdgcn_ds_read_tr16_b64_v4i16((__attribute__((address_space(3))) v4i16_t*)p)); }
__device__ __forceinline__ float rowmax(const f32x16&p0,const f32x16&p1){
  float a=max3f(p0[0],p0[1],p1[0]),b=max3f(p0[2],p0[3],p1[1]);a=max3f(a,p1[2],p1[3]);
  #pragma unroll
  for(int r=4;r<16;r+=4){a=max3f(a,p0[r],p0[r+1]);b=max3f(b,p0[r+2],p0[r+3]);a=max3f(a,p1[r],p1[r+1]);b=max3f(b,p1[r+2],p1[r+3]);}
  const float m=max2f(a,b);
  auto rr=__builtin_amdgcn_permlane32_swap(__float_as_uint(m),__float_as_uint(m),false,false);
  return max2f(__uint_as_float(rr[0]),__uint_as_float(rr[1]));
}
__device__ __forceinline__ void pv(f32x16*o,int vb,bf16x8 pa0,bf16x8 pa1,bf16x8 pa2,bf16x8 pa3){
  #pragma unroll
  for(int d0=0;d0<2;++d0){s16x4 lo[4],hi[4];
    #pragma unroll
    for(int ks=0;ks<4;++ks){
      asm volatile("ds_read_b64_tr_b16 %0,%1 offset:%c2":"=&v"(lo[ks]):"v"(vb),"i"(d0*4096+ks*1024):"memory");
      asm volatile("ds_read_b64_tr_b16 %0,%1 offset:%c2":"=&v"(hi[ks]):"v"(vb),"i"(d0*4096+ks*1024+512):"memory");}
    asm volatile("s_waitcnt lgkmcnt(0)":::"memory");SBAR();
    #define PK(k) (bf16x8){lo[k][0],lo[k][1],lo[k][2],lo[k][3],hi[k][0],hi[k][1],hi[k][2],hi[k][3]}
    o[d0]=__builtin_amdgcn_mfma_f32_32x32x16_bf16(pa0,PK(0),o[d0],0,0,0);
    o[d0]=__builtin_amdgcn_mfma_f32_32x32x16_bf16(pa1,PK(1),o[d0],0,0,0);
    o[d0]=__builtin_amdgcn_mfma_f32_32x32x16_bf16(pa2,PK(2),o[d0],0,0,0);
    o[d0]=__builtin_amdgcn_mfma_f32_32x32x16_bf16(pa3,PK(3),o[d0],0,0,0);
    #undef PK
  }
}

#ifndef ATTN_STORE16
#define ATTN_STORE16(p,v) (*(u32x4*)(p)=(v))
#endif
template<int THRL,int MODE> __device__ __forceinline__ void attn_unit(int b,int qc,int kc,int vc,int oc,int qb,const bf16*Q,const bf16*__restrict__ K,const bf16*__restrict__ V,bf16*O,char*shm,const float*aux,int hidx,const float*kpart,int npart,const int tid_in){
  int tid=tid_in; asm volatile("":"+v"(tid));
  const int lane=tid&63,r32=lane&31,hi=lane>>5; const int wid=__builtin_amdgcn_readfirstlane(tid>>6);
  const long rowbase=(long)b*SEQ; const int q0=qb*QB;
  const bf16*Qw=Q+(rowbase+q0+wid*QBLK)*DM+qc;
  const bf16*Kh=K+rowbase*DM+kc; const bf16*Vh=V+rowbase*DM+vc;
  const unsigned lds0=(unsigned)(uintptr_t)shm;
  float*wsf=(float*)(shm+LDS_WS)+wid*64;
  int tskip=0; float mfix=0.f;
  if(MODE==1){
    bf16x8 qv[4];
    #pragma unroll
    for(int d0=0;d0<4;++d0) qv[d0]=*reinterpret_cast<const bf16x8*>(&Qw[(long)r32*DM+d0*16+hi*8]);
    bf16x8 kvd[4];
    #pragma unroll
    for(int d0=0;d0<4;++d0) kvd[d0]=*reinterpret_cast<const bf16x8*>(&Kh[(long)(q0+wid*QBLK+r32)*DM+d0*16+hi*8]);
    float kmv[4];
    #pragma unroll
    for(int j=0;j<4;++j){ const int i=lane+64*j; kmv[j]=(i<npart)?kpart[(long)i*64]:0.f; }
    const int NT0=(q0+QB)/KVBLK;
    const float a_row=aux[q0+wid*QBLK+r32], a_t0=aux[64*lane+63], a_t1=aux[64*(lane+64)+63];
    const int n4=(q0+QB)>>2; f32x4v tv[4];
    #pragma unroll
    for(int j=0;j<4;++j){ const int i=tid+512*j; if(i<n4) tv[j]=((const f32x4v*)aux)[i]; }
    float km=fmaxf(fmaxf(kmv[0],kmv[1]),fmaxf(kmv[2],kmv[3]));
    for(int i=lane+256;i<npart;i+=64) km=fmaxf(km,kpart[(long)i*64]);
    float ss=0.f,sd=0.f;
    #pragma unroll
    for(int d0=0;d0<4;++d0){
      #pragma unroll
      for(int e=0;e<8;++e){ const float f=__uint_as_float(((unsigned)(unsigned short)qv[d0][e])<<16), g=__uint_as_float(((unsigned)(unsigned short)kvd[d0][e])<<16); ss+=f*f; sd+=f*g; } }
    { auto rr=__builtin_amdgcn_permlane32_swap(__float_as_uint(ss),__float_as_uint(ss),false,false); ss=__uint_as_float(rr[0])+__uint_as_float(rr[1]); }
    { auto rr=__builtin_amdgcn_permlane32_swap(__float_as_uint(sd),__float_as_uint(sd),false,false); sd=__uint_as_float(rr[0])+__uint_as_float(rr[1]); }
    const float dneg=wave_max32(-(sd+a_row));
    const float ssrow=ss;
    ss=wave_max32(ss);
    km=wave_max64(km);
    ALAS float*wsl=(ALAS float*)((__attribute__((address_space(3))) char*)shm+LDS_WS);
    if(lane==0){wsl[wid*64]=ss; wsl[wid*64+1]=dneg;}
    { ALAS f32x4v*tabw=(ALAS f32x4v*)((__attribute__((address_space(3))) char*)shm+LDS_BYTES);
      #pragma unroll
      for(int j=0;j<4;++j){ const int i=tid+512*j; if(i<n4) tabw[i]=tv[j]; } }
    asm volatile("s_waitcnt lgkmcnt(0)\n\ts_barrier":::"memory");
    float qm=wsl[0],dn=wsl[1];
    #pragma unroll
    for(int w=1;w<NW;++w){qm=fmaxf(qm,wsl[w*64]);dn=fmaxf(dn,wsl[w*64+1]);}
    const float smax1=__builtin_amdgcn_sqrtf(qm*km)*1.01f+1.f;
    constexpr float SKIP_T=64.f;
    const float thr=-dn-SKIP_T-smax1;
    mfix=a_row+(__builtin_amdgcn_sqrtf(ssrow*km)*1.01f+1.f);
    const bool sk0=(lane<NT0-6)&&(a_t0<thr);
    const bool sk1=(lane+64<NT0-6)&&(a_t1<thr);
    const unsigned long long m0=~__ballot(sk0), m1=~__ballot(sk1);
    const int nlead=m0?__builtin_ctzll(m0):64+(m1?__builtin_ctzll(m1):64);
    tskip=__builtin_amdgcn_readfirstlane(nlead&~1);
    Kh+=(long)tskip*KVBLK*DM; Vh+=(long)tskip*KVBLK*DM;
  }
  const bf16*ksrc=Kh+(long)lane*DM+wid*8;
  const bf16*vsrc=Vh+(long)(16*(wid&3)+(lane>>2))*DM+(wid>>2)*32+(lane&3)*8;
  const unsigned kdst=lds0+LDS_K+wid*1024, vdst=lds0+LDS_V+wid*1024;
  #define DMA_K(t,slot) glds16(ksrc+(long)(t)*KVBLK*DM,(unsigned)__builtin_amdgcn_readfirstlane(kdst+(slot)))
  #define DMA_V(t,slot) glds16(vsrc+(long)(t)*KVBLK*DM,(unsigned)__builtin_amdgcn_readfirstlane(vdst+(slot)))
  const int vb0=(int)(lds0+LDS_V)+((lane>>4)&1)*32+(lane&3)*8+(4*hi+((lane&15)>>2))*64;
  const char*Kbase=shm+LDS_K; bf16x8 kf[8];
  const lds_cptr shm3=(lds_cptr)shm; const lds_cptr kp0=shm3+LDS_K+hi*1024+r32*16; const lds_cptr vp0=shm3+LDS_V+((lane>>4)&1)*32+(lane&3)*8+(4*hi+((lane&15)>>2))*64;
  const int NT=(q0+QB)/KVBLK-tskip;
  const ALAS float*tab3=(const ALAS float*)(shm3+LDS_BYTES);
  { ALAS float*tabf=(ALAS float*)(shm3+LDS_BYTES);
    if(MODE==0){ if(tid<130){ float v; if(tid==0)v=-INFINITY; else if(tid==129)v=0.f; else{ const int n=tid-1; int bk; if(n<16)bk=n; else{ const int lg=16+(int)(__builtin_amdgcn_logf((float)n*0.0625f)*(16.0f/3.0f));     bk=lg<31?lg:31; } v=(aux[bk*8+hidx]-aux[31*8+hidx])*1.4426950408889634f; } tabf[tid]=v; } }
    asm volatile("s_waitcnt vmcnt(0) lgkmcnt(0)":::"memory"); }
  DMA_K(0,0);DMA_V(0,0);DMA_K(1,SLOTB);
  bf16x8 qr[4];
  #pragma unroll
  for(int d0=0;d0<4;++d0)qr[d0]=*reinterpret_cast<const bf16x8*>(&Qw[(long)r32*DM+d0*16+hi*8]);
  float mhat=(MODE==1)?mfix:0.f,l_reg=0.f;f32x16 o[2];o[0]=f32x16{};o[1]=f32x16{};f32x16 negm=f32x16{};asm volatile("":"+v"(negm));
  const f32x16 zero16=f32x16{};
  #define CIN ((MODE==1)?zero16:negm)
  const int qrel=wid*QBLK+r32;
  #define CMASK(P0,P1,t) do{int jb_=(t)-(NT-4); if(MODE==1){ if(jb_>=0)cmask(P0,P1,jb_,qrel,hi); } else { if(jb_>=-2)biasmask(P0,P1,jb_,qrel,hi,tab3); } }while(0)
  #define FADD(P0,P1,t) do{ if(MODE==1){ const ALAS f32x4v*fp_=(const ALAS f32x4v*)(shm3+LDS_BYTES)+(16*((t)+tskip)+hi); \
    _Pragma("unroll") for(int g_=0;g_<4;++g_){ const f32x4v a_=fp_[2*g_]-mhat, b_=fp_[8+2*g_]-mhat; \
      P0[4*g_]+=a_[0];P0[4*g_+1]+=a_[1];P0[4*g_+2]+=a_[2];P0[4*g_+3]+=a_[3]; P1[4*g_]+=b_[0];P1[4*g_+1]+=b_[1];P1[4*g_+2]+=b_[2];P1[4*g_+3]+=b_[3]; } } }while(0)
  bool resc=false;
  #define START(P0,P1) do{ resc=false; if(MODE==1){ \
      _Pragma("unroll") for(int r=0;r<16;++r)P0[r]=__builtin_amdgcn_exp2f(P0[r]); } else { const float rm=rowmax(P0,P1); \
    { const float dl=rm; mhat=fadd_s(mhat,dl); \
      _Pragma("unroll") for(int r=0;r<16;++r){P0[r]=fsub_s(P0[r],dl);P1[r]=fsub_s(P1[r],dl);} \
      _Pragma("unroll") for(int r=0;r<16;++r)negm[r]=-mhat; asm volatile("":"+v"(negm)); } \
    _Pragma("unroll") for(int r=0;r<16;++r)P0[r]=__builtin_amdgcn_exp2f(P0[r]); } }while(0)
  #define RESC() do{ if(resc){ asm volatile("s_waitcnt lgkmcnt(0)":::"memory"); \
      _Pragma("unroll") for(int d_=0;d_<2;++d_) _Pragma("unroll") for(int r=0;r<16;++r)o[d_][r]*=wsf[crow(r,hi)]; } }while(0)
  f32x16 pA0,pA1,pB0,pB1;
  int sl_prev=0,sl_cur=0,sl_next=SLOTB;
  #define ROT() do{sl_prev=sl_cur;sl_cur=sl_next;sl_next=(sl_next==(NSLOT-1)*SLOTB)?0:sl_next+SLOTB;}while(0)
  DMA_K(2,2*SLOTB);
  WAIT_BAR(3);
  qkt(pA0,pA1,Kbase,qr,CIN,r32,hi);asm volatile("s_nop 15\n\ts_nop 7":"+v"(pA0),"+v"(pA1));FADD(pA0,pA1,0);CMASK(pA0,pA1,0);
  START(pA0,pA1);
  _Pragma("unroll") for(int r=0;r<16;++r)pA1[r]=__builtin_amdgcn_exp2f(pA1[r]);
  WAIT_BAR(0);
  DMA_K(3,0);DMA_V(1,SLOTB);
  ROT();
  kload8(kf,kp0+sl_cur);
  WAIT_BAR(2);
  s16x4 vlo[8],vhi[8]; u32x4 pw0,pw1,pw2,pw3;
  #define PKW(P,B) cvtpk_s(P[B],P[B+1])
  #define PAF(k) __builtin_bit_cast(bf16x8,pw##k)
  #define VFR(i) (bf16x8){vlo[i][0],vlo[i][1],vlo[i][2],vlo[i][3],vhi[i][0],vhi[i][1],vhi[i][2],vhi[i][3]}
  #define PIN(x) asm volatile("":"+v"(x))
  #define MX3(a,b,c) __builtin_fmaxf(__builtin_fmaxf((a),(b)),(c))
  #define GAPA(MF,A0,A1,A2,A3,W0,W1,PW) do{ MF; sacc+=A0; sacc+=A1; sacc+=A2; sacc+=A3; PIN(sacc); W0; W1; PIN(PW); SBAR(); }while(0)
  #define EX(v) __builtin_amdgcn_exp2f(v)
  #define GAPB(MF,X,B) do{ MF; X[B]=EX(X[B]); X[B+1]=EX(X[B+1]); X[B+2]=EX(X[B+2]); X[B+3]=EX(X[B+3]); PIN(X); SBAR(); }while(0)
  #define VRD(i) do{ vlo[i]=vtr(vp_+(((i)>>2)*4096+((i)&3)*1024)); vhi[i]=vtr(vp_+(((i)>>2)*4096+((i)&3)*1024+512)); }while(0)
  #define KRD(G,j) do{ if(G){ kload2(kf,kp0+sl_next,j); SBAR(); } }while(0)
  #define STEP(C0,C1,P0,P1,t,GK,GV,GL) do{ SBAR(); \
    const lds_cptr vp_=vp0+sl_prev; \
    VRD(0); SBAR(); float sacc=(P0[0]+P0[1]); \
    GAPA(C0=__builtin_amdgcn_mfma_f32_32x32x16_bf16(kf[0],qr[0],CIN,0,0,0), P0[2],P0[3],P0[4],P0[5],     pw0[0]=PKW(P0,0), pw0[1]=PKW(P0,2), pw0); \
    VRD(4); SBAR(); GAPA(C1=__builtin_amdgcn_mfma_f32_32x32x16_bf16(kf[1],qr[0],CIN,0,0,0), P0[6],P0[7],P0[8],P0[9],     pw0[2]=PKW(P0,4), pw0[3]=PKW(P0,6), pw0); \
    VRD(1); SBAR(); GAPA(C0=__builtin_amdgcn_mfma_f32_32x32x16_bf16(kf[2],qr[1],C0,0,0,0),   P0[10],P0[11],P0[12],P0[13], pw1[0]=PKW(P0,8), pw1[1]=PKW(P0,10), pw1); \
    VRD(5); SBAR(); GAPA(C1=__builtin_amdgcn_mfma_f32_32x32x16_bf16(kf[3],qr[1],C1,0,0,0),   P0[14],P0[15],P1[0],P1[1],   pw1[2]=PKW(P0,12),pw1[3]=PKW(P0,14), pw1); \
    VRD(2); SBAR(); GAPA(C0=__builtin_amdgcn_mfma_f32_32x32x16_bf16(kf[4],qr[2],C0,0,0,0),   P1[2],P1[3],P1[4],P1[5],     pw2[0]=PKW(P1,0), pw2[1]=PKW(P1,2), pw2); \
    VRD(6); SBAR(); GAPA(C1=__builtin_amdgcn_mfma_f32_32x32x16_bf16(kf[5],qr[2],C1,0,0,0),   P1[6],P1[7],P1[8],P1[9],     pw2[2]=PKW(P1,4), pw2[3]=PKW(P1,6), pw2); \
    VRD(3); SBAR(); GAPA(C0=__builtin_amdgcn_mfma_f32_32x32x16_bf16(kf[6],qr[3],C0,0,0,0),   P1[10],P1[11],P1[12],P1[13], pw3[0]=PKW(P1,8), pw3[1]=PKW(P1,10), pw3); \
    VRD(7); SBAR(); GAPA(C1=__builtin_amdgcn_mfma_f32_32x32x16_bf16(kf[7],qr[3],C1,0,0,0),   P1[14],P1[15],0.f,0.f,       pw3[2]=PKW(P1,12),pw3[3]=PKW(P1,14), pw3); \
    l_reg+=sacc; \
    if(GK){DMA_K((t)+3,sl_cur);} if(GV){DMA_V((t)+1,sl_next);} \
    FADD(C0,C1,t); CMASK(C0,C1,t); \
    resc=false; if(MODE!=1) { float a=MX3(C0[0],C0[1],C1[0]),b=MX3(C0[2],C0[3],C1[1]); a=MX3(a,C1[2],C1[3]); \
      _Pragma("unroll") for(int r=4;r<16;r+=4){a=MX3(a,C0[r],C0[r+1]);b=MX3(b,C0[r+2],C0[r+3]);a=MX3(a,C1[r],C1[r+1]);b=MX3(b,C1[r+2],C1[r+3]);} \
      float rm=__builtin_fmaxf(a,b); { auto rr=__builtin_amdgcn_permlane32_swap(__float_as_uint(rm),__float_as_uint(rm),false,false); rm=__builtin_fmaxf(__uint_as_float(rr[0]),__uint_as_float(rr[1])); } \
      resc=false; \
      if(__builtin_expect(__any(rm>(float)THRL),0)){ const float dl=__builtin_fmaxf(rm,0.f); mhat+=dl; \
        _Pragma("unroll") for(int r=0;r<16;++r){C0[r]-=dl;C1[r]-=dl;} \
        if(MODE==0){ _Pragma("unroll") for(int r=0;r<16;++r)negm[r]=-mhat; asm volatile("":"+v"(negm)); } \
        const float f=__builtin_amdgcn_exp2f(-dl); l_reg*=f; if(hi==0)wsf[r32]=f; resc=true; } } \
    SBAR(); \
    GAPB(o[0]=__builtin_amdgcn_mfma_f32_32x32x16_bf16(PAF(0),VFR(0),o[0],0,0,0), C0,0); \
    GAPB(o[1]=__builtin_amdgcn_mfma_f32_32x32x16_bf16(PAF(0),VFR(4),o[1],0,0,0), C0,4); \
    KRD(GL,0); GAPB(o[0]=__builtin_amdgcn_mfma_f32_32x32x16_bf16(PAF(1),VFR(1),o[0],0,0,0), C0,8); \
    KRD(GL,1); GAPB(o[1]=__builtin_amdgcn_mfma_f32_32x32x16_bf16(PAF(1),VFR(5),o[1],0,0,0), C0,12); \
    KRD(GL,2); GAPB(o[0]=__builtin_amdgcn_mfma_f32_32x32x16_bf16(PAF(2),VFR(2),o[0],0,0,0), C1,0); \
    KRD(GL,3); GAPB(o[1]=__builtin_amdgcn_mfma_f32_32x32x16_bf16(PAF(2),VFR(6),o[1],0,0,0), C1,4); \
    GAPB(o[0]=__builtin_amdgcn_mfma_f32_32x32x16_bf16(PAF(3),VFR(3),o[0],0,0,0), C1,8); \
    GAPB(o[1]=__builtin_amdgcn_mfma_f32_32x32x16_bf16(PAF(3),VFR(7),o[1],0,0,0), C1,12); \
    }while(0)
  int t=1;
  #undef CMASK
  #define CMASK(P0,P1,t) do{}while(0)
  for(;t+(MODE==0?7:5)<NT;t+=2){
    STEP(pB0,pB1,pA0,pA1,t,true,true,true);     WAIT_BAR(2); RESC(); ROT();
    STEP(pA0,pA1,pB0,pB1,t+1,true,true,true);   WAIT_BAR(2); RESC(); ROT();
  }
  #undef CMASK
  #define CMASK(P0,P1,t) do{int jb_=(t)-(NT-4); if(MODE==1){ if(jb_>=0)cmask(P0,P1,jb_,qrel,hi); } else { if(jb_>=-2)biasmask(P0,P1,jb_,qrel,hi,tab3); } }while(0)
  #define ENDW(tt) do{ if((tt)+3<NT){WAIT_BAR(2);} else if((tt)+2<NT){WAIT_BAR(1);} else {WAIT_BAR(0);} }while(0)
  for(;t+1<NT;t+=2){
    STEP(pB0,pB1,pA0,pA1,t,(t+3<NT),(t+1<NT),(t+1<NT));       ENDW(t);   RESC(); ROT();
    STEP(pA0,pA1,pB0,pB1,t+1,(t+4<NT),(t+2<NT),(t+2<NT));     ENDW(t+1); RESC(); ROT();
  }
  STEP(pB0,pB1,pA0,pA1,NT-1,false,false,false); RESC();
  { float sacc=pB0[0]+pB0[1]; _Pragma("unroll") for(int r=2;r<16;++r)sacc+=pB0[r]; _Pragma("unroll") for(int r=0;r<16;++r)sacc+=pB1[r]; l_reg+=sacc;
    pw0=(u32x4){PKW(pB0,0),PKW(pB0,2),PKW(pB0,4),PKW(pB0,6)};pw1=(u32x4){PKW(pB0,8),PKW(pB0,10),PKW(pB0,12),PKW(pB0,14)};pw2=(u32x4){PKW(pB1,0),PKW(pB1,2),PKW(pB1,4),PKW(pB1,6)};pw3=(u32x4){PKW(pB1,8),PKW(pB1,10),PKW(pB1,12),PKW(pB1,14)};
    SBAR(); pv(o,vb0+sl_cur,PAF(0),PAF(1),PAF(2),PAF(3)); }
  #undef PKW
  #undef PAF
  #undef VFR
  #undef PIN
  #undef MX3
  #undef GAPA
  #undef GAPB
  #undef EX
  #undef VRD
  #undef KRD
  #undef STEP
  #undef ENDW
  {auto rr=__builtin_amdgcn_permlane32_swap(__float_as_uint(l_reg),__float_as_uint(l_reg),false,false);l_reg=__uint_as_float(rr[0])+__uint_as_float(rr[1]);}
  if(hi==0)wsf[32+r32]=l_reg;asm volatile("s_waitcnt lgkmcnt(0)":::"memory");
  float rli[16];
  #pragma unroll
  for(int r=0;r<16;++r)rli[r]=__builtin_amdgcn_rcpf(wsf[32+crow(r,hi)]);
  bf16*Ow=O+(rowbase+q0+wid*QBLK)*DM+oc;
  { bf16*stg=(bf16*)(shm+LDS_OST)+wid*2048;
    #pragma unroll
    for(int r=0;r<16;++r){const int orow=crow(r,hi);
      #pragma unroll
      for(int d0=0;d0<2;++d0)stg[orow*64+d0*32+r32]=__float2bfloat16(o[d0][r]*rli[r]);}
    asm volatile("s_waitcnt lgkmcnt(0)":::"memory");
    #pragma unroll
    for(int i=0;i<4;++i){const int row=i*8+(lane>>3),ch=lane&7; const u32x4 v=*(const u32x4*)(stg+row*64+ch*8); ATTN_STORE16(Ow+(long)row*DM+ch*8,v);} }
  asm volatile("s_waitcnt lgkmcnt(0)\n\ts_barrier":::"memory");
  #undef FADD
  #undef CIN
  #undef DMA_K
  #undef DMA_V
  #undef CMASK
  #undef START
  #undef RESC
  #undef ROT
}
constexpr int WLDS_V=NSLOT*SLOTB, WLDS_WS=WLDS_V+NSLOT*2*SLOTB, WLDS_OST=WLDS_WS+NW*64*4, WLDS_BYTES=WLDS_OST+NW*4096;
__device__ __forceinline__ void pv_w(f32x16*o,int vb,bf16x8 pa0,bf16x8 pa1,bf16x8 pa2,bf16x8 pa3){
  #pragma unroll
  for(int d0=0;d0<4;++d0){s16x4 lo[4],hi[4];
    #pragma unroll
    for(int ks=0;ks<4;++ks){
      asm volatile("ds_read_b64_tr_b16 %0,%1 offset:%c2":"=&v"(lo[ks]):"v"(vb),"i"(d0*4096+ks*1024):"memory");
      asm volatile("ds_read_b64_tr_b16 %0,%1 offset:%c2":"=&v"(hi[ks]):"v"(vb),"i"(d0*4096+ks*1024+512):"memory");}
    asm volatile("s_waitcnt lgkmcnt(0)":::"memory");SBAR();
    #define PK(k) (bf16x8){lo[k][0],lo[k][1],lo[k][2],lo[k][3],hi[k][0],hi[k][1],hi[k][2],hi[k][3]}
    o[d0]=__builtin_amdgcn_mfma_f32_32x32x16_bf16(pa0,PK(0),o[d0],0,0,0);
    o[d0]=__builtin_amdgcn_mfma_f32_32x32x16_bf16(pa1,PK(1),o[d0],0,0,0);
    o[d0]=__builtin_amdgcn_mfma_f32_32x32x16_bf16(pa2,PK(2),o[d0],0,0,0);
    o[d0]=__builtin_amdgcn_mfma_f32_32x32x16_bf16(pa3,PK(3),o[d0],0,0,0);
    #undef PK
  }
}
template<int THRL,bool NOREF> __device__ __forceinline__ bool attn_unit_w(int b,int qc,int kc,int vc,int oc,int qb,const bf16*Q,const bf16*__restrict__ K,const bf16*__restrict__ V,bf16*O,char*shm,const float*aux,int hidx,const float*kpart,int npart,const int tid_in){
  int tid=tid_in; asm volatile("":"+v"(tid));
  constexpr int MODE=0;
  const int lane=tid&63,r32=lane&31,hi=lane>>5; const int wid=__builtin_amdgcn_readfirstlane(tid>>6);
  const long rowbase=(long)b*SEQ; const int q0=qb*QB;
  const bf16*Qw=Q+(rowbase+q0+wid*QBLK)*DM+qc;
  const bf16*Kh=K+rowbase*DM+kc; const bf16*Vh=V+rowbase*DM+vc;
  const unsigned lds0=(unsigned)(uintptr_t)shm;
  float*wsf=(float*)(shm+WLDS_WS)+wid*64;
  int tskip=0;
  if(MODE==1){
    float ss=0.f;
    #pragma unroll
    for(int d0=0;d0<4;++d0){ const bf16x8 qv=*reinterpret_cast<const bf16x8*>(&Qw[(long)r32*DM+d0*16+hi*8]);
      #pragma unroll
      for(int e=0;e<8;++e){ const float f=__uint_as_float(((unsigned)(unsigned short)qv[e])<<16); ss+=f*f; } }
    { auto rr=__builtin_amdgcn_permlane32_swap(__float_as_uint(ss),__float_as_uint(ss),false,false); ss=__uint_as_float(rr[0])+__uint_as_float(rr[1]); }
    ss=wave_max32(ss);
    float km=0.f; for(int i=lane;i<npart;i+=64) km=fmaxf(km,kpart[(long)i*64]);
    km=wave_max64(km);
    ALAS float*wsl=(ALAS float*)((__attribute__((address_space(3))) char*)shm+WLDS_WS);
    if(lane==0)wsl[wid*64]=ss;
    asm volatile("s_waitcnt lgkmcnt(0)\n\ts_barrier":::"memory");
    float qm=wsl[0];
    #pragma unroll
    for(int w=1;w<NW;++w)qm=fmaxf(qm,wsl[w*64]);
    const float smax2=2.f*(__builtin_amdgcn_sqrtf(qm*km)*1.01f+1.f);
    const int NT0=(q0+QB)/KVBLK;
    const float thr=aux[q0]-160.f-smax2;
    const bool sk0=(lane<NT0-6)&&(aux[64*lane+63]<thr);
    const bool sk1=(lane+64<NT0-6)&&(aux[64*(lane+64)+63]<thr);
    const unsigned long long m0=~__ballot(sk0), m1=~__ballot(sk1);
    const int nlead=m0?__builtin_ctzll(m0):64+(m1?__builtin_ctzll(m1):64);
    tskip=__builtin_amdgcn_readfirstlane(nlead&~1);
    Kh+=(long)tskip*KVBLK*DM; Vh+=(long)tskip*KVBLK*DM; aux+=64*tskip;
  }
  const bf16*ksrc=Kh+(long)lane*DM+wid*8;
  const bf16*vsrc=Vh+(long)(16*(wid&3)+(lane>>2))*DM+(wid>>2)*32+(lane&3)*8;
  const unsigned kdst=lds0+LDS_K+wid*1024, vdst=lds0+WLDS_V+wid*1024;
  #define DMA_K(t,slot) glds16(ksrc+(long)(t)*KVBLK*DM,(unsigned)__builtin_amdgcn_readfirstlane(kdst+(slot)))
  #define DMA_V(t,slot) do{ glds16(vsrc+(long)(t)*KVBLK*DM,(unsigned)__builtin_amdgcn_readfirstlane(vdst+2*(slot))); glds16(vsrc+64+(long)(t)*KVBLK*DM,(unsigned)__builtin_amdgcn_readfirstlane(vdst+2*(slot)+8192)); }while(0)
  const int vb0=(int)(lds0+WLDS_V)+((lane>>4)&1)*32+(lane&3)*8+(4*hi+((lane&15)>>2))*64;
  const char*Kbase=shm+LDS_K; bf16x8 kf[8];
  const lds_cptr shm3=(lds_cptr)shm; const lds_cptr kp0=shm3+LDS_K+hi*1024+r32*16; const lds_cptr vp0=shm3+WLDS_V+((lane>>4)&1)*32+(lane&3)*8+(4*hi+((lane&15)>>2))*64;
  const int NT=(q0+QB)/KVBLK-tskip;
  const ALAS float*tab3=(const ALAS float*)(shm3+WLDS_BYTES);
  { ALAS float*tabf=(ALAS float*)(shm3+WLDS_BYTES);
    if(NOREF&&tid==130) tabf[255]=0.f;
    if(MODE==0){ if(tid<130){ float v; if(tid==0)v=-INFINITY; else if(tid==129)v=0.f; else{ const int n=tid-1; int bk; if(n<16)bk=n; else{ const int lg=16+(int)(__builtin_amdgcn_logf((float)n*0.0625f)*(16.0f/3.0f));     bk=lg<31?lg:31; } v=(aux[bk*8+hidx]-aux[31*8+hidx])*1.4426950408889634f; } tabf[tid]=v; } }
    else{ const int n4=(q0+QB-64*tskip)>>2; for(int i=tid;i<n4;i+=512) ((ALAS f32x4v*)tabf)[i]=((const f32x4v*)aux)[i]; }
    asm volatile("s_waitcnt vmcnt(0) lgkmcnt(0)":::"memory"); }
  DMA_K(0,0);DMA_V(0,0);DMA_K(1,SLOTB);
  bf16x8 qr[4];
  #pragma unroll
  for(int d0=0;d0<4;++d0)qr[d0]=*reinterpret_cast<const bf16x8*>(&Qw[(long)r32*DM+d0*16+hi*8]);
  float mhat=0.f,l_reg=0.f;f32x16 o[4];o[0]=f32x16{};o[1]=f32x16{};o[2]=f32x16{};o[3]=f32x16{};
  const f32x16 zero16=f32x16{};
  #define CIN zero16
  const int qrel=wid*QBLK+r32;
  #define CMASK(P0,P1,t) do{int jb_=(t)-(NT-4); if(MODE==1){ if(jb_>=0)cmask(P0,P1,jb_,qrel,hi); } else { if(jb_>=-2)biasmask(P0,P1,jb_,qrel,hi,tab3); } }while(0)
  #define FADD(P0,P1,t) do{ if(MODE==1){ const ALAS f32x4v*fp_=(const ALAS f32x4v*)(shm3+WLDS_BYTES)+(16*(t)+hi); \
    _Pragma("unroll") for(int g_=0;g_<4;++g_){ const f32x4v a_=fp_[2*g_]-mhat, b_=fp_[8+2*g_]-mhat; \
      P0[4*g_]+=a_[0];P0[4*g_+1]+=a_[1];P0[4*g_+2]+=a_[2];P0[4*g_+3]+=a_[3]; P1[4*g_]+=b_[0];P1[4*g_+1]+=b_[1];P1[4*g_+2]+=b_[2];P1[4*g_+3]+=b_[3]; } } }while(0)
  bool resc=false;
  #define START(P0,P1) do{ resc=false; if(NOREF){ mhat=0.f; _Pragma("unroll") for(int r=0;r<16;++r)P0[r]=__builtin_amdgcn_exp2f(P0[r]); } else { const float rm=rowmax(P0,P1); mhat=rm; \
    _Pragma("unroll") for(int r=0;r<16;++r)P0[r]=__builtin_amdgcn_exp2f(fsub_s(P0[r],mhat)); } }while(0)
  #define RESC() do{ if(resc){ asm volatile("s_waitcnt lgkmcnt(0)":::"memory"); \
      _Pragma("unroll") for(int d_=0;d_<4;++d_) _Pragma("unroll") for(int r=0;r<16;++r)o[d_][r]*=wsf[crow(r,hi)]; } }while(0)
  f32x16 pA0,pA1,pB0,pB1;
  int sl_prev=0,sl_cur=0,sl_next=SLOTB;
  #define ROT() do{sl_prev=sl_cur;sl_cur=sl_next;sl_next=(sl_next==(NSLOT-1)*SLOTB)?0:sl_next+SLOTB;}while(0)
  DMA_K(2,2*SLOTB);
  WAIT_BAR(4);
  qkt(pA0,pA1,Kbase,qr,CIN,r32,hi);asm volatile("s_nop 15\n\ts_nop 7":"+v"(pA0),"+v"(pA1));FADD(pA0,pA1,0);CMASK(pA0,pA1,0);
  START(pA0,pA1);
  _Pragma("unroll") for(int r=0;r<16;++r)pA1[r]=__builtin_amdgcn_exp2f(NOREF?pA1[r]:pA1[r]-mhat);
  WAIT_BAR(0);
  DMA_K(3,0);DMA_V(1,SLOTB);
  ROT();
  kload8(kf,kp0+sl_cur);
  WAIT_BAR(3);
  s16x4 vlo[8],vhi[8]; u32x4 pw0,pw1,pw2,pw3;
  #define PKW(P,B) cvtpk_s(P[B],P[B+1])
  #define PAF(k) __builtin_bit_cast(bf16x8,pw##k)
  #define VFR(i) (bf16x8){vlo[i][0],vlo[i][1],vlo[i][2],vlo[i][3],vhi[i][0],vhi[i][1],vhi[i][2],vhi[i][3]}
  #define PIN(x) asm volatile("":"+v"(x))
  #define MX3(a,b,c) __builtin_fmaxf(__builtin_fmaxf((a),(b)),(c))
  #define GAPA(MF,A0,A1,A2,A3,W0,W1,PW) do{ MF; sacc+=A0; sacc+=A1; sacc+=A2; sacc+=A3; PIN(sacc); W0; W1; PIN(PW); SBAR(); }while(0)
  #define EX(v) __builtin_amdgcn_exp2f(v)
  #define GAPB(MF,X,B) do{ MF; X[B]=EX(X[B]-mhat); X[B+1]=EX(X[B+1]-mhat); X[B+2]=EX(X[B+2]-mhat); X[B+3]=EX(X[B+3]-mhat); PIN(X); SBAR(); }while(0)
  #define GAPC(MF) do{ MF; SBAR(); }while(0)
  #define GAPB2(MF,X,B) do{ MF; X[B]=EX(NOREF?X[B]:X[B]-mhat); X[B+1]=EX(NOREF?X[B+1]:X[B+1]-mhat); PIN(X); SBAR(); }while(0)
  #define VRD2(i) do{ vlo[i]=vtr(vp_+((((i)>>2)+2)*4096+((i)&3)*1024)); vhi[i]=vtr(vp_+((((i)>>2)+2)*4096+((i)&3)*1024+512)); SBAR(); }while(0)
  #define VRD(i) do{ vlo[i]=vtr(vp_+(((i)>>2)*4096+((i)&3)*1024)); vhi[i]=vtr(vp_+(((i)>>2)*4096+((i)&3)*1024+512)); }while(0)
  #define KRD(G,j) do{ if(G){ kload2(kf,kp0+sl_next,j); SBAR(); } }while(0)
  #define STEP(C0,C1,P0,P1,t,GK,GV,GL) do{ SBAR(); \
    const lds_cptr vp_=vp0+2*sl_prev; \
    VRD(0); SBAR(); float sacc=(P0[0]+P0[1]); \
    GAPA(C0=__builtin_amdgcn_mfma_f32_32x32x16_bf16(kf[0],qr[0],CIN,0,0,0), P0[2],P0[3],P0[4],P0[5],     pw0[0]=PKW(P0,0), pw0[1]=PKW(P0,2), pw0); \
    VRD(4); SBAR(); GAPA(C1=__builtin_amdgcn_mfma_f32_32x32x16_bf16(kf[1],qr[0],CIN,0,0,0), P0[6],P0[7],P0[8],P0[9],     pw0[2]=PKW(P0,4), pw0[3]=PKW(P0,6), pw0); \
    VRD(1); SBAR(); GAPA(C0=__builtin_amdgcn_mfma_f32_32x32x16_bf16(kf[2],qr[1],C0,0,0,0),   P0[10],P0[11],P0[12],P0[13], pw1[0]=PKW(P0,8), pw1[1]=PKW(P0,10), pw1); \
    VRD(5); SBAR(); GAPA(C1=__builtin_amdgcn_mfma_f32_32x32x16_bf16(kf[3],qr[1],C1,0,0,0),   P0[14],P0[15],P1[0],P1[1],   pw1[2]=PKW(P0,12),pw1[3]=PKW(P0,14), pw1); \
    VRD(2); SBAR(); GAPA(C0=__builtin_amdgcn_mfma_f32_32x32x16_bf16(kf[4],qr[2],C0,0,0,0),   P1[2],P1[3],P1[4],P1[5],     pw2[0]=PKW(P1,0), pw2[1]=PKW(P1,2), pw2); \
    VRD(6); SBAR(); GAPA(C1=__builtin_amdgcn_mfma_f32_32x32x16_bf16(kf[5],qr[2],C1,0,0,0),   P1[6],P1[7],P1[8],P1[9],     pw2[2]=PKW(P1,4), pw2[3]=PKW(P1,6), pw2); \
    VRD(3); SBAR(); GAPA(C0=__builtin_amdgcn_mfma_f32_32x32x16_bf16(kf[6],qr[3],C0,0,0,0),   P1[10],P1[11],P1[12],P1[13], pw3[0]=PKW(P1,8), pw3[1]=PKW(P1,10), pw3); \
    VRD(7); SBAR(); GAPA(C1=__builtin_amdgcn_mfma_f32_32x32x16_bf16(kf[7],qr[3],C1,0,0,0),   P1[14],P1[15],0.f,0.f,       pw3[2]=PKW(P1,12),pw3[3]=PKW(P1,14), pw3); \
    l_reg+=sacc; \
    if(GK){DMA_K((t)+3,sl_cur);} if(GV){DMA_V((t)+1,sl_next);} \
    FADD(C0,C1,t); CMASK(C0,C1,t); \
    resc=false; if(!NOREF) { float a=MX3(C0[0],C0[1],C1[0]),b=MX3(C0[2],C0[3],C1[1]); a=MX3(a,C1[2],C1[3]); \
      _Pragma("unroll") for(int r=4;r<16;r+=4){a=MX3(a,C0[r],C0[r+1]);b=MX3(b,C0[r+2],C0[r+3]);a=MX3(a,C1[r],C1[r+1]);b=MX3(b,C1[r+2],C1[r+3]);} \
      float rm=__builtin_fmaxf(a,b); { auto rr=__builtin_amdgcn_permlane32_swap(__float_as_uint(rm),__float_as_uint(rm),false,false); rm=__builtin_fmaxf(__uint_as_float(rr[0]),__uint_as_float(rr[1])); } \
      resc=false; \
      const float rmr=rm-mhat; \
      if(__builtin_expect(__any(rmr>(float)THRL),0)){ const float dl=__builtin_fmaxf(rmr,0.f); mhat+=dl; \
        const float f=__builtin_amdgcn_exp2f(-dl); l_reg*=f; if(hi==0)wsf[r32]=f; resc=true; } } \
    SBAR(); \
    GAPB2(o[0]=__builtin_amdgcn_mfma_f32_32x32x16_bf16(PAF(0),VFR(0),o[0],0,0,0), C0,0); VRD2(0); \
    GAPB2(o[1]=__builtin_amdgcn_mfma_f32_32x32x16_bf16(PAF(0),VFR(4),o[1],0,0,0), C0,2); VRD2(4); \
    KRD(GL,0); GAPB2(o[0]=__builtin_amdgcn_mfma_f32_32x32x16_bf16(PAF(1),VFR(1),o[0],0,0,0), C0,4); VRD2(1); \
    KRD(GL,1); GAPB2(o[1]=__builtin_amdgcn_mfma_f32_32x32x16_bf16(PAF(1),VFR(5),o[1],0,0,0), C0,6); VRD2(5); \
    KRD(GL,2); GAPB2(o[0]=__builtin_amdgcn_mfma_f32_32x32x16_bf16(PAF(2),VFR(2),o[0],0,0,0), C0,8); VRD2(2); \
    KRD(GL,3); GAPB2(o[1]=__builtin_amdgcn_mfma_f32_32x32x16_bf16(PAF(2),VFR(6),o[1],0,0,0), C0,10); VRD2(6); \
    GAPB2(o[0]=__builtin_amdgcn_mfma_f32_32x32x16_bf16(PAF(3),VFR(3),o[0],0,0,0), C0,12); VRD2(3); \
    GAPB2(o[1]=__builtin_amdgcn_mfma_f32_32x32x16_bf16(PAF(3),VFR(7),o[1],0,0,0), C0,14); VRD2(7); \
    GAPB2(o[2]=__builtin_amdgcn_mfma_f32_32x32x16_bf16(PAF(0),VFR(0),o[2],0,0,0), C1,0); GAPB2(o[3]=__builtin_amdgcn_mfma_f32_32x32x16_bf16(PAF(0),VFR(4),o[3],0,0,0), C1,2); \
    GAPB2(o[2]=__builtin_amdgcn_mfma_f32_32x32x16_bf16(PAF(1),VFR(1),o[2],0,0,0), C1,4); GAPB2(o[3]=__builtin_amdgcn_mfma_f32_32x32x16_bf16(PAF(1),VFR(5),o[3],0,0,0), C1,6); \
    GAPB2(o[2]=__builtin_amdgcn_mfma_f32_32x32x16_bf16(PAF(2),VFR(2),o[2],0,0,0), C1,8); GAPB2(o[3]=__builtin_amdgcn_mfma_f32_32x32x16_bf16(PAF(2),VFR(6),o[3],0,0,0), C1,10); \
    GAPB2(o[2]=__builtin_amdgcn_mfma_f32_32x32x16_bf16(PAF(3),VFR(3),o[2],0,0,0), C1,12); GAPB2(o[3]=__builtin_amdgcn_mfma_f32_32x32x16_bf16(PAF(3),VFR(7),o[3],0,0,0), C1,14); \
    }while(0)
  int t=1;
  #undef CMASK
  #define CMASK(P0,P1,t) do{}while(0)
  for(;t+(MODE==0?7:5)<NT;t+=2){
    STEP(pB0,pB1,pA0,pA1,t,true,true,true);     WAIT_BAR(3); RESC(); ROT();
    STEP(pA0,pA1,pB0,pB1,t+1,true,true,true);   WAIT_BAR(3); RESC(); ROT();
  }
  #undef CMASK
  #define CMASK(P0,P1,t) do{int jb_=(t)-(NT-4); if(MODE==1){ if(jb_>=0)cmask(P0,P1,jb_,qrel,hi); } else { if(jb_>=-2)biasmask(P0,P1,jb_,qrel,hi,tab3); } }while(0)
  #define ENDW(tt) do{ if((tt)+3<NT){WAIT_BAR(3);} else if((tt)+2<NT){WAIT_BAR(2);} else {WAIT_BAR(0);} }while(0)
  for(;t+1<NT;t+=2){
    STEP(pB0,pB1,pA0,pA1,t,(t+3<NT),(t+1<NT),(t+1<NT));       ENDW(t);   RESC(); ROT();
    STEP(pA0,pA1,pB0,pB1,t+1,(t+4<NT),(t+2<NT),(t+2<NT));     ENDW(t+1); RESC(); ROT();
  }
  STEP(pB0,pB1,pA0,pA1,NT-1,false,false,false); RESC();
  { float sacc=pB0[0]+pB0[1]; _Pragma("unroll") for(int r=2;r<16;++r)sacc+=pB0[r]; _Pragma("unroll") for(int r=0;r<16;++r)sacc+=pB1[r]; l_reg+=sacc;
    pw0=(u32x4){PKW(pB0,0),PKW(pB0,2),PKW(pB0,4),PKW(pB0,6)};pw1=(u32x4){PKW(pB0,8),PKW(pB0,10),PKW(pB0,12),PKW(pB0,14)};pw2=(u32x4){PKW(pB1,0),PKW(pB1,2),PKW(pB1,4),PKW(pB1,6)};pw3=(u32x4){PKW(pB1,8),PKW(pB1,10),PKW(pB1,12),PKW(pB1,14)};
    SBAR(); pv_w(o,vb0+2*sl_cur,PAF(0),PAF(1),PAF(2),PAF(3)); }
  #undef PKW
  #undef PAF
  #undef VFR
  #undef PIN
  #undef MX3
  #undef GAPA
  #undef GAPB
  #undef GAPC
  #undef GAPB2
  #undef VRD2
  #undef EX
  #undef VRD
  #undef KRD
  #undef STEP
  #undef ENDW
  {auto rr=__builtin_amdgcn_permlane32_swap(__float_as_uint(l_reg),__float_as_uint(l_reg),false,false);l_reg=__uint_as_float(rr[0])+__uint_as_float(rr[1]);}
  bool okay=true;
  if(NOREF){ const bool bad=!(l_reg>7.9e-31f&&l_reg<1.2e30f);
    if(__any(bad)){ if(lane==0)((ALAS float*)(shm3+WLDS_BYTES))[255]=1.f; }
    asm volatile("s_waitcnt lgkmcnt(0)\n\ts_barrier":::"memory");
    okay=(tab3[255]==0.f); }
  if(hi==0)wsf[32+r32]=l_reg;asm volatile("s_waitcnt lgkmcnt(0)":::"memory");
  float rli[16];
  #pragma unroll
  for(int r=0;r<16;++r)rli[r]=__builtin_amdgcn_rcpf(wsf[32+crow(r,hi)]);
  bf16*Ow=O+(rowbase+q0+wid*QBLK)*DM+oc;
  int lane2=tid_in; asm volatile("":"+v"(lane2)); lane2&=63;
  if(okay){ bf16*stg=(bf16*)(shm+WLDS_OST)+wid*2048;
    #pragma unroll
    for(int hh=0;hh<2;++hh){
      #pragma unroll
      for(int r=0;r<16;++r){const int orow=crow(r,hi);
        #pragma unroll
        for(int d0=0;d0<2;++d0)stg[orow*64+d0*32+r32]=__float2bfloat16(o[2*hh+d0][r]*rli[r]);}
      asm volatile("s_waitcnt lgkmcnt(0)":::"memory");
      #pragma unroll
      for(int i=0;i<4;++i){const int row=i*8+(lane2>>3),ch=lane2&7; const u32x4 v=*(const u32x4*)(stg+row*64+ch*8); ATTN_STORE16(Ow+(long)row*DM+hh*64+ch*8,v);}
      asm volatile("s_waitcnt lgkmcnt(0)":::"memory"); } }
  asm volatile("s_waitcnt lgkmcnt(0)\n\ts_barrier":::"memory");
  #undef FADD
  #undef CIN
  #undef DMA_K
  #undef DMA_V
  #undef CMASK
  #undef START
  #undef RESC
  #undef ROT
  return okay;
}
constexpr int ATTN_W_LDS_BYTES=WLDS_BYTES+1024;
constexpr int ATTN_LDS_BYTES=LDS_BYTES;
#undef SBAR
#undef WAIT_BAR
}
namespace cg = cooperative_groups;
constexpr int NWAVES = 8;
constexpr int BATCH = 4, T = 8192, D = 1024, FF = 2816, NIN = 2 * FF, M = BATCH * T, NMOD = 9 * D;
constexpr float EPS = 1e-6f, LOG2E = 1.4426950408889634f;
constexpr size_t MiB = 1u << 20;
constexpr size_t WS_CNT = 6 * MiB, WS_XBUF = 7 * MiB, WS_BAR = 1 * MiB + 832 * 1024, WS_QCTR = 1 * MiB + 768 * 1024, WS_KPART = 1 * MiB + 512 * 1024, WS_MOD = 1 * MiB, WS_LOGF = 2 * MiB, WS_NF2 = 4 * MiB, WS_WB = 8 * MiB, WS_XN = 52 * MiB, WS_R1 = 116 * MiB, WS_R2 = 308 * MiB, WS_XN2 = 436 * MiB, WS_WA = 436 * MiB, WS_END = 500 * MiB;
constexpr size_t WO_IN0 = 0, WO_IN1 = 11 * MiB, WO_OUT0 = 22 * MiB, WO_OUT1 = 22 * MiB + 5767168, WO_X1 = 33 * MiB, WO_AWO = 39 * MiB, WO_BWQ = 37 * MiB, WO_BWO = 39 * MiB;
constexpr size_t BUF64 = 64 * MiB;
constexpr int RING_BYTES = 131072, LDS_BYTES = 147456;
static_assert(attn_body::ATTN_LDS_BYTES + 32768 <= RING_BYTES && attn_body::ATTN_W_LDS_BYTES <= RING_BYTES, "attention LDS");

#define LAS __attribute__((address_space(3)))
typedef unsigned short bf16;
typedef unsigned v4u __attribute__((ext_vector_type(4)));
typedef float f32x4 __attribute__((ext_vector_type(4)));
#define LDS_WAIT() asm volatile("s_waitcnt lgkmcnt(0)" ::: "memory")

#define XB_TMO      128
#define XB_XCNT(j)  (256  + 64 * (j))
#define XB_XSUB(j)  (1280 + 64 * (j))
#define XB_XGEN(j)  (2304 + 64 * (j))
#define XB_TOP      3328
#define XB_TOPGEN   3392
#define XCD_BAR_WORDS 3456
#define XB_SPIN_CAP (1u << 18)

__device__ __forceinline__ unsigned xb_ld(unsigned* p)              { return __hip_atomic_load(p, __ATOMIC_RELAXED, __HIP_MEMORY_SCOPE_AGENT); }
__device__ __forceinline__ unsigned xb_add(unsigned* p, unsigned v) { return __hip_atomic_fetch_add(p, v, __ATOMIC_RELAXED, __HIP_MEMORY_SCOPE_AGENT); }
__device__ __forceinline__ unsigned xb_xcc_id() { return (unsigned)__builtin_amdgcn_s_getreg((3 << 11) | 20) & 0xFu; }
#define XB_SPIN(cond, bar) do { unsigned _sp = 0; while (cond) { __builtin_amdgcn_s_sleep(1); \
    if ((++_sp & 255u) == 0u) { if (xb_ld(&(bar)[XB_TMO])) break; if (_sp > XB_SPIN_CAP) { atomicAdd(&(bar)[XB_TMO], 1u); break; } } } } while (0)

struct XcdBarrier {
    unsigned* bar; unsigned x;
    volatile LAS unsigned* st;
};

__device__ __forceinline__ XcdBarrier xcd_barrier_post(unsigned* bar, volatile LAS unsigned* st, int tid) {
    XcdBarrier b; b.bar = bar; b.x = xb_xcc_id(); b.st = st;
    if (tid == 0) (void)xb_add(&bar[XB_XCNT(b.x)], 1u);
    return b;
}
__device__ __forceinline__ void xcd_barrier_complete(unsigned* bar, unsigned x, unsigned& nloc, unsigned& nx) {
    const unsigned G = gridDim.x * gridDim.y * gridDim.z;
    unsigned sum, cnt, mine, sp = 0u;
    for (;;) {
        sum = 0u; cnt = 0u; mine = 0u;
#pragma unroll
        for (unsigned j = 0; j < 16; ++j) { const unsigned c = xb_ld(&bar[XB_XCNT(j)]); sum += c; cnt += (c > 0u) ? 1u : 0u; mine = (j == x) ? c : mine; }
        if (sum == G) break;
        __builtin_amdgcn_s_sleep(1);
        if ((++sp & 255u) == 0u) { if (xb_ld(&bar[XB_TMO])) break; if (sp > XB_SPIN_CAP) { atomicAdd(&bar[XB_TMO], 1u); break; } }
    }
    nloc = mine > 0u ? mine : 1u; nx = cnt > 0u ? cnt : 1u;
}

__device__ __forceinline__ void xcd_barrier(const XcdBarrier& b, int tid) {
    asm volatile("s_waitcnt vmcnt(0)" ::: "memory");
    __syncthreads();
    if (tid == 0) {
        unsigned* bar = b.bar;
        __builtin_amdgcn_s_waitcnt(0);
        unsigned nloc = b.st[0], nx = b.st[1];
        if (nloc == 0u) { xcd_barrier_complete(bar, b.x, nloc, nx); b.st[0] = nloc; b.st[1] = nx; }
        const unsigned old = xb_add(&bar[XB_XSUB(b.x)], 1u);
        const unsigned gen = old / nloc;
        if (old + 1u == (gen + 1u) * nloc) {
            __builtin_amdgcn_fence(__ATOMIC_RELEASE, "agent");
            asm volatile("s_waitcnt vmcnt(0)" ::: "memory");
            const unsigned og = xb_add(&bar[XB_TOP], 1u);
            const unsigned tg = og / nx;
            if (og + 1u == (tg + 1u) * nx) xb_add(&bar[XB_TOPGEN], 1u);
            else XB_SPIN(xb_ld(&bar[XB_TOPGEN]) == tg, bar);
            __builtin_amdgcn_fence(__ATOMIC_ACQUIRE, "agent");
            xb_add(&bar[XB_XGEN(b.x)], 1u);
            asm volatile("s_waitcnt vmcnt(0)" ::: "memory");
        } else {
            XB_SPIN(xb_ld(&bar[XB_XGEN(b.x)]) == gen, bar);
            __builtin_amdgcn_fence(__ATOMIC_ACQUIRE, "agent");
            asm volatile("s_waitcnt vmcnt(0)" ::: "memory");
        }
    }
    __syncthreads();
}


__device__ __forceinline__ float wave_sum(float v) {
    return wave_sum64(v);
}
__device__ __forceinline__ unsigned pk2(float lo, float hi) { return pg8::cvt_pk_bf16(lo, hi); }
__device__ __forceinline__ float bf_lo(unsigned u) { return __uint_as_float(u << 16); }
__device__ __forceinline__ float bf_hi(unsigned u) { return __uint_as_float(u & 0xffff0000u); }

__device__ __forceinline__ void p0_transpose_item(const float* W, int K, int N, bf16* WT, int perm, LAS float* scr, int item, int lane) {
    const int nblk = N / 32, kb = item / nblk, nb = item % nblk, k0 = 64 * kb, n0 = 32 * nb;
    int nd = n0;
    if (perm) nd = (n0 < FF) ? 256 * (n0 >> 7) + (n0 & 127) : 256 * ((n0 - FF) >> 7) + 128 + ((n0 - FF) & 127);
    float wv[32];
#pragma unroll
    for (int i = 0; i < 32; ++i) wv[i] = W[(size_t)(k0 + 2 * i + (lane >> 5)) * N + n0 + (lane & 31)];
#pragma unroll
    for (int i = 0; i < 32; ++i) scr[(2 * i + (lane >> 5)) * 33 + (lane & 31)] = wv[i];
    LDS_WAIT(); asm volatile("" ::: "memory");
    const int c = lane & 7;
#pragma unroll
    for (int j = 0; j < 4; ++j) { const int n = (lane >> 3) + 8 * j; const LAS float* s = scr + (8 * c) * 33 + n;
        v4u o; o.x = pk2(s[0 * 33], s[1 * 33]); o.y = pk2(s[2 * 33], s[3 * 33]); o.z = pk2(s[4 * 33], s[5 * 33]); o.w = pk2(s[6 * 33], s[7 * 33]);
        *(v4u*)(WT + (size_t)(nd + n) * K + k0 + 8 * c) = o; }
    LDS_WAIT(); asm volatile("" ::: "memory");
}
__device__ __forceinline__ void p0_mod_item(int item, const float* c, const float* ada_w, const float* ada_b, const float* kvw, const float* kvb, float* mod, LAS unsigned char* lds, int tid) {
    LAS float* cact = (LAS float*)lds; LAS float* red = (LAS float*)(lds + 16384);
    for (int i = tid; i < 4096; i += 512) { const int b = i >> 10, k = i & 1023; const float v = c[i]; cact[k * 4 + b] = v * __builtin_amdgcn_rcpf(1.f + __builtin_amdgcn_exp2f(-LOG2E * v)); }
    __syncthreads();
    const float* W; const float* bias; int N, col0, dstride; float* dst;
    if (item < 36) { W = ada_w; bias = ada_b; N = NMOD; col0 = 256 * item; dst = mod; dstride = NMOD; }
    else if (item < 72) { W = ada_w + (size_t)D * NMOD; bias = ada_b + NMOD; N = NMOD; col0 = 256 * (item - 36); dst = mod + 4 * NMOD; dstride = NMOD; }
    else { W = kvw; bias = kvb; N = 2 * D; col0 = 256 * (item - 72); dst = mod + 8 * NMOD; dstride = 2 * D; }
    const int wave = tid >> 6, lane = tid & 63;
    f32x4 a0 = {0.f, 0.f, 0.f, 0.f}, a1 = a0, a2 = a0, a3 = a0;
    const float* wp = W + (size_t)(128 * wave) * N + col0 + 4 * lane;
#pragma unroll 8
    for (int kk = 0; kk < 128; ++kk) { const f32x4 w = *(const f32x4*)(wp + (size_t)kk * N); const f32x4 cv = *(const LAS f32x4*)(cact + (128 * wave + kk) * 4);
        a0 += w * cv.x; a1 += w * cv.y; a2 += w * cv.z; a3 += w * cv.w; }
    LAS f32x4* rp = (LAS f32x4*)(red + (wave * 64 + lane) * 16);
    rp[0] = a0; rp[1] = a1; rp[2] = a2; rp[3] = a3;
    __syncthreads();
    for (int o = tid; o < 1024; o += 512) { const int b = o >> 8, j = o & 255; float s = 0.f;
#pragma unroll
        for (int w = 0; w < 8; ++w) s += red[(w * 64 + (j >> 2)) * 16 + 4 * b + (j & 3)];
        dst[(size_t)b * dstride + col0 + j] = s + bias[col0 + j]; }
    __syncthreads();
}
__device__ __forceinline__ void norm_rows(const float* src, const float* g, const float* shift, const float* scale, int mstride, bf16* dst, int gw, int NGW, int lane) {
    f32x4 nx[4];
    if (gw < M) {
#pragma unroll
        for (int j = 0; j < 4; ++j) nx[j] = ((const f32x4*)(src + (size_t)gw * D) + lane)[64 * j]; }
    for (int m = gw; m < M; m += NGW) {
        const int b = m >> 13;
        f32x4 v[4]; float s = 0.f;
#pragma unroll
        for (int j = 0; j < 4; ++j) v[j] = nx[j];
        if (m + NGW < M) { const f32x4* xn_ = (const f32x4*)(src + (size_t)(m + NGW) * D) + lane;
#pragma unroll
            for (int j = 0; j < 4; ++j) nx[j] = xn_[64 * j]; }
#pragma unroll
        for (int j = 0; j < 4; ++j) s += (v[j].x * v[j].x + v[j].y * v[j].y) + (v[j].z * v[j].z + v[j].w * v[j].w);
        const float rs = __builtin_amdgcn_rsqf(wave_sum(s) * (1.f / D) + EPS);
        const f32x4* g4 = (const f32x4*)g + lane; const f32x4* sh4 = (const f32x4*)(shift + (size_t)b * mstride) + lane; const f32x4* sc4 = (const f32x4*)(scale + (size_t)b * mstride) + lane;
        unsigned long long* o8 = (unsigned long long*)(dst + (size_t)m * D) + lane;
#pragma unroll
        for (int j = 0; j < 4; ++j) { const f32x4 y = v[j] * rs * g4[64 * j] * (sc4[64 * j] + 1.f) + sh4[64 * j];
            o8[64 * j] = (unsigned long long)pk2(y.x, y.y) | ((unsigned long long)pk2(y.z, y.w) << 32); }
    }
}
__device__ __forceinline__ void norm_rows_kv(const bf16* src, const float* gA, const float* shA, const float* scA, int strideA, bf16* dstA,
                                             const float* gB, const float* shB, const float* scB, int strideB, bf16* dstB,
                                             const LAS float* fgT, const float* fgb, float* logf_out, int gw, int NGW, int lane) {
    unsigned long long nw[4] = {0ull, 0ull, 0ull, 0ull};
    if (gw < M) { const unsigned long long* x0_ = (const unsigned long long*)(src + (size_t)gw * D) + lane;
#pragma unroll
        for (int j = 0; j < 4; ++j) nw[j] = x0_[64 * j]; }
    for (int m = gw; m < M; m += NGW) {
        const int b = m >> 13;
        unsigned long long cw[4];
#pragma unroll
        for (int j = 0; j < 4; ++j) cw[j] = nw[j];
        if (m + NGW < M) { const unsigned long long* xn_ = (const unsigned long long*)(src + (size_t)(m + NGW) * D) + lane;
#pragma unroll
            for (int j = 0; j < 4; ++j) nw[j] = xn_[64 * j]; }
        f32x4 v[4]; float s = 0.f;
#pragma unroll
        for (int j = 0; j < 4; ++j) { const unsigned long long w = cw[j]; const unsigned lo = (unsigned)w, hi = (unsigned)(w >> 32);
            { const pg8::f32x2s_t a = pg8::up_h2(lo), b = pg8::up_h2(hi); v[j] = (f32x4){a.x, a.y, b.x, b.y}; } s += (v[j].x * v[j].x + v[j].y * v[j].y) + (v[j].z * v[j].z + v[j].w * v[j].w); }
        const float rs = __builtin_amdgcn_rsqf(wave_sum(s) * (1.f / D) + EPS);
        {   const f32x4* g4 = (const f32x4*)gB + lane; const f32x4* sh4 = (const f32x4*)(shB + (size_t)b * strideB) + lane; const f32x4* sc4 = (const f32x4*)(scB + (size_t)b * strideB) + lane;
            unsigned long long* o8 = (unsigned long long*)(dstB + (size_t)m * D) + lane;
#pragma unroll
            for (int j = 0; j < 4; ++j) { const f32x4 y = v[j] * rs * g4[64 * j] * (sc4[64 * j] + 1.f) + sh4[64 * j];
                o8[64 * j] = (unsigned long long)pk2(y.x, y.y) | ((unsigned long long)pk2(y.z, y.w) << 32); } }
        {   const f32x4* g4 = (const f32x4*)gA + lane; const f32x4* sh4 = (const f32x4*)(shA + (size_t)b * strideA) + lane; const f32x4* sc4 = (const f32x4*)(scA + (size_t)b * strideA) + lane;
            unsigned long long* o8 = (unsigned long long*)(dstA + (size_t)m * D) + lane;
#pragma unroll
            for (int j = 0; j < 4; ++j) { v[j] = v[j] * rs * g4[64 * j] * (sc4[64 * j] + 1.f) + sh4[64 * j];
                o8[64 * j] = (unsigned long long)pk2(v[j].x, v[j].y) | ((unsigned long long)pk2(v[j].z, v[j].w) << 32); } }
        float zmine = 0.f;
#pragma unroll
        for (int hh = 0; hh < 16; ++hh) { float p = 0.f;
#pragma unroll
            for (int j = 0; j < 4; ++j) { const f32x4 w = *(const LAS f32x4*)(fgT + hh * 1024 + 256 * j + 4 * lane); p += (v[j].x * w.x + v[j].y * w.y) + (v[j].z * w.z + v[j].w * w.w); }
            p = wave_sum(p); if (lane == hh) zmine = p; }
        if (lane < 16) { const float z = zmine + fgb[lane]; const float lf = fminf(z, 0.f) - 0.6931471805599453f * __builtin_amdgcn_logf(1.f + __builtin_amdgcn_exp2f(-LOG2E * fabsf(z)));     logf_out[(size_t)m * 16 + lane] = lf; }
    }
}
__device__ __forceinline__ void combine_rows(const bf16* O0, const bf16* O1, const float* lamp, const float* subg, bf16* dst, int gw, int NGW, int lane) {
    const float pa = lamp[lane] * lamp[64 + lane], pb = lamp[128 + lane] * lamp[192 + lane];
    const float lam = __builtin_amdgcn_exp2f(LOG2E * wave_sum(pa)) - __builtin_amdgcn_exp2f(LOG2E * wave_sum(pb)) + 0.2f;
    float gg[16];
#pragma unroll
    for (int e = 0; e < 16; ++e) gg[e] = subg[16 * (lane & 7) + e] * 0.8f;
    v4u na0, na1, nb0, nb1;
    if (gw < M) { const v4u* p0 = (const v4u*)(O0 + (size_t)gw * D + 16 * lane); const v4u* p1 = (const v4u*)(O1 + (size_t)gw * D + 16 * lane); na0 = p0[0]; na1 = p0[1]; nb0 = p1[0]; nb1 = p1[1]; }
    for (int m = gw; m < M; m += NGW) {
        const v4u a0 = na0, a1 = na1, b0 = nb0, b1 = nb1;
        if (m + NGW < M) { const v4u* p0 = (const v4u*)(O0 + (size_t)(m + NGW) * D + 16 * lane); const v4u* p1 = (const v4u*)(O1 + (size_t)(m + NGW) * D + 16 * lane); na0 = p0[0]; na1 = p0[1]; nb0 = p1[0]; nb1 = p1[1]; }
        float v[16];
#pragma unroll
        for (int i = 0; i < 4; ++i) { v[2 * i] = bf_lo(a0[i]) - lam * bf_lo(b0[i]); v[2 * i + 1] = bf_hi(a0[i]) - lam * bf_hi(b0[i]);
            v[8 + 2 * i] = bf_lo(a1[i]) - lam * bf_lo(b1[i]); v[8 + 2 * i + 1] = bf_hi(a1[i]) - lam * bf_hi(b1[i]); }
        float ss = 0.f;
#pragma unroll
        for (int e = 0; e < 16; ++e) ss += v[e] * v[e];
        ss = xadd<1>(ss); ss = xadd<2>(ss); ss = xadd<4>(ss);
        const float rs = __builtin_amdgcn_rsqf(ss * (1.f / 128.f) + EPS);
        v4u o0, o1;
#pragma unroll
        for (int i = 0; i < 4; ++i) { o0[i] = pk2(v[2 * i] * rs * gg[2 * i], v[2 * i + 1] * rs * gg[2 * i + 1]); o1[i] = pk2(v[8 + 2 * i] * rs * gg[8 + 2 * i], v[8 + 2 * i + 1] * rs * gg[8 + 2 * i + 1]); }
        v4u* q = (v4u*)(dst + (size_t)m * D + 16 * lane); q[0] = o0; q[1] = o1;
    }
}
__device__ __forceinline__ void scan_seq(int seq, const float* logf_in, float* nf2, LAS unsigned char* lds, int tid) {
    const int b = seq >> 4, hh = seq & 15, s0 = 16 * tid, lane = tid & 63, wave = tid >> 6;
    float v[16]; float run = 0.f;
#pragma unroll
    for (int i = 0; i < 16; ++i) { run += logf_in[((size_t)(b * T + s0 + i)) * 16 + hh]; v[i] = run; }
    float incl = run;
#pragma unroll
    for (int o = 1; o < 64; o <<= 1) { const float t = __int_as_float(__builtin_amdgcn_ds_bpermute((lane - o) << 2, __float_as_int(incl))); if (lane >= o) incl += t; }
    LAS float* wt = (LAS float*)lds;
    if (lane == 63) wt[wave] = incl;
    __syncthreads();
    float off = incl - run;
    for (int w = 0; w < wave; ++w) off += wt[w];
#pragma unroll
    for (int i = 0; i < 16; ++i) nf2[(size_t)seq * T + s0 + i] = -(off + v[i]) * LOG2E;
    __syncthreads();
}

__device__ __forceinline__ void kmax_rows(const bf16* KB, float* kpart, LAS unsigned char* lds, int gw, int NGW, int tid, int lane, int bx) {
    LAS unsigned* lm = (LAS unsigned*)lds;
    if (tid < 64) lm[tid] = 0u;
    __syncthreads();
    float run = 0.f; int cb = -1;
    v4u ka0 = {0u, 0u, 0u, 0u}, ka1 = ka0;
    if (gw < M) { const v4u* p0_ = (const v4u*)(KB + (size_t)gw * D + 16 * lane); ka0 = p0_[0]; ka1 = p0_[1]; }
    for (int m = gw; m < M; m += NGW) {
        const int b = m >> 13;
        if (b != cb) { if (cb >= 0 && (lane & 3) == 0) atomicMax((unsigned*)(lm + cb * 16 + (lane >> 2)), __float_as_uint(run)); run = 0.f; cb = b; }
        const v4u a0 = ka0, a1 = ka1;
        if (m + NGW < M) { const v4u* pn_ = (const v4u*)(KB + (size_t)(m + NGW) * D + 16 * lane); ka0 = pn_[0]; ka1 = pn_[1]; }
        float ss = 0.f;
#pragma unroll
        for (int i = 0; i < 4; ++i) { const float x0 = bf_lo(a0[i]), x1 = bf_hi(a0[i]), x2 = bf_lo(a1[i]), x3 = bf_hi(a1[i]); ss += (x0 * x0 + x1 * x1) + (x2 * x2 + x3 * x3); }
        ss = xadd<1>(ss); ss = xadd<2>(ss);
        run = fmaxf(run, ss);
    }
    if (cb >= 0 && (lane & 3) == 0) atomicMax((unsigned*)(lm + cb * 16 + (lane >> 2)), __float_as_uint(run));
    __syncthreads();
    if (tid < 64) kpart[(size_t)bx * 64 + tid] = __uint_as_float(lm[tid]);
    __syncthreads();
}

struct Args { const float* in[21]; float* out; unsigned char* ws; int pad0, pad1; };
enum { K_PRO = 0, K_NORM, K_SWIGLU, K_RESID, K_SPLIT, K_ATTNA, K_COMB, K_NORMKV, K_ATTNB, K_RESIDN, K_NOP };
constexpr int NPH = 23;

__global__ void __launch_bounds__(NWAVES * 64, 2) skel_fwd(Args args) {
    extern __shared__ __attribute__((aligned(16))) unsigned char lds[];
    cg::grid_group grid = cg::this_grid();
    LAS unsigned char* ldsL = (LAS unsigned char*)lds;
    typedef __attribute__((address_space(4))) const Args CArgs;
    {   volatile LAS unsigned* bst0 = (volatile LAS unsigned*)(ldsL + RING_BYTES + 512);
        if (threadIdx.x < 2) bst0[threadIdx.x] = 0u;
        if (blockIdx.x == 0) { unsigned* bw = (unsigned*)(args.ws + WS_BAR); for (int i = threadIdx.x; i < XCD_BAR_WORDS; i += NWAVES * 64) bw[i] = 0u;
            unsigned* cw = (unsigned*)(args.ws + WS_CNT); for (int i = threadIdx.x; i < 5 * 128 * 64; i += NWAVES * 64) cw[i] = 0u; }
        __syncthreads(); }
    int prep = 0;
    const int wave_s = __builtin_amdgcn_readfirstlane(threadIdx.x >> 6);
#pragma nounroll
    for (int ph = 0; ph < NPH; ++ph) {
        CArgs* ap = (CArgs*)__builtin_amdgcn_kernarg_segment_ptr();
        asm volatile("" : "+s"(ap));
        const int wave = wave_s;
#define TID() opq_tid(wave_s)
        int G = gridDim.x, bx = blockIdx.x; asm volatile("" : "+s"(G), "+s"(bx));
        const int vcu = (G % 8 == 0) ? (bx % 8) * (G / 8) + bx / 8 : bx;
        const int gw = vcu * NWAVES + wave, NGW = G * NWAVES;
        unsigned char* ws = ap->ws;
        const float* x = ap->in[0];
        float* OUTF = ap->out; bf16* XB = (bf16*)ap->out;
        bf16* XB2 = (bf16*)(ws + WS_XN2);
        float* mod = (float*)(ws + WS_MOD);
        float* kvmod = mod + 8 * NMOD;
        float* logfb = (float*)(ws + WS_LOGF);
        float* nf2 = (float*)(ws + WS_NF2);
        bf16* XN = (bf16*)(ws + WS_XN); bf16* XN2 = (bf16*)(ws + WS_XN2);
        bf16* R1 = (bf16*)(ws + WS_R1); bf16* R2 = (bf16*)(ws + WS_R2);
        const float* norm_g = ap->in[4];
        int kind = K_NORM; bool sync_after = true;
        const bf16* gA = XN; const bf16* gB = nullptr; int gN = D, gK = D;
        const float* nsrc = x; const float* ng = norm_g; const float* nsh = mod; const float* nsc = mod;
        const void* rbase = XB; int rbase_bf = 1; bf16* rout = XB; const float* rgate = mod; float rcoef = 0.5f;
        bf16* sO = R1; float sscale = 1.f;
        int bank = 0, fin = 0;
        const int L = (ph >= 12) ? 1 : 0;
        unsigned char* wl = ws + (L ? WS_WB : WS_WA);
        const float* modl = mod + (size_t)L * 4 * NMOD;
        switch (ph) {
            case 0: kind = K_PRO; break;
            case 1: kind = K_NORM; nsrc = x; ng = norm_g; nsh = modl; nsc = modl + D; break;
            case 2: kind = K_SWIGLU; gB = (const bf16*)(wl + WO_IN0); gN = NIN; gK = D; break;
            case 3: kind = K_RESIDN; gA = R1; gB = (const bf16*)(wl + WO_OUT0); gN = D; gK = FF; rbase = x; rbase_bf = 0; rgate = modl + 2 * D; rcoef = 0.5f; bank = 0; ng = norm_g + D; nsh = modl + 3 * D; nsc = modl + 4 * D; break;
            case 4: kind = K_NOP; sync_after = false; break;
            case 5: kind = K_SPLIT; gB = (const bf16*)(wl + WO_X1); gN = 3 * D; gK = D; sO = R1; sscale = attn_body::C2; break;
            case 6: kind = K_ATTNA; break;
            case 7: kind = K_COMB; break;
            case 8: kind = K_RESIDN; gA = R1; gB = (const bf16*)(wl + WO_AWO); gN = D; gK = D; rgate = modl + 5 * D; rcoef = 1.f; bank = 1; ng = norm_g + 2 * D; nsh = modl + 6 * D; nsc = modl + 7 * D; break;
            case 9: kind = K_NOP; sync_after = false; break;
            case 10: kind = K_SWIGLU; gB = (const bf16*)(wl + WO_IN1); gN = NIN; gK = D; break;
            case 11: kind = K_RESID; gA = R1; gB = (const bf16*)(wl + WO_OUT1); gN = D; gK = FF; rgate = modl + 8 * D; rcoef = 0.5f; break;
            case 12: kind = K_NORMKV; break;
            case 13: kind = K_SPLIT; gB = (const bf16*)(wl + WO_X1); gN = 2 * D; gK = D; sO = R2; sscale = 1.f; sync_after = false; break;
            case 14: kind = K_SWIGLU; gA = XN2; gB = (const bf16*)(wl + WO_IN0); gN = NIN; gK = D; break;
            case 15: kind = K_RESIDN; gA = R1; gB = (const bf16*)(wl + WO_OUT0); gN = D; gK = FF; rgate = modl + 2 * D; rcoef = 0.5f; bank = 2; ng = norm_g + 4 * D; nsh = modl + 3 * D; nsc = modl + 4 * D; break;
            case 16: kind = K_NOP; sync_after = false; break;
            case 17: kind = K_SPLIT; gB = (const bf16*)(wl + WO_BWQ); gN = D; gK = D; sO = R1; sscale = attn_body::C2; break;
            case 18: kind = K_ATTNB; break;
            case 19: kind = K_RESIDN; gA = R1; gB = (const bf16*)(wl + WO_BWO); gN = D; gK = D; rgate = modl + 5 * D; rcoef = 1.f; bank = 3; rout = XB2; ng = norm_g + 5 * D; nsh = modl + 6 * D; nsc = modl + 7 * D; break;
            case 20: kind = K_NOP; sync_after = false; break;
            case 21: kind = K_SWIGLU; gB = (const bf16*)(wl + WO_IN1); gN = NIN; gK = D; break;
            case 22: kind = K_RESIDN; gA = R1; gB = (const bf16*)(wl + WO_OUT1); gN = D; gK = FF; rgate = modl + 8 * D; rcoef = 0.5f; bank = 4; fin = 1; rbase = XB2; ng = ap->in[20]; sync_after = false; break;
            default: kind = K_NOP; sync_after = false; break;
        }
#ifndef PROBE_REP
#define PROBE_REP 0
#endif
#ifndef PROBE_SYNC
#define PROBE_SYNC 1
#endif
        if (kind == K_PRO) {
            if (bx == 0 && TID() == 0) *(unsigned*)(ws + WS_QCTR) = 0u;
            if (PROBE_REP != 0 && bx == 1 && TID() == 0) ((unsigned*)(ws + WS_QCTR))[1] = 0u;
            for (int it = bx; it < 80; it += G) p0_mod_item(it, ap->in[1], ap->in[2], ap->in[3], ap->in[12], ap->in[13], mod, ldsL, TID());
            LAS float* scr = (LAS float*)(ldsL + wave * 16384);
            constexpr int I_IN = (D / 64) * (NIN / 32), I_OUT = (FF / 64) * (D / 32), I_QKV = (D / 64) * (3 * D / 32), I_SQ = (D / 64) * (D / 32), I_KV = (D / 64) * (2 * D / 32);
            constexpr int NITEMS = 4 * I_IN + 4 * I_OUT + I_QKV + I_SQ + I_KV + 2 * I_SQ;
            for (int it = gw; it < NITEMS; it += NGW) {
                int r = it; const float* W; int K, N, perm = 0; bf16* WT;
                if (r < 4 * I_IN) { const int w = r / I_IN; r -= w * I_IN; W = ap->in[5] + (size_t)w * D * NIN; K = D; N = NIN; perm = 1;
                    WT = (bf16*)(ws + ((w >> 1) ? WS_WB : WS_WA) + ((w & 1) ? WO_IN1 : WO_IN0)); }
                else if ((r -= 4 * I_IN) < 4 * I_OUT) { const int w = r / I_OUT; r -= w * I_OUT; W = ap->in[6] + (size_t)w * FF * D; K = FF; N = D;
                    WT = (bf16*)(ws + ((w >> 1) ? WS_WB : WS_WA) + ((w & 1) ? WO_OUT1 : WO_OUT0)); }
                else if ((r -= 4 * I_OUT) < I_QKV) { W = ap->in[7]; K = D; N = 3 * D; WT = (bf16*)(ws + WS_WA + WO_X1); }
                else if ((r -= I_QKV) < I_SQ) { W = ap->in[8]; K = D; N = D; WT = (bf16*)(ws + WS_WA + WO_AWO); }
                else if ((r -= I_SQ) < I_KV) { W = ap->in[15]; K = D; N = 2 * D; WT = (bf16*)(ws + WS_WB + WO_X1); }
                else if ((r -= I_KV) < I_SQ) { W = ap->in[18]; K = D; N = D; WT = (bf16*)(ws + WS_WB + WO_BWQ); }
                else { r -= I_SQ; W = ap->in[19]; K = D; N = D; WT = (bf16*)(ws + WS_WB + WO_BWO); }
                p0_transpose_item(W, K, N, WT, perm, scr, r, TID() & 63);
            }
        } else if (kind == K_NORM) {
            norm_rows(nsrc, ng, nsh, nsc, NMOD, XN, gw, NGW, TID() & 63);
        } else if (kind == K_NORMKV) {
            LAS float* fgT = (LAS float*)ldsL;
            for (int i = TID(); i < 16 * D; i += NWAVES * 64) { const int c = i >> 4, hh = i & 15; fgT[hh * 1024 + c] = ap->in[16][i]; }
            __syncthreads();
            norm_rows_kv(XB, ap->in[14], kvmod, kvmod + D, 2 * D, XN, norm_g + 3 * D, modl, modl + D, NMOD, XN2, fgT, ap->in[17], logfb, gw, NGW, TID() & 63);
            __syncthreads();
        } else if (kind == K_SWIGLU) {
            pg8::Gemm g{gA, gB, M, gN, gK}; pg8::StaticOrder S; S.init(M, gN, G, bx);
            pg8::EpiSwiglu E{R1, FF};
            pg8::gemm_phase<pg8::EpiSwiglu, pg8::StaticOrder, true, true>(ldsL, g, S, E, TID());
        } else if (kind == K_RESID) {
            pg8::Gemm g{gA, gB, M, gN, gK}; pg8::StaticOrder S; S.init(M, gN, G, bx);
            pg8::EpiResid E{(const bf16*)rbase, rout, rgate, NMOD, rcoef};
            pg8::gemm_phase<pg8::EpiResid, pg8::StaticOrder, true, true>(ldsL, g, S, E, TID());
        } else if (kind == K_RESIDN) {
            pg8::Gemm g{gA, gB, M, D, gK}; pg8::StaticOrder S; S.init(M, D, G, bx);
            pg8::RmsStats st{(unsigned*)(ws + WS_XBUF), (unsigned*)(ws + WS_CNT) + (size_t)bank * 128 * 64, EPS};
#define RUN_RESIDN(BH, FN) do { pg8::EpiResidNorm<BH, FN> E{rbase, rout, OUTF, rgate, NMOD, rcoef, ng, nsh, nsc, NMOD, XN, st, ldsL + RING_BYTES + 1024}; \
                pg8::gemm_phase<pg8::EpiResidNorm<BH, FN>, pg8::StaticOrder, true, true>(ldsL, g, S, E, TID()); } while (0)
            if (fin) RUN_RESIDN(true, true); else if (rbase_bf) RUN_RESIDN(true, false); else RUN_RESIDN(false, false);
#undef RUN_RESIDN
        } else if (kind == K_SPLIT) {
            if (ph == 17) { const int t_ = TID(); kmax_rows(R2, (float*)(ws + WS_KPART), ldsL, gw, NGW, t_, t_ & 63, bx); }
            pg8::Gemm g{gA, gB, M, gN, gK}; pg8::StaticOrder S; S.init(M, gN, G, bx);
            pg8::EpiBf16<0> E{sO, D, nullptr, D, BUF64 / 2, sscale};
            pg8::gemm_phase<pg8::EpiBf16<0>, pg8::StaticOrder, true, true>(ldsL, g, S, E, TID());
            if (ph == 13) { for (int seq = bx; seq < 64; seq += G) scan_seq(seq, logfb, nf2, ldsL, TID()); }
        } else if (kind == K_ATTNA) {
            const attn_body::bf16* Qp = (const attn_body::bf16*)R1; const attn_body::bf16* Kp = Qp + BUF64 / 2; const attn_body::bf16* Vp = Kp + BUF64 / 2;
            attn_body::bf16* O0 = (attn_body::bf16*)R2; attn_body::bf16* O1 = O0 + BUF64 / 2;
            for (int pi = vcu; pi < 1024; pi += G) { const int combo = pi >> 4, s = pi & 15, b = combo >> 4, h16 = combo & 15;
                const int vc = (h16 >> 1) * 128;
                for (int k = 0; k < 2; ++k) { const int qb = k ? s : 31 - s;
                    if (!attn_body::attn_unit_w<8, true>(b, h16 * 64, h16 * 64, vc, vc, qb, Qp, Kp, Vp, (h16 & 1) ? O1 : O0, (char*)lds, ap->in[11], h16 >> 1, nullptr, 0, TID()))
                        (void)attn_body::attn_unit_w<8, false>(b, h16 * 64, h16 * 64, vc, vc, qb, Qp, Kp, Vp, (h16 & 1) ? O1 : O0, (char*)lds, ap->in[11], h16 >> 1, nullptr, 0, TID()); } }
        } else if (kind == K_ATTNB) {
            const attn_body::bf16* Qp = (const attn_body::bf16*)R1; const attn_body::bf16* Kp = (const attn_body::bf16*)R2; const attn_body::bf16* Vp = Kp + BUF64 / 2;
            LAS int* ordl = (LAS int*)(ldsL + RING_BYTES); LAS unsigned* slotl = (LAS unsigned*)(ldsL + RING_BYTES + 256);
            if (wave == 0) { const int lane = TID() & 63; const float v = nf2[(size_t)lane * T + T - 1]; int rank = 0;
                for (int j = 0; j < 64; ++j) { const float vj = __int_as_float(__builtin_amdgcn_readlane(__float_as_int(v), j)); rank += (vj < v || (vj == v && j < lane)) ? 1 : 0; }
                ordl[rank] = lane; }
            __syncthreads();
            unsigned* qctr = (unsigned*)(ws + WS_QCTR) + (PROBE_REP ? prep : 0);
            for (;;) {
                if (TID() == 0) slotl[0] = atomicAdd(qctr, 1u);
                __syncthreads();
                const unsigned u = slotl[0];
                __syncthreads();
                if (u >= 2048u) break;
                const int combo = ordl[u >> 5], qb = 31 - (int)(u & 31u), b = combo >> 4, h = combo & 15;
                attn_body::attn_unit<8, 1>(b, h * 64, h * 64, h * 64, h * 64, qb, Qp, Kp, Vp, (attn_body::bf16*)R1, (char*)lds, nf2 + (size_t)combo * T, 0, (const float*)(ws + WS_KPART) + combo, G, TID());
            }
        } else if (kind == K_COMB) {
            combine_rows(R2, R2 + BUF64 / 2, ap->in[9], ap->in[10], R1, gw, NGW, TID() & 63);
        }
        if (PROBE_REP != 0 && prep == 0 && ((PROBE_REP >> kind) & 1) && kind != K_RESID && kind != K_RESIDN && kind != K_NOP) { prep = 1; --ph; if (ph < 0) { grid.sync(); } else { XcdBarrier bar; bar.bar = (unsigned*)(ws + WS_BAR); bar.x = xb_xcc_id(); bar.st = (volatile LAS unsigned*)(ldsL + RING_BYTES + 512); xcd_barrier(bar, TID()); } continue; }
        prep = 0;
        if (sync_after) {
            XcdBarrier bar; bar.bar = (unsigned*)(ws + WS_BAR); bar.x = xb_xcc_id(); bar.st = (volatile LAS unsigned*)(ldsL + RING_BYTES + 512);
            if (ph == 0) { grid.sync(); if (TID() == 0) (void)xb_add(&bar.bar[XB_XCNT(bar.x)], 1u); }
            else { for (int sy = 0; sy < PROBE_SYNC; ++sy) xcd_barrier(bar, TID()); }
        }
    }
}

extern "C" void kernel_launch(void* const* d_in, const int* in_sizes, int n_in, void* d_out, int out_size, void* d_ws, size_t ws_size, hipStream_t stream) {
    static int grid = 0;
    if (grid == 0) {
        if (n_in != 21 || in_sizes[0] != M * D || out_size != M * D || ws_size < WS_END) { fprintf(stderr, "kernel_launch: unexpected shapes (n_in %d in0 %d out %d ws %zu); nothing launched\n", n_in, n_in > 0 ? in_sizes[0] : -1, out_size, ws_size); grid = -1; return; }
        int dev = 0, cus = 0, per_cu = 0;
        (void)hipGetDevice(&dev);
        (void)hipDeviceGetAttribute(&cus, hipDeviceAttributeMultiprocessorCount, dev);
        (void)hipFuncSetAttribute((const void*)skel_fwd, hipFuncAttributeMaxDynamicSharedMemorySize, LDS_BYTES);
        (void)hipOccupancyMaxActiveBlocksPerMultiprocessor(&per_cu, (const void*)skel_fwd, NWAVES * 64, LDS_BYTES);
        if (per_cu < 1) per_cu = 1;
        grid = cus * per_cu;
    }
    if (grid < 0) return;
    Args a{};
    for (int i = 0; i < 21; ++i) a.in[i] = (const float*)d_in[i];
    a.out = (float*)d_out; a.ws = (unsigned char*)d_ws;
    void* kargs[] = {&a};
    hipError_t e = hipLaunchCooperativeKernel((const void*)skel_fwd, dim3(grid), dim3(NWAVES * 64), kargs, LDS_BYTES, stream);
    if (e != hipSuccess) fprintf(stderr, "cooperative launch failed: %s (grid %d)\n", hipGetErrorString(e), grid);
}
```
